# Optimizing an MI355X kernel written in HIP

```python
import math
import jax, jax.numpy as jnp
from jax import lax
import numpy as np

D_MODEL = 1024
BATCH = 8
SEQ = 4096
DEPTH = 2

M_HEADS = 4
M_DH = D_MODEL // M_HEADS
M_W = M_HEADS * M_DH
M_CHUNK = 128
CONV_W = 4
POOL_WINDOWS = (2, 4, 8, 16)
POOL_GROUPS = 4
POOL_W = D_MODEL
POOL_G = POOL_W // POOL_GROUPS
A_HEADS = 8
A_DK = 64
A_DV = 2 * A_DK
A_QK_W = A_HEADS * 2 * A_DK
A_V_W = A_HEADS * A_DV
Q_BLOCK = 128
ROPE_THETA = 10000.0
N_BRANCH = 3
FF = -(-8 * D_MODEL // (3 * 256)) * 256
NORM_EPS = 1e-6
NEG_BIG = -1e30

SPLIT_SIZES = (M_W, M_W, M_W, M_W, M_HEADS, M_HEADS, POOL_W, A_QK_W, A_QK_W, A_V_W, N_BRANCH * D_MODEL)
N_IN = sum(SPLIT_SIZES)

kernel_name = "hybrid_mlstm_pool_diffattn_block"


def rmsnorm(x, g):
    xf = x.astype(jnp.float32)
    y = xf * lax.rsqrt(jnp.mean(xf * xf, axis=-1, keepdims=True) + NORM_EPS)
    return (y * g.astype(jnp.float32)).astype(x.dtype)


def rope(x):
    S, d = x.shape[-2], x.shape[-1]
    half = d // 2
    inv = ROPE_THETA ** (-jnp.arange(half, dtype=jnp.float32) / half)
    ang = jnp.arange(S, dtype=jnp.float32)[:, None] * inv[None, :]
    cos, sin = jnp.cos(ang), jnp.sin(ang)
    xf = x.astype(jnp.float32)
    x1, x2 = xf[..., :half], xf[..., half:]
    return jnp.concatenate([x1 * cos - x2 * sin, x2 * cos + x1 * sin], axis=-1).astype(x.dtype)


def causal_conv(u, w):
    C = u.shape[-1]
    return lax.conv_general_dilated(u, w[:, None, :].astype(u.dtype), window_strides=(1,),
                                    padding=((CONV_W - 1, 0),),
                                    dimension_numbers=('NWC', 'WIO', 'NWC'),
                                    feature_group_count=C)


def mlstm_chunkwise(q, k, v, i_pre, f_pre):
    B, H, S, Dh = q.shape
    L = M_CHUNK
    NC = S // L
    q = q.reshape(B, H, NC, L, Dh) * (Dh ** -0.5)
    k = k.reshape(B, H, NC, L, Dh)
    v = v.reshape(B, H, NC, L, Dh)
    li = i_pre.reshape(B, H, NC, L)
    lf = jax.nn.log_sigmoid(f_pre).reshape(B, H, NC, L)
    b = jnp.cumsum(lf, axis=-1)
    g = b[..., -1]
    w_state = g[..., None] - b + li
    m_loc = jnp.max(w_state, axis=-1)
    e_state = jnp.exp(w_state - m_loc[..., None])
    C_loc = jnp.einsum('bhcsk,bhcsv->bhckv', k * e_state[..., None], v)
    n_loc = jnp.einsum('bhcs,bhcsk->bhck', e_state, k)

    def step(carry, inp):
        C, n, m = carry
        g_c, m_c, C_c, n_c = inp
        m_new = jnp.maximum(g_c + m, m_c)
        a = jnp.exp(g_c + m - m_new)
        bb = jnp.exp(m_c - m_new)
        C_new = a[..., None, None] * C + bb[..., None, None] * C_c
        n_new = a[..., None] * n + bb[..., None] * n_c
        return (C_new, n_new, m_new), (C, n, m)

    init = (jnp.zeros((B, H, Dh, Dh), jnp.float32), jnp.zeros((B, H, Dh), jnp.float32),
            jnp.full((B, H), NEG_BIG, jnp.float32))
    xs = (jnp.moveaxis(g, 2, 0), jnp.moveaxis(m_loc, 2, 0), jnp.moveaxis(C_loc, 2, 0), jnp.moveaxis(n_loc, 2, 0))
    _, (C_prev, n_prev, m_prev) = lax.scan(step, init, xs)
    C_prev = jnp.moveaxis(C_prev, 0, 2)
    n_prev = jnp.moveaxis(n_prev, 0, 2)
    m_prev = jnp.moveaxis(m_prev, 0, 2)

    causal = jnp.tril(jnp.ones((L, L), dtype=bool))
    Dm = jnp.where(causal, b[..., :, None] - b[..., None, :] + li[..., None, :], -jnp.inf)
    m_inter = b + m_prev[..., None]
    m_t = jnp.maximum(m_inter, jnp.max(Dm, axis=-1))
    P = jnp.exp(Dm - m_t[..., None])
    Sqk = jnp.einsum('bhcjd,bhcsd->bhcjs', q, k) * P
    inter = jnp.exp(m_inter - m_t)
    num = jnp.einsum('bhcjs,bhcsv->bhcjv', Sqk, v) + inter[..., None] * jnp.einsum('bhcjk,bhckv->bhcjv', q, C_prev)
    den = jnp.sum(Sqk, axis=-1) + inter * jnp.einsum('bhcjk,bhck->bhcj', q, n_prev)
    h = num / jnp.maximum(jnp.abs(den), jnp.exp(-m_t))[..., None]
    return h.reshape(B, H, S, Dh)


def pool_mixer(u, w_pool, scale):
    B, S, _ = u.shape
    uf = u.astype(jnp.float32)
    cs = jnp.concatenate([jnp.zeros((B, 1, POOL_W), jnp.float32), jnp.cumsum(uf, axis=1)], axis=1)
    pos1 = jnp.arange(1, S + 1)
    means = []
    for gi, w in enumerate(POOL_WINDOWS):
        c = cs[..., gi * POOL_G:(gi + 1) * POOL_G]
        lo = jnp.concatenate([jnp.zeros((B, w - 1, POOL_G), jnp.float32), c[:, :S - w + 1]], axis=1)
        cnt = jnp.minimum(pos1, w).astype(jnp.float32)
        means.append((c[:, 1:] - lo) / cnt[None, :, None])
    pooled = jnp.concatenate(means, axis=-1) - uf
    y = jnp.einsum('bsgi,gio->bsgo', pooled.reshape(B, S, POOL_GROUPS, POOL_G),
                   w_pool.astype(jnp.float32)).reshape(B, S, POOL_W)
    return (y * scale.astype(jnp.float32)).astype(u.dtype)


def diff_attention(q, k, v, lam):
    B, H, _, S, dk = q.shape
    nb = S // Q_BLOCK
    qb = jnp.moveaxis(q.reshape(B, H, 2, nb, Q_BLOCK, dk), 3, 0)
    kpos = jnp.arange(S)
    scale = dk ** -0.5

    def block(args):
        q_blk, blk = args
        s = jnp.einsum('bhcqd,bhckd->bhcqk', q_blk, k).astype(jnp.float32) * scale
        qpos = blk * Q_BLOCK + jnp.arange(Q_BLOCK)
        s = jnp.where(kpos[None, :] <= qpos[:, None], s, -jnp.inf)
        p = jax.nn.softmax(s, axis=-1)
        a = p[:, :, 0] - lam * p[:, :, 1]
        return jnp.einsum('bhqk,bhkd->bhqd', a, v.astype(jnp.float32))

    out = lax.map(block, (qb, jnp.arange(nb)))
    return jnp.moveaxis(out, 0, 2).reshape(B, H, S, v.shape[-1]).astype(v.dtype)


def hybrid_mixer(x, layer_idx, g_mix, w_in, b_if, conv_qk, w_m_out, w_pool, pool_scale,
                 g_qk, lam_p, g_diff_head, w_diff_out, w_out):
    B, S, _ = x.shape
    h = rmsnorm(x, g_mix)
    proj = h @ w_in
    mq, mk, mv, mo, mi, mf, pu, aq, ak, av, gate_pre = jnp.split(
        proj, np.cumsum(SPLIT_SIZES)[:-1].tolist(), axis=-1)

    qk = jax.nn.silu(causal_conv(jnp.concatenate([mq, mk], axis=-1), conv_qk))
    mq, mk = jnp.split(qk, 2, axis=-1)

    def heads(t):
        return t.reshape(B, S, M_HEADS, M_DH).transpose(0, 2, 1, 3).astype(jnp.float32)

    i_pre = (mi + b_if[:M_HEADS]).astype(jnp.float32).transpose(0, 2, 1)
    f_pre = (mf + b_if[M_HEADS:]).astype(jnp.float32).transpose(0, 2, 1)
    hm = mlstm_chunkwise(heads(mq), heads(mk), heads(mv), i_pre, f_pre)
    hm = hm.transpose(0, 2, 1, 3).reshape(B, S, M_W).astype(x.dtype)
    y_m = (jax.nn.sigmoid(mo) * hm) @ w_m_out

    y_p = pool_mixer(pu, w_pool, pool_scale)

    q = aq.reshape(B, S, A_HEADS, 2, A_DK).transpose(0, 2, 3, 1, 4)
    k = ak.reshape(B, S, A_HEADS, 2, A_DK).transpose(0, 2, 3, 1, 4)
    q = rope(rmsnorm(q, g_qk[0]))
    k = rope(rmsnorm(k, g_qk[1]))
    v = av.reshape(B, S, A_HEADS, A_DV).transpose(0, 2, 1, 3)
    lam_init = 0.8 - 0.6 * math.exp(-0.3 * layer_idx)
    lp = lam_p.astype(jnp.float32)
    lam = jnp.exp(jnp.sum(lp[0] * lp[1])) - jnp.exp(jnp.sum(lp[2] * lp[3])) + lam_init
    o = diff_attention(q, k, v, lam)
    o = rmsnorm(o, g_diff_head) * (1.0 - lam_init)
    y_a = o.transpose(0, 2, 1, 3).reshape(B, S, A_V_W) @ w_diff_out

    g_m, g_p, g_a = jnp.split(jax.nn.sigmoid(gate_pre), N_BRANCH, axis=-1)
    merged = g_m * y_m + g_p * y_p + g_a * y_a
    return merged @ w_out


def swiglu_ffn(x, g_ffn, w_gate_up, w_down):
    h = rmsnorm(x, g_ffn)
    gate, up = jnp.split(h @ w_gate_up, 2, axis=-1)
    return (jax.nn.silu(gate) * up) @ w_down


def setup_inputs(seed: int = 0) -> dict:
    key = jax.random.key(seed)
    ks = jax.random.split(key, 18)
    f32 = jnp.float32

    def nrm(k, shape, scale):
        return jax.random.normal(k, shape, f32) * scale

    x = nrm(ks[0], (BATCH, SEQ, D_MODEL), 1.0)
    g_mix = 1.0 + nrm(ks[1], (DEPTH, D_MODEL), 0.02)
    w_in = nrm(ks[2], (DEPTH, D_MODEL, N_IN), D_MODEL ** -0.5)
    b_i = nrm(ks[3], (DEPTH, M_HEADS), 0.1)
    b_f = jnp.linspace(3.0, 6.0, M_HEADS, dtype=f32)[None, :] + nrm(ks[4], (DEPTH, M_HEADS), 0.1)
    b_if = jnp.concatenate([b_i, b_f], axis=-1)
    conv_qk = nrm(ks[5], (DEPTH, CONV_W, 2 * M_W), CONV_W ** -0.5)
    w_m_out = nrm(ks[6], (DEPTH, M_W, D_MODEL), M_W ** -0.5)
    w_pool = nrm(ks[7], (DEPTH, POOL_GROUPS, POOL_G, POOL_G), POOL_G ** -0.5)
    pool_scale = 1.0 + nrm(ks[8], (DEPTH, POOL_W), 0.02)
    g_qk = 1.0 + nrm(ks[9], (DEPTH, 2, A_DK), 0.02)
    lam_p = nrm(ks[10], (DEPTH, 4, A_DK), 0.1)
    g_diff_head = 1.0 + nrm(ks[11], (DEPTH, A_DV), 0.02)
    w_diff_out = nrm(ks[12], (DEPTH, A_V_W, D_MODEL), A_V_W ** -0.5)
    w_out = nrm(ks[13], (DEPTH, D_MODEL, D_MODEL), D_MODEL ** -0.5)
    g_ffn = 1.0 + nrm(ks[14], (DEPTH, D_MODEL), 0.02)
    w_gate_up = nrm(ks[15], (DEPTH, D_MODEL, 2 * FF), D_MODEL ** -0.5)
    w_down = nrm(ks[16], (DEPTH, FF, D_MODEL), FF ** -0.5)
    return {"x": x, "g_mix": g_mix, "w_in": w_in, "b_if": b_if, "conv_qk": conv_qk,
            "w_m_out": w_m_out, "w_pool": w_pool, "pool_scale": pool_scale, "g_qk": g_qk,
            "lam_p": lam_p, "g_diff_head": g_diff_head, "w_diff_out": w_diff_out, "w_out": w_out,
            "g_ffn": g_ffn, "w_gate_up": w_gate_up, "w_down": w_down}


def reference(x, g_mix, w_in, b_if, conv_qk, w_m_out, w_pool, pool_scale, g_qk, lam_p,
              g_diff_head, w_diff_out, w_out, g_ffn, w_gate_up, w_down):
    for l in range(DEPTH):
        x = x + hybrid_mixer(x, l, g_mix[l], w_in[l], b_if[l], conv_qk[l], w_m_out[l], w_pool[l],
                             pool_scale[l], g_qk[l], lam_p[l], g_diff_head[l], w_diff_out[l], w_out[l])
        x = x + swiglu_ffn(x, g_ffn[l], w_gate_up[l], w_down[l])
    return x
```

```cpp
#include <hip/hip_runtime.h>
#include <hip/hip_cooperative_groups.h>
#include <cstdio>
#include <cstdint>
namespace cg = cooperative_groups;
namespace pg8 {
#define PG8_LAS __attribute__((address_space(3)))
typedef unsigned short bf16_t;
typedef short bf16x8 __attribute__((ext_vector_type(8)));
typedef float f32x4 __attribute__((ext_vector_type(4)));
typedef unsigned u32x4 __attribute__((ext_vector_type(4)));
constexpr int BM = 256, BK = 64, HALF = 128, HTB = HALF * BK * 2  , STAGE_BYTES = 8 * HTB, NXCD = 8, WGM = 8;

__host__ __device__ __forceinline__ int lds_byte(int r, int c) { const int st = (r >> 4) * 2 + (c >> 5), rr = r & 15, cc = c & 31, ob = rr * 64 + cc * 2; return st * 1024 + (ob ^ (((ob >> 9) & 1) << 5)); }
__host__ __device__ __forceinline__ void stage_rc(int b, int& R, int& C) { const int st = b / 1024, sb = b % 1024, swz = sb ^ (((sb >> 9) & 1) << 5); R = (st >> 1) * 16 + swz / 64; C = (st & 1) * 32 + (swz % 64) / 2; }
__host__ __device__ __forceinline__ int perm32(int rho) { const int n = rho >> 4, i = rho & 15; return 8 * (i >> 2) + 4 * n + (i & 3); }

struct Unit { int pm, pn; };
struct Gemm { const bf16_t* A; const bf16_t* Bt; int M, N, K, lda, a_pn_off; };

struct StaticOrder {
    int nM, nN, nwg, G, c;
    __host__ __device__ void init(int M, int N, int G_, int c_) { nM = M / BM; nN = N / BM; nwg = nM * nN; G = G_; c = c_; }
    __host__ __device__ bool next(int i, Unit& u) const {
        const long L = (long)i * G + c; if (L >= nwg) return false;
        int wgid = (int)L; { const int q = nwg / NXCD, r = nwg % NXCD, xcd = wgid % NXCD, off = wgid / NXCD; wgid = (xcd < r ? xcd * (q + 1) : r * (q + 1) + (xcd - r) * q) + off; }
        const int nig = WGM * nN, gid = wgid / nig, fm = gid * WGM, gsz = (nM - fm) < WGM ? (nM - fm) : WGM;
        u.pm = fm + ((wgid % nig) % gsz); u.pn = (wgid % nig) / gsz; return true;
    }
    __device__ __forceinline__ void a_ready(const Unit&) const {}
    __device__ __forceinline__ void done(const Unit&) const {}
};

typedef float f32x2_t __attribute__((ext_vector_type(2))); typedef __bf16 bf16x2_t __attribute__((ext_vector_type(2)));
__device__ __forceinline__ unsigned cvt_pk_bf16(float lo, float hi) { const f32x2_t v = {lo, hi}; const bf16x2_t b = __builtin_convertvector(v, bf16x2_t); return __builtin_bit_cast(unsigned, b); }
__device__ __forceinline__ float fsigmoid(float x) { return __builtin_amdgcn_rcpf(1.0f + __expf(-x)); }
__device__ __forceinline__ float bflo(unsigned u) { return __uint_as_float(u << 16); }
__device__ __forceinline__ float bfhi(unsigned u) { return __uint_as_float(u & 0xffff0000u); }

struct EpiProj {
    static constexpr bool PERM = true, AFTER_DRAIN = false;
    bf16_t* O; int ldc;
    __device__ __forceinline__ void operator()(const f32x4 (&acc)[2][2][4][2], const Unit& u, int wr, int wc, int fr, int fq) const {
        const bool sg = (u.pn >= 12 && u.pn < 16) || (u.pn >= 32);
        const int row0 = u.pm * BM + wr * 64 + fr, col0 = u.pn * BM + wc * 32 + 8 * fq;
#pragma unroll
        for (int ai = 0; ai < 2; ++ai)
#pragma unroll
            for (int m = 0; m < 4; ++m) { bf16_t* rowp = O + (size_t)(row0 + ai * HALF + m * 16) * ldc + col0;
#pragma unroll
                for (int bj = 0; bj < 2; ++bj) { f32x4 v0 = acc[ai][bj][m][0], v1 = acc[ai][bj][m][1];
                    if (sg) {
#pragma unroll
                        for (int i = 0; i < 4; ++i) { v0[i] = fsigmoid(v0[i]); v1[i] = fsigmoid(v1[i]); } }
                    u32x4 w; w.x = cvt_pk_bf16(v0[0], v0[1]); w.y = cvt_pk_bf16(v0[2], v0[3]); w.z = cvt_pk_bf16(v1[0], v1[1]); w.w = cvt_pk_bf16(v1[2], v1[3]);
                    *(u32x4*)(rowp + bj * HALF) = w; } }
    }
};
struct EpiMerge {
    static constexpr bool PERM = true, AFTER_DRAIN = false;
    bf16_t* O; const bf16_t* Gt; int ld; int first;
    __device__ __forceinline__ void operator()(const f32x4 (&acc)[2][2][4][2], const Unit& u, int wr, int wc, int fr, int fq) const {
        const int row0 = u.pm * BM + wr * 64 + fr, col0 = u.pn * BM + wc * 32 + 8 * fq;
#pragma unroll
        for (int ai = 0; ai < 2; ++ai) {
            u32x4 gv[4][2], pv[4][2];
#pragma unroll
            for (int m = 0; m < 4; ++m)
#pragma unroll
                for (int bj = 0; bj < 2; ++bj) { const size_t ro = (size_t)(row0 + ai * HALF + m * 16) * ld + col0 + bj * HALF;
                    gv[m][bj] = *(const u32x4*)(Gt + ro); pv[m][bj] = first ? (u32x4){0u, 0u, 0u, 0u} : *(const u32x4*)(O + ro); }
#pragma unroll
            for (int m = 0; m < 4; ++m)
#pragma unroll
                for (int bj = 0; bj < 2; ++bj) { const size_t ro = (size_t)(row0 + ai * HALF + m * 16) * ld + col0 + bj * HALF;
                    const f32x4 v0 = acc[ai][bj][m][0], v1 = acc[ai][bj][m][1]; const u32x4 g4 = gv[m][bj], p4 = pv[m][bj];
                    float o[8];
                    o[0] = v0[0] * bflo(g4.x) + bflo(p4.x); o[1] = v0[1] * bfhi(g4.x) + bfhi(p4.x); o[2] = v0[2] * bflo(g4.y) + bflo(p4.y); o[3] = v0[3] * bfhi(g4.y) + bfhi(p4.y);
                    o[4] = v1[0] * bflo(g4.z) + bflo(p4.z); o[5] = v1[1] * bfhi(g4.z) + bfhi(p4.z); o[6] = v1[2] * bflo(g4.w) + bflo(p4.w); o[7] = v1[3] * bfhi(g4.w) + bfhi(p4.w);
                    u32x4 w; w.x = cvt_pk_bf16(o[0], o[1]); w.y = cvt_pk_bf16(o[2], o[3]); w.z = cvt_pk_bf16(o[4], o[5]); w.w = cvt_pk_bf16(o[6], o[7]);
                    *(u32x4*)(O + ro) = w; }
        }
    }
};
struct EpiResid {
    static constexpr bool PERM = false, AFTER_DRAIN = false;
    const float* base; float* out; int ldc;
    __device__ __forceinline__ void operator()(const f32x4 (&acc)[2][2][4][2], const Unit& u, int wr, int wc, int fr, int fq) const {
        const int row0 = u.pm * BM + wr * 64 + fr, col0 = u.pn * BM + wc * 32 + 4 * fq;
#pragma unroll
        for (int ai = 0; ai < 2; ++ai) {
            f32x4 b[4][2][2];
#pragma unroll
            for (int m = 0; m < 4; ++m) { const size_t off = (size_t)(row0 + ai * HALF + m * 16) * ldc + col0;
#pragma unroll
                for (int bj = 0; bj < 2; ++bj)
#pragma unroll
                    for (int n = 0; n < 2; ++n) b[m][bj][n] = *(const f32x4*)(base + off + bj * HALF + n * 16); }
#pragma unroll
            for (int m = 0; m < 4; ++m) { const size_t off = (size_t)(row0 + ai * HALF + m * 16) * ldc + col0;
#pragma unroll
                for (int bj = 0; bj < 2; ++bj)
#pragma unroll
                    for (int n = 0; n < 2; ++n) *(f32x4*)(out + off + bj * HALF + n * 16) = b[m][bj][n] + acc[ai][bj][m][n]; }
        }
    }
};
struct EpiSwiGLU {
    static constexpr bool PERM = true, AFTER_DRAIN = false;
    bf16_t* O; int ldc;
    __device__ __forceinline__ void operator()(const f32x4 (&acc)[2][2][4][2], const Unit& u, int wr, int wc, int fr, int fq) const {
        const int row0 = u.pm * BM + wr * 64 + fr, col0 = u.pn * HALF + wc * 32 + 8 * fq;
#pragma unroll
        for (int ai = 0; ai < 2; ++ai)
#pragma unroll
            for (int m = 0; m < 4; ++m) { bf16_t* rowp = O + (size_t)(row0 + ai * HALF + m * 16) * ldc + col0;
                float o[8];
#pragma unroll
                for (int n = 0; n < 2; ++n)
#pragma unroll
                    for (int i = 0; i < 4; ++i) { const float gt = acc[ai][0][m][n][i], up = acc[ai][1][m][n][i]; o[n * 4 + i] = gt * fsigmoid(gt) * up; }
                u32x4 w; w.x = cvt_pk_bf16(o[0], o[1]); w.y = cvt_pk_bf16(o[2], o[3]); w.z = cvt_pk_bf16(o[4], o[5]); w.w = cvt_pk_bf16(o[6], o[7]);
                *(u32x4*)rowp = w; }
    }
};
template <class Epi, class Sched, bool ALIGN_EPI = false, bool SP2 = false>
__device__ __forceinline__ void gemm_phase(PG8_LAS unsigned char* lds, const Gemm g, const Sched& S, const Epi& E) {
    int tid_ = threadIdx.x; asm volatile("" : "+v"(tid_)); const int tid = tid_, wid = __builtin_amdgcn_readfirstlane(tid >> 6), lane = tid & 63, wr = wid >> 2, wc = wid & 3, fr = lane & 15, fq = lane >> 4;
    const int K = g.K, nt = K / BK;
    unsigned voffA[2], voffB[2];
#pragma unroll
    for (int i = 0; i < 2; ++i) { int R, C; stage_rc(tid * 16 + i * 8192, R, C); const int Rb = Epi::PERM ? ((R & ~31) + perm32(R & 31)) : R;
        voffA[i] = (unsigned)(R * g.lda + C) * 2u; voffB[i] = (unsigned)(Rb * K + C) * 2u; }
    const size_t kstep = (size_t)(BK * 2);
    const size_t hstepA = (size_t)HALF * g.lda * 2, hstepB = (size_t)HALF * K * 2;
    const size_t tstepA = 2 * hstepA, tstepB = 2 * hstepB, pnoffA = (size_t)g.a_pn_off * 2;
    const unsigned ldsw = (unsigned)wid * 1024u;
    const int aoff = lds_byte(wr * 64 + fr, fq * 8), boff = lds_byte(wc * 32 + fr, fq * 8);
#define PG8_SA(b, h) (((b) * 2 + (h)) * HTB)
#define PG8_SB(b, h) ((4 + (b) * 2 + (h)) * HTB)
#define PG8_STAGE(bufoff, gbase, voff) do { _Pragma("unroll") for (int _i = 0; _i < 2; ++_i) \
        __builtin_amdgcn_global_load_lds((const unsigned*)((const char*)(gbase) + (voff)[_i]), (PG8_LAS unsigned*)(lds + (bufoff) + ldsw + _i * 8192), 16, 0, 0); } while (0)
#define PG8_LDA(dst, b, h) do { _Pragma("unroll") for (int m = 0; m < 4; ++m) _Pragma("unroll") for (int k = 0; k < 2; ++k) dst[m][k] = *(const PG8_LAS bf16x8*)(lds + PG8_SA(b, h) + aoff + m * 2048 + k * 1024); } while (0)
#define PG8_LDB(dst, b, h) do { _Pragma("unroll") for (int n = 0; n < 2; ++n) _Pragma("unroll") for (int k = 0; k < 2; ++k) dst[n][k] = *(const PG8_LAS bf16x8*)(lds + PG8_SB(b, h) + boff + n * 2048 + k * 1024); } while (0)
#define PG8_MMA(ai, bj, At, Bt) do { __builtin_amdgcn_s_setprio(1); _Pragma("unroll") for (int m = 0; m < 4; ++m) _Pragma("unroll") for (int n = 0; n < 2; ++n) _Pragma("unroll") for (int k = 0; k < 2; ++k) \
        acc[ai][bj][m][n] = __builtin_amdgcn_mfma_f32_16x16x32_bf16(Bt[n][k], At[m][k], acc[ai][bj][m][n], 0, 0, 0); __builtin_amdgcn_s_setprio(0); } while (0)
#define PG8_WAIT_V(n) asm volatile("s_waitcnt vmcnt(" #n ")" ::: "memory")
#define PG8_WAIT_L(n) asm volatile("s_waitcnt lgkmcnt(" #n ")" ::: "memory")
#define PG8_BAR __builtin_amdgcn_s_barrier()
#define PG8_SCHED __builtin_amdgcn_sched_barrier(0)
    Unit cur, nxt; int ui = 0;
    if (!S.next(0, cur)) return;
    f32x4 acc[2][2][4][2];
#pragma unroll
    for (int a = 0; a < 2; ++a)
#pragma unroll
        for (int b = 0; b < 2; ++b)
#pragma unroll
            for (int m = 0; m < 4; ++m)
#pragma unroll
                for (int n = 0; n < 2; ++n) acc[a][b][m][n] = (f32x4){0.f, 0.f, 0.f, 0.f};
    bf16x8 At[4][2], B0[2][2], B1[2][2];
    const char* cA = (const char*)g.A + (size_t)cur.pm * tstepA + (size_t)cur.pn * pnoffA; const char* cB = (const char*)g.Bt + (size_t)cur.pn * tstepB;
    S.a_ready(cur);
    if constexpr (SP2) {
        PG8_STAGE(PG8_SB(0, 0), cB, voffB); PG8_STAGE(PG8_SB(0, 1), cB + hstepB, voffB); PG8_STAGE(PG8_SA(0, 0), cA, voffA); PG8_STAGE(PG8_SA(0, 1), cA + hstepA, voffA);
        if (wr == 1) PG8_BAR;
        PG8_WAIT_V(2); PG8_BAR;
        PG8_STAGE(PG8_SB(1, 0), cB + kstep, voffB); PG8_STAGE(PG8_SA(1, 0), cA + kstep, voffA); PG8_STAGE(PG8_SB(1, 1), cB + hstepB + kstep, voffB);
        PG8_WAIT_V(6); PG8_BAR;
    } else {
        PG8_STAGE(PG8_SB(0, 0), cB, voffB); PG8_STAGE(PG8_SA(0, 0), cA, voffA); PG8_STAGE(PG8_SB(0, 1), cB + hstepB, voffB); PG8_STAGE(PG8_SA(0, 1), cA + hstepA, voffA);
        if (wr == 1) PG8_BAR;
        PG8_WAIT_V(4); PG8_BAR;
        PG8_STAGE(PG8_SB(1, 0), cB + kstep, voffB); PG8_STAGE(PG8_SA(1, 0), cA + kstep, voffA); PG8_STAGE(PG8_SB(1, 1), cB + hstepB + kstep, voffB);
        PG8_WAIT_V(6); PG8_BAR;
    }
    for (;;) {
        const bool has_next = S.next(ui + 1, nxt);
        const char* nA = has_next ? (const char*)g.A + (size_t)nxt.pm * tstepA + (size_t)nxt.pn * pnoffA : cA; const char* nB = has_next ? (const char*)g.Bt + (size_t)nxt.pn * tstepB : cB;
        for (int t = 0; t < nt; t += 2) {
            const bool last = (t == nt - 2);
            const char* a1 = cA + (size_t)(t + 1) * kstep;
            const char* a2 = last ? nA : cA + (size_t)(t + 2) * kstep; const char* b2 = last ? nB : cB + (size_t)(t + 2) * kstep;
            const char* a3 = a2 + kstep; const char* b3 = b2 + kstep;
            if (last && has_next) S.a_ready(nxt);
            if constexpr (SP2) {
            PG8_LDB(B0, 0, 0); PG8_LDB(B1, 0, 1); PG8_SCHED; PG8_LDA(At, 0, 0); PG8_STAGE(PG8_SA(1, 1), a1 + hstepA, voffA);
            PG8_WAIT_V(8); PG8_WAIT_L(0); PG8_BAR; PG8_MMA(0, 0, At, B0); PG8_MMA(0, 1, At, B1); PG8_BAR; PG8_SCHED;
            PG8_LDA(At, 0, 1); PG8_STAGE(PG8_SB(0, 0), b2, voffB); PG8_STAGE(PG8_SB(0, 1), b2 + hstepB, voffB); PG8_STAGE(PG8_SA(0, 0), a2, voffA);
            PG8_WAIT_V(8); PG8_WAIT_L(0); PG8_BAR; PG8_MMA(1, 0, At, B0); PG8_MMA(1, 1, At, B1); PG8_BAR; PG8_SCHED;
            PG8_LDB(B0, 1, 0); PG8_LDB(B1, 1, 1); PG8_SCHED; PG8_LDA(At, 1, 0); PG8_STAGE(PG8_SA(0, 1), a2 + hstepA, voffA);
            PG8_WAIT_V(8); PG8_WAIT_L(0); PG8_BAR; PG8_MMA(0, 0, At, B0); PG8_MMA(0, 1, At, B1); PG8_BAR; PG8_SCHED;
            PG8_LDA(At, 1, 1); PG8_STAGE(PG8_SB(1, 0), b3, voffB); PG8_STAGE(PG8_SB(1, 1), b3 + hstepB, voffB); PG8_STAGE(PG8_SA(1, 0), a3, voffA);
            PG8_WAIT_V(8); PG8_WAIT_L(0); PG8_BAR; PG8_MMA(1, 0, At, B0); PG8_MMA(1, 1, At, B1); PG8_BAR; PG8_SCHED;
            } else {
            PG8_LDB(B0, 0, 0); PG8_SCHED; PG8_LDA(At, 0, 0); PG8_STAGE(PG8_SA(1, 1), a1 + hstepA, voffA);
            PG8_WAIT_L(8); PG8_BAR; PG8_WAIT_L(0); PG8_MMA(0, 0, At, B0); PG8_BAR; PG8_SCHED;
            PG8_LDB(B1, 0, 1); PG8_STAGE(PG8_SB(0, 0), b2, voffB);
            PG8_BAR; PG8_WAIT_L(0); PG8_MMA(0, 1, At, B1); PG8_BAR;
            PG8_LDA(At, 0, 1); PG8_STAGE(PG8_SA(0, 0), a2, voffA);
            PG8_BAR; PG8_WAIT_L(0); PG8_MMA(1, 0, At, B0); PG8_BAR; PG8_SCHED;
            PG8_STAGE(PG8_SB(0, 1), b2 + hstepB, voffB);
            PG8_WAIT_V(6); PG8_BAR; PG8_MMA(1, 1, At, B1); PG8_BAR;
            PG8_LDB(B0, 1, 0); PG8_SCHED; PG8_LDA(At, 1, 0); PG8_STAGE(PG8_SA(0, 1), a2 + hstepA, voffA);
            PG8_WAIT_L(8); PG8_BAR; PG8_WAIT_L(0); PG8_MMA(0, 0, At, B0); PG8_BAR; PG8_SCHED;
            PG8_LDB(B1, 1, 1); PG8_STAGE(PG8_SB(1, 0), b3, voffB);
            PG8_BAR; PG8_WAIT_L(0); PG8_MMA(0, 1, At, B1); PG8_BAR;
            PG8_LDA(At, 1, 1); PG8_STAGE(PG8_SA(1, 0), a3, voffA);
            PG8_BAR; PG8_WAIT_L(0); PG8_MMA(1, 0, At, B0); PG8_BAR; PG8_SCHED;
            PG8_STAGE(PG8_SB(1, 1), b3 + hstepB, voffB);
            PG8_WAIT_V(6); PG8_BAR; PG8_MMA(1, 1, At, B1); PG8_BAR;
            }
        }
        if constexpr (ALIGN_EPI) { if (wr == 0) PG8_BAR; }
        if constexpr (!Epi::AFTER_DRAIN) { E(acc, cur, wr, wc, fr, fq); S.done(cur); }
        if (!has_next) break;
#pragma unroll
        for (int a = 0; a < 2; ++a)
#pragma unroll
            for (int b = 0; b < 2; ++b)
#pragma unroll
                for (int m = 0; m < 4; ++m)
#pragma unroll
                    for (int n = 0; n < 2; ++n) acc[a][b][m][n] = (f32x4){0.f, 0.f, 0.f, 0.f};
        cur = nxt; cA = nA; cB = nB; ++ui;
        if constexpr (ALIGN_EPI) { if (wr == 1) PG8_BAR; }
    }
    PG8_WAIT_V(0);
    if constexpr (!ALIGN_EPI) { if (wr == 0) PG8_BAR; }
    PG8_BAR;
    if constexpr (Epi::AFTER_DRAIN) { E.fused(acc, cur, wr, wc, fr, fq, lds, wid, lane); S.done(cur); }
#undef PG8_SA
#undef PG8_SB
#undef PG8_STAGE
#undef PG8_LDA
#undef PG8_LDB
#undef PG8_MMA
#undef PG8_WAIT_V
#undef PG8_WAIT_L
#undef PG8_BAR
#undef PG8_SCHED
}
}

#define LAS __attribute__((address_space(3)))
typedef unsigned short bf16_t;
typedef short bf16x8 __attribute__((ext_vector_type(8)));
typedef short s16x4 __attribute__((ext_vector_type(4)));
typedef float f32x4 __attribute__((ext_vector_type(4)));
typedef unsigned u32x4 __attribute__((ext_vector_type(4)));
typedef unsigned u32x2 __attribute__((ext_vector_type(2)));
using pg8::cvt_pk_bf16; using pg8::bflo; using pg8::bfhi; using pg8::fsigmoid;

constexpr int DM = 1024, NBATCH = 8, SEQ = 4096, TT = NBATCH * SEQ, NIN = 11272, NP = 11264, FF = 2816;
constexpr int GB = 4, TG = GB * SEQ, NGRP = NBATCH / GB;
constexpr int NBH = GB * 4;
constexpr int LDS_BYTES = 147456;
constexpr int NTHR = 512;
constexpr int C_MQ = 0, C_MK = 1024, C_MV = 2048, C_MO = 3072, C_PU = 4096, C_AQ = 5120, C_AK = 6144, C_AV = 7168, C_GT = 8192;
constexpr size_t MiB = 1u << 20;
constexpr size_t WS_ROPE = 1 * MiB;
constexpr size_t WS_WIN = 2 * MiB, WS_WMO = 24 * MiB, WS_WPOOL = 26 * MiB, WS_WDIFF = 27 * MiB, WS_WOUT = 29 * MiB, WS_WGU = 31 * MiB, WS_WDN = 42 * MiB;
constexpr size_t WS_GIF = 48 * MiB;
constexpr size_t WS_MV = 48 * MiB + 512 * 1024;
constexpr size_t WS_NST = 49 * MiB;
constexpr size_t WS_HN = 50 * MiB;
constexpr size_t WS_CST = 82 * MiB;
constexpr size_t WS_PROJ = 146 * MiB;
constexpr size_t WS_END = 498 * MiB;

__device__ __forceinline__ int my_tid() { int t = threadIdx.x; asm volatile("" : "+v"(t)); return t; }
__device__ __forceinline__ float wave_sum(float v) {
#pragma unroll
    for (int o = 1; o < 64; o <<= 1) v += __shfl_xor(v, o);
    return v;
}
__device__ __forceinline__ float wave_max(float v) {
#pragma unroll
    for (int o = 1; o < 64; o <<= 1) v = fmaxf(v, __shfl_xor(v, o));
    return v;
}
typedef short v4i16_t __attribute__((ext_vector_type(4)));
__device__ __forceinline__ s16x4 vtr(const LAS char* p) { return __builtin_bit_cast(s16x4, __builtin_amdgcn_ds_read_tr16_b64_v4i16((LAS v4i16_t*)p)); }
__device__ __forceinline__ bf16x8 trfrag(const LAS char* base, int pitch, int k0, int n0, int lane) {
    const int g = lane >> 4, q = (lane & 15) >> 2, p = lane & 3;
    const LAS char* a = base + (k0 + 4 * g + q) * pitch + (n0 + 4 * p) * 2;
    const s16x4 lo = vtr(a), hi = vtr(a + 16 * pitch);
    return (bf16x8){lo[0], lo[1], lo[2], lo[3], hi[0], hi[1], hi[2], hi[3]};
}
__device__ __forceinline__ bf16x8 rowfrag(const LAS char* base, int pitch, int r0, int c0, int lane) {
    return *(const LAS bf16x8*)(base + (r0 + (lane & 15)) * pitch + (c0 + 8 * (lane >> 4)) * 2);
}
__device__ __forceinline__ bf16x8 rowfrag_perm(const LAS char* base, int pitch, int r0, int c0, int lane) {
    const LAS char* a = base + (r0 + (lane & 15)) * pitch + (c0 + 4 * (lane >> 4)) * 2;
    const s16x4 lo = *(const LAS s16x4*)a, hi = *(const LAS s16x4*)(a + 32);
    return (bf16x8){lo[0], lo[1], lo[2], lo[3], hi[0], hi[1], hi[2], hi[3]};
}
__device__ __forceinline__ f32x4 mfma16(bf16x8 a, bf16x8 b, f32x4 c) { return __builtin_amdgcn_mfma_f32_16x16x32_bf16(a, b, c, 0, 0, 0); }
__device__ __forceinline__ void unpack8(const u32x4 v, float (&f)[8]) {
    f[0] = bflo(v.x); f[1] = bfhi(v.x); f[2] = bflo(v.y); f[3] = bfhi(v.y); f[4] = bflo(v.z); f[5] = bfhi(v.z); f[6] = bflo(v.w); f[7] = bfhi(v.w);
}
__device__ __forceinline__ u32x4 pack8(const float (&f)[8]) {
    u32x4 w; w.x = cvt_pk_bf16(f[0], f[1]); w.y = cvt_pk_bf16(f[2], f[3]); w.z = cvt_pk_bf16(f[4], f[5]); w.w = cvt_pk_bf16(f[6], f[7]); return w;
}
#define LDS_WAIT() asm volatile("s_waitcnt lgkmcnt(0)" ::: "memory")
#define BAR_LDS() do { asm volatile("s_waitcnt lgkmcnt(0)" ::: "memory"); __builtin_amdgcn_s_barrier(); asm volatile("" ::: "memory"); } while (0)

struct Args { const float* in[16]; float* out; unsigned char* ws; int ph_lo, ph_hi; };
#define XB_TMO      128
#define XB_XCNT(j)  (256  + 64 * (j))
#define XB_XSUB(j)  (1280 + 64 * (j))
#define XB_XGEN(j)  (2304 + 64 * (j))
#define XB_TOP      3328
#define XB_TOPGEN   3392
#define XCD_BAR_WORDS 3456
#define XB_SPIN_CAP (1u << 18)

__device__ __forceinline__ unsigned xb_ld(unsigned* p)              { return __hip_atomic_load(p, __ATOMIC_RELAXED, __HIP_MEMORY_SCOPE_AGENT); }
__device__ __forceinline__ unsigned xb_add(unsigned* p, unsigned v) { return __hip_atomic_fetch_add(p, v, __ATOMIC_RELAXED, __HIP_MEMORY_SCOPE_AGENT); }
__device__ __forceinline__ unsigned xb_xcc_id() { return (unsigned)__builtin_amdgcn_s_getreg((3 << 11) | 20) & 0xFu; }
#define XB_SPIN(cond, bar) do { unsigned _sp = 0; while (cond) { __builtin_amdgcn_s_sleep(1); \
    if ((++_sp & 255u) == 0u) { if (xb_ld(&(bar)[XB_TMO])) break; if (_sp > XB_SPIN_CAP) { atomicAdd(&(bar)[XB_TMO], 1u); break; } } } } while (0)

struct XcdBarrier {
    unsigned* bar; unsigned x;
    volatile LAS unsigned* st;
};

__device__ __forceinline__ XcdBarrier xcd_barrier_post(unsigned* bar, volatile LAS unsigned* st) {
    XcdBarrier b; b.bar = bar; b.x = xb_xcc_id(); b.st = st;
    if (threadIdx.x == 0) (void)xb_add(&bar[XB_XCNT(b.x)], 1u);
    return b;
}
__device__ __forceinline__ void xcd_barrier_complete(unsigned* bar, unsigned x, unsigned& nloc, unsigned& nx) {
    const unsigned G = gridDim.x * gridDim.y * gridDim.z;
    unsigned sum, cnt, mine, sp = 0u;
    for (;;) {
        sum = 0u; cnt = 0u; mine = 0u;
#pragma unroll
        for (unsigned j = 0; j < 16; ++j) { const unsigned c = xb_ld(&bar[XB_XCNT(j)]); sum += c; cnt += (c > 0u) ? 1u : 0u; mine = (j == x) ? c : mine; }
        if (sum == G) break;
        __builtin_amdgcn_s_sleep(1);
        if ((++sp & 255u) == 0u) { if (xb_ld(&bar[XB_TMO])) break; if (sp > XB_SPIN_CAP) { atomicAdd(&bar[XB_TMO], 1u); break; } }
    }
    nloc = mine > 0u ? mine : 1u; nx = cnt > 0u ? cnt : 1u;
}

__device__ __forceinline__ void xcd_barrier(const XcdBarrier& b) {
    asm volatile("s_waitcnt vmcnt(0)" ::: "memory");
    __syncthreads();
    if (threadIdx.x == 0) {
        unsigned* bar = b.bar;
        __builtin_amdgcn_s_waitcnt(0);
        unsigned nloc = b.st[0], nx = b.st[1];
        if (nloc == 0u) { xcd_barrier_complete(bar, b.x, nloc, nx); b.st[0] = nloc; b.st[1] = nx; }
        const unsigned old = xb_add(&bar[XB_XSUB(b.x)], 1u);
        const unsigned gen = old / nloc;
        if (old + 1u == (gen + 1u) * nloc) {
            __builtin_amdgcn_fence(__ATOMIC_RELEASE, "agent");
            asm volatile("s_waitcnt vmcnt(0)" ::: "memory");
            const unsigned og = xb_add(&bar[XB_TOP], 1u);
            const unsigned tg = og / nx;
            if (og + 1u == (tg + 1u) * nx) xb_add(&bar[XB_TOPGEN], 1u);
            else XB_SPIN(xb_ld(&bar[XB_TOPGEN]) == tg, bar);
            __builtin_amdgcn_fence(__ATOMIC_ACQUIRE, "agent");
            xb_add(&bar[XB_XGEN(b.x)], 1u);
            asm volatile("s_waitcnt vmcnt(0)" ::: "memory");
        } else {
            XB_SPIN(xb_ld(&bar[XB_XGEN(b.x)]) == gen, bar);
            __builtin_amdgcn_fence(__ATOMIC_ACQUIRE, "agent");
            asm volatile("s_waitcnt vmcnt(0)" ::: "memory");
        }
    }
    __syncthreads();
}


__device__ __forceinline__ void cvt_item(const float* W, int ldw, int k0, int srccol0, bf16_t* WT, int K, int dstrow0, const float* rowscale, LAS float* scr, int lane) {
    float wv[32];
#pragma unroll
    for (int i = 0; i < 32; ++i) { const int kk = 2 * i + (lane >> 5); wv[i] = W[(size_t)(k0 + kk) * ldw + srccol0 + (lane & 31)]; }
#pragma unroll
    for (int i = 0; i < 32; ++i) { const int kk = 2 * i + (lane >> 5); scr[kk * 33 + (lane & 31)] = wv[i]; }
    LDS_WAIT();
    const int c = lane & 7;
#pragma unroll
    for (int j = 0; j < 4; ++j) { const int n = (lane >> 3) + 8 * j; const LAS float* s = scr + (8 * c) * 33 + n;
        const float sc = rowscale ? rowscale[n] : 1.0f;
        u32x4 o; o.x = cvt_pk_bf16(s[0 * 33] * sc, s[1 * 33] * sc); o.y = cvt_pk_bf16(s[2 * 33] * sc, s[3 * 33] * sc); o.z = cvt_pk_bf16(s[4 * 33] * sc, s[5 * 33] * sc); o.w = cvt_pk_bf16(s[6 * 33] * sc, s[7 * 33] * sc);
        *(u32x4*)(WT + (size_t)(dstrow0 + n) * K + k0 + 8 * c) = o; }
    LDS_WAIT();
}
__device__ __forceinline__ void phase_weights(const Args& a, int l, LAS unsigned char* lds) {
    const int tid = my_tid(), lane = tid & 63, wave = tid >> 6;
    LAS float* scr = (LAS float*)(lds + wave * 8704);
    const int gw = blockIdx.x * 8 + wave, NGW = gridDim.x * 8;
    unsigned char* ws = a.ws;
    const float* w_in = a.in[2] + (size_t)l * DM * NIN;
    const float* w_mo = a.in[5] + (size_t)l * DM * DM;
    const float* w_pool = a.in[6] + (size_t)l * 4 * 256 * 256;
    const float* pscale = a.in[7] + (size_t)l * DM;
    const float* w_diff = a.in[11] + (size_t)l * DM * DM;
    const float* w_out = a.in[12] + (size_t)l * DM * DM;
    const float* w_gu = a.in[14] + (size_t)l * DM * 2 * FF;
    const float* w_dn = a.in[15] + (size_t)l * FF * DM;
    constexpr int I0 = 16 * (NP / 32), I1 = 16 * 32, I2 = 4 * 4 * 8, I3 = I1, I4 = I1, I5 = 16 * (2 * FF / 32), I6 = (FF / 64) * 32;
    constexpr int NIT = I0 + I1 + I2 + I3 + I4 + I5 + I6;
    for (int it = gw; it < NIT; it += NGW) {
        int r = it;
        if (r < I0) { const int nb = r % (NP / 32), kb = r / (NP / 32), n0 = nb * 32; cvt_item(w_in, NIN, kb * 64, n0 < 4096 ? n0 : n0 + 8, (bf16_t*)(ws + WS_WIN), DM, n0, nullptr, scr, lane); continue; } r -= I0;
        if (r < I1) { const int nb = r % 32, kb = r / 32; cvt_item(w_mo, DM, kb * 64, nb * 32, (bf16_t*)(ws + WS_WMO), DM, nb * 32, nullptr, scr, lane); continue; } r -= I1;
        if (r < I2) { const int g = r / 32, q = r % 32, nb = q % 8, kb = q / 8; cvt_item(w_pool + g * 65536, 256, kb * 64, nb * 32, (bf16_t*)(ws + WS_WPOOL), 256, g * 256 + nb * 32, pscale + g * 256 + nb * 32, scr, lane); continue; } r -= I2;
        if (r < I3) { const int nb = r % 32, kb = r / 32; cvt_item(w_diff, DM, kb * 64, nb * 32, (bf16_t*)(ws + WS_WDIFF), DM, nb * 32, nullptr, scr, lane); continue; } r -= I3;
        if (r < I4) { const int nb = r % 32, kb = r / 32; cvt_item(w_out, DM, kb * 64, nb * 32, (bf16_t*)(ws + WS_WOUT), DM, nb * 32, nullptr, scr, lane); continue; } r -= I4;
        if (r < I5) { const int nb = r % (2 * FF / 32), kb = r / (2 * FF / 32), n0 = nb * 32, pn = n0 >> 8, wi = n0 & 255;
            const int sc0 = wi < 128 ? 128 * pn + wi : FF + 128 * pn + (wi - 128);
            cvt_item(w_gu, 2 * FF, kb * 64, sc0, (bf16_t*)(ws + WS_WGU), DM, n0, nullptr, scr, lane); continue; } r -= I5;
        { const int nb = r % 32, kb = r / 32; cvt_item(w_dn, DM, kb * 64, nb * 32, (bf16_t*)(ws + WS_WDN), FF, nb * 32, nullptr, scr, lane); }
    }
    if (l == 0) {
        float2* tab = (float2*)(ws + WS_ROPE);
        for (int e = blockIdx.x * NTHR + tid; e < SEQ * 32; e += gridDim.x * NTHR) {
            const int pos = e >> 5, i = e & 31;
            double inv = 1.0; const double rr = 0.74989420933245582730;
            for (int j = 0; j < i; ++j) inv *= rr;
            const double t2 = inv * inv; double cs = 1.0, sn = inv, tc = 1.0, tsn = inv;
#pragma unroll
            for (int n = 1; n <= 12; ++n) { tc *= -t2 / (double)((2 * n - 1) * (2 * n)); cs += tc; tsn *= -t2 / (double)((2 * n) * (2 * n + 1)); sn += tsn; }
            double zr = 1.0, zi = 0.0, br = cs, bi = sn;
            for (int b = 0; b < 12; ++b) { if ((pos >> b) & 1) { const double nr = zr * br - zi * bi, ni = zr * bi + zi * br; zr = nr; zi = ni; } const double sr = br * br - bi * bi, si = 2.0 * br * bi; br = sr; bi = si; }
            tab[e] = make_float2((float)zr, (float)zi);
        }
    }
}

template <bool GATES>
__device__ __forceinline__ void phase_norm(const float* x, const float* gain, bf16_t* hn, int nrows, const float* w_in_l, const float* bif, float* gif, LAS unsigned char* lds) {
    const int tid = my_tid(), lane = tid & 63, wave = tid >> 6;
    LAS float* wif = (LAS float*)lds;
    f32x4 wr[GATES ? 8 : 1][4];
    if (GATES) {
        float wt[16];
#pragma unroll
        for (int i = 0; i < 16; ++i) { const int idx = tid + NTHR * i, k = idx >> 3, e = idx & 7; wt[i] = w_in_l[(size_t)k * NIN + 4096 + e]; }
#pragma unroll
        for (int i = 0; i < 16; ++i) { const int idx = tid + NTHR * i, k = idx >> 3, e = idx & 7; wif[e * 1024 + k] = wt[i]; }
        __syncthreads();
#pragma unroll
        for (int e = 0; e < 8; ++e)
#pragma unroll
            for (int j = 0; j < 4; ++j) wr[e][j] = *(const LAS f32x4*)(wif + e * 1024 + 4 * lane + 256 * j);
    }
    const int gw = blockIdx.x * 8 + wave, NGW = gridDim.x * 8;
    f32x4 gv[4];
#pragma unroll
    for (int j = 0; j < 4; ++j) gv[j] = *(const f32x4*)(gain + 4 * lane + 256 * j);
    f32x4 v[4], nx[4];
    if (gw < nrows) { const f32x4* xr = (const f32x4*)(x + (size_t)gw * DM) + lane;
#pragma unroll
        for (int j = 0; j < 4; ++j) nx[j] = xr[64 * j]; }
    for (int row = gw; row < nrows; row += NGW) {
        float ss = 0.f;
#pragma unroll
        for (int j = 0; j < 4; ++j) v[j] = nx[j];
        if (row + NGW < nrows) { const f32x4* xr = (const f32x4*)(x + (size_t)(row + NGW) * DM) + lane;
#pragma unroll
            for (int j = 0; j < 4; ++j) nx[j] = xr[64 * j]; }
#pragma unroll
        for (int j = 0; j < 4; ++j) ss += (v[j].x * v[j].x + v[j].y * v[j].y) + (v[j].z * v[j].z + v[j].w * v[j].w);
        const float rstd = 1.0f / sqrtf(wave_sum(ss) * (1.0f / DM) + 1e-6f);
        u32x2* o8 = (u32x2*)(hn + (size_t)row * DM) + lane;
#pragma unroll
        for (int j = 0; j < 4; ++j) { v[j] = v[j] * rstd * gv[j]; u32x2 w; w.x = cvt_pk_bf16(v[j].x, v[j].y); w.y = cvt_pk_bf16(v[j].z, v[j].w); o8[64 * j] = w; }
        if (GATES) {
            float ga[8];
#pragma unroll
            for (int e = 0; e < 8; ++e) { float s = 0.f;
#pragma unroll
                for (int j = 0; j < 4; ++j) { const f32x4 w = wr[e][j]; s += (v[j].x * w.x + v[j].y * w.y) + (v[j].z * w.z + v[j].w * w.w); }
                ga[e] = s; }
            float h4[4], h2[2], h1;
            { const bool up = (lane & 32) != 0;
#pragma unroll
              for (int i = 0; i < 4; ++i) { const float mine = up ? ga[4 + i] : ga[i], other = up ? ga[i] : ga[4 + i]; h4[i] = mine + __shfl_xor(other, 32); } }
            { const bool up = (lane & 16) != 0;
#pragma unroll
              for (int i = 0; i < 2; ++i) { const float mine = up ? h4[2 + i] : h4[i], other = up ? h4[i] : h4[2 + i]; h2[i] = mine + __shfl_xor(other, 16); } }
            { const bool up = (lane & 8) != 0; const float mine = up ? h2[1] : h2[0], other = up ? h2[0] : h2[1]; h1 = mine + __shfl_xor(other, 8); }
            h1 += __shfl_xor(h1, 4); h1 += __shfl_xor(h1, 2); h1 += __shfl_xor(h1, 1);
            if ((lane & 7) == 0) {
                const int e = 4 * (lane >> 5) + 2 * ((lane >> 4) & 1) + ((lane >> 3) & 1);
                const float pre = h1 + bif[e];
                gif[(size_t)row * 8 + e] = (e < 4) ? pre : (fminf(pre, 0.f) - log1pf(__expf(-fabsf(pre))));
            }
        }
    }
    __syncthreads();
}

constexpr int PIT = 544;
constexpr int XOFF = 0, YOFF = 128 * PIT, VECOFF = 2 * 128 * PIT;
__device__ __forceinline__ void load_plain(LAS char* dst, const bf16_t* src, size_t gpitch, int tid) {
#pragma unroll
    for (int i = 0; i < 8; ++i) { const int id = tid + NTHR * i, row = id >> 5, cc = id & 31;
        const u32x4 v = *(const u32x4*)(src + (size_t)row * gpitch + cc * 8);
        *(LAS u32x4*)(dst + row * PIT + cc * 16) = v; }
}
__device__ __forceinline__ void load_plain_issue(u32x4 (&pre)[8], const bf16_t* src, size_t gpitch, int tid) {
#pragma unroll
    for (int i = 0; i < 8; ++i) { const int id = tid + NTHR * i, row = id >> 5, cc = id & 31; pre[i] = *(const u32x4*)(src + (size_t)row * gpitch + cc * 8); }
}
__device__ __forceinline__ void load_plain_commit(LAS char* dst, const u32x4 (&pre)[8], int tid) {
#pragma unroll
    for (int i = 0; i < 8; ++i) { const int id = tid + NTHR * i, row = id >> 5, cc = id & 31; *(LAS u32x4*)(dst + row * PIT + cc * 16) = pre[i]; }
}
__device__ __forceinline__ void load_conv_issue(u32x4 (&rw)[11], const bf16_t* src, int pos0, int tid) {
    const int cg = tid & 31, r0 = (tid >> 5) * 8;
#pragma unroll
    for (int j = 0; j < 11; ++j) { const int rr = r0 - 3 + j;
        if (j >= 3 || pos0 + rr >= 0) rw[j] = *(const u32x4*)(src + (ptrdiff_t)rr * NP + cg * 8); else rw[j] = (u32x4){0u, 0u, 0u, 0u}; }
}
__device__ __forceinline__ void load_conv_finish(LAS char* dst, const u32x4 (&rw)[11], const float* cw  , const LAS float* rowscale, float cscale, int tid) {
    const int cg = tid & 31, r0 = (tid >> 5) * 8;
    float w[4][8];
#pragma unroll
    for (int j = 0; j < 4; ++j) { const f32x4 a = *(const f32x4*)(cw + j * 2048 + cg * 8), b = *(const f32x4*)(cw + j * 2048 + cg * 8 + 4);
        w[j][0] = a.x; w[j][1] = a.y; w[j][2] = a.z; w[j][3] = a.w; w[j][4] = b.x; w[j][5] = b.y; w[j][6] = b.z; w[j][7] = b.w; }
    float sc8[8];
#pragma unroll
    for (int r = 0; r < 8; ++r) sc8[r] = rowscale ? rowscale[r0 + r] : cscale;
    float u[3][8];
#pragma unroll
    for (int j = 0; j < 3; ++j) unpack8(rw[j], u[j]);
#pragma unroll
    for (int r = 0; r < 8; ++r) {
        float x[8]; unpack8(rw[3 + r], x);
        const float sc = sc8[r];
        float o[8];
#pragma unroll
        for (int e = 0; e < 8; ++e) { const float cv = (w[0][e] * u[0][e] + w[1][e] * u[1][e]) + (w[2][e] * u[2][e] + w[3][e] * x[e]); o[e] = cv * fsigmoid(cv) * sc;
            u[0][e] = u[1][e]; u[1][e] = u[2][e]; u[2][e] = x[e]; }
        *(LAS u32x4*)(dst + (r0 + r) * PIT + cg * 16) = pack8(o);
    }
}
__device__ __forceinline__ void load_conv(LAS char* dst, const bf16_t* src, int pos0, const float* cw, const LAS float* rowscale, float cscale, int tid) {
    u32x4 rw[11]; load_conv_issue(rw, src, pos0, tid); load_conv_finish(dst, rw, cw, rowscale, cscale, tid);
}
__device__ __forceinline__ void load_gates(LAS float* vec, const float* gif, int t0, int h, int tid) {
    LAS float* li = vec; LAS float* bc = vec + 128; LAS float* tot = vec + 256;
    const int lane = tid & 63;
    float v = 0.f;
    if (tid < 128) { const float liv = gif[(size_t)(t0 + tid) * 8 + h]; v = gif[(size_t)(t0 + tid) * 8 + 4 + h]; li[tid] = liv;
#pragma unroll
        for (int o = 1; o < 64; o <<= 1) { const float uu = __shfl_up(v, o); if (lane >= o) v += uu; }
        if (tid == 63) tot[0] = v; }
    __syncthreads();
    if (tid < 128) { if (tid >= 64) v += tot[0]; bc[tid] = v; }
}

__device__ __forceinline__ void m1_item(LAS char* lds, const bf16_t* proj, const float* gif, bf16_t* Cst, float* nst, float* gch, float* mloc, const float* convw, int bhl, int c) {
    const int tid = my_tid(), lane = tid & 63, wid = __builtin_amdgcn_readfirstlane(tid >> 6), g = lane >> 4, fr = lane & 15;
    const int bl = bhl >> 2, h = bhl & 3, item = bhl * 32 + c, t0 = bl * SEQ + c * 128;
    LAS char* X = lds + XOFF; LAS char* Y = lds + YOFF; LAS float* vec = (LAS float*)(lds + VECOFF);
    LAS float* li = vec; LAS float* bc = vec + 128; LAS float* es = vec + 272;
    load_gates(vec, gif, t0, h, tid);
    __syncthreads();
    const float gtot = bc[127];
    const float w0 = gtot - bc[lane] + li[lane], w1 = gtot - bc[lane + 64] + li[lane + 64];
    const float ml = wave_max(fmaxf(w0, w1));
    if (tid < 128) es[tid] = __expf(gtot - bc[tid] + li[tid] - ml);
    if (tid == 0) { gch[item] = gtot; mloc[item] = ml; }
    __syncthreads();
    { u32x4 pv[8]; load_plain_issue(pv, proj + (size_t)t0 * NP + C_MV + h * 256, NP, tid);
      load_conv(X, proj + (size_t)t0 * NP + C_MK + h * 256, c * 128, convw + 1024 + h * 256, es, 1.0f, tid);
      load_plain_commit(Y, pv, tid); }
    __syncthreads();
    { float sn = 0.f; const LAS char* xc = X + ((tid >> 8) * 64) * PIT + (tid & 255) * 2;
#pragma unroll 16
        for (int r = 0; r < 64; ++r) sn += __uint_as_float((unsigned)(*(const LAS unsigned short*)(xc + r * PIT)) << 16);
        vec[400 + tid] = sn; }
    bf16_t* Co = Cst + (size_t)item * 65536;
#pragma unroll 1
    for (int hk = 0; hk < 2; ++hk) {
        f32x4 acc[2][8];
#pragma unroll
        for (int i = 0; i < 2; ++i)
#pragma unroll
            for (int j = 0; j < 8; ++j) acc[i][j] = (f32x4){0.f, 0.f, 0.f, 0.f};
        const LAS char* Xh = X + hk * 256;
#pragma unroll 1
        for (int t = 0; t < 4; ++t) {
            const bf16x8 v0 = trfrag(Y, PIT, 32 * t, 16 * (2 * wid), lane), v1 = trfrag(Y, PIT, 32 * t, 16 * (2 * wid + 1), lane);
            bf16x8 kf[8];
#pragma unroll
            for (int kb = 0; kb < 8; ++kb) kf[kb] = trfrag(Xh, PIT, 32 * t, 16 * kb, lane);
            __builtin_amdgcn_sched_barrier(0);
#pragma unroll
            for (int kb = 0; kb < 8; ++kb) { acc[0][kb] = mfma16(v0, kf[kb], acc[0][kb]); acc[1][kb] = mfma16(v1, kf[kb], acc[1][kb]); }
        }
#pragma unroll
        for (int i = 0; i < 2; ++i)
#pragma unroll
            for (int kb = 0; kb < 8; ++kb) { u32x2 w; w.x = cvt_pk_bf16(acc[i][kb][0], acc[i][kb][1]); w.y = cvt_pk_bf16(acc[i][kb][2], acc[i][kb][3]);
                *(u32x2*)(Co + (size_t)(128 * hk + 16 * kb + fr) * 256 + 16 * (2 * wid + i) + 4 * g) = w; }
    }
    __syncthreads();
    if (tid < 256) nst[(size_t)item * 256 + tid] = vec[400 + tid] + vec[656 + tid];
    __syncthreads();
}

__device__ __forceinline__ void phase_scan(bf16_t* Cst, float* nst, const float* gch, const float* mloc, float* mprev) {
    const int tid = my_tid();
    for (int i = blockIdx.x * NTHR + tid; i < NBH * 8192 + NBH * 256; i += gridDim.x * NTHR) {
        if (i < NBH * 8192) {
            const int bh = i >> 13, e8 = i & 8191;
            float st[8];
#pragma unroll
            for (int e = 0; e < 8; ++e) st[e] = 0.f;
            float m = -1e30f;
            for (int c0 = 0; c0 < 32; c0 += 8) {
                u32x4 ld[8];
#pragma unroll
                for (int j = 0; j < 8; ++j) ld[j] = *(const u32x4*)(Cst + ((size_t)(bh * 32 + c0 + j) * 65536 + e8 * 8));
#pragma unroll
                for (int j = 0; j < 8; ++j) { const int c = c0 + j; const float gc = gch[bh * 32 + c], mc = mloc[bh * 32 + c];
                    const float mn = fmaxf(gc + m, mc), aa = __expf(gc + m - mn), bb = __expf(mc - mn);
                    float lc[8]; unpack8(ld[j], lc);
                    *(u32x4*)(Cst + ((size_t)(bh * 32 + c) * 65536 + e8 * 8)) = pack8(st);
#pragma unroll
                    for (int e = 0; e < 8; ++e) st[e] = aa * st[e] + bb * lc[e];
                    if (e8 == 0) mprev[bh * 32 + c] = m;
                    m = mn; }
            }
        } else {
            const int j = i - NBH * 8192, bh = j >> 8, k = j & 255;
            float st = 0.f, m = -1e30f;
            for (int c = 0; c < 32; ++c) { const float gc = gch[bh * 32 + c], mc = mloc[bh * 32 + c];
                const float mn = fmaxf(gc + m, mc), aa = __expf(gc + m - mn), bb = __expf(mc - mn);
                const size_t o = (size_t)(bh * 32 + c) * 256 + k; const float lc = nst[o]; nst[o] = st; st = aa * st + bb * lc; m = mn; }
        }
    }
}

__device__ __forceinline__ void m3_item(LAS char* lds, bf16_t* proj, const float* gif, const bf16_t* Cst, const float* nst, const float* mprev, const float* convw, int bhl, int c) {
    const int tid = my_tid(), lane = tid & 63, wid = __builtin_amdgcn_readfirstlane(tid >> 6), g = lane >> 4, fr = lane & 15;
    const int bl = bhl >> 2, h = bhl & 3, item = bhl * 32 + c, t0 = bl * SEQ + c * 128;
    LAS char* X = lds + XOFF; LAS char* Y = lds + YOFF; LAS float* vec = (LAS float*)(lds + VECOFF);
    LAS float* li = vec; LAS float* bc = vec + 128; LAS float* npv = vec + 272;
    { u32x4 rq[11], rk[11];
      load_conv_issue(rq, proj + (size_t)t0 * NP + C_MQ + h * 256, c * 128, tid);
      load_conv_issue(rk, proj + (size_t)t0 * NP + C_MK + h * 256, c * 128, tid);
      const float npl = (tid < 256) ? nst[(size_t)item * 256 + tid] : 0.f;
      load_gates(vec, gif, t0, h, tid);
      if (tid < 256) npv[tid] = npl;
      load_conv_finish(X, rq, convw + h * 256, nullptr, 0.0625f, tid);
      load_conv_finish(Y, rk, convw + 1024 + h * 256, nullptr, 1.0f, tid); }
    __syncthreads();
    const int j0 = 16 * wid, jj = j0 + fr;
    bf16x8 pf[4]; float den, inter, mt;
    u32x4 pre[8];
    load_plain_issue(pre, Cst + (size_t)item * 65536, 256, tid);
    {
        f32x4 S[8];
#pragma unroll
        for (int sb = 0; sb < 8; ++sb) S[sb] = (f32x4){0.f, 0.f, 0.f, 0.f};
#pragma unroll 1
        for (int t = 0; t < 8; ++t) { const bf16x8 qb = rowfrag(X, PIT, j0, 32 * t, lane);
            bf16x8 kf[8];
#pragma unroll
            for (int sb = 0; sb < 8; ++sb) kf[sb] = rowfrag(Y, PIT, 16 * sb, 32 * t, lane);
            __builtin_amdgcn_sched_barrier(0);
#pragma unroll
            for (int sb = 0; sb < 8; ++sb) S[sb] = mfma16(kf[sb], qb, S[sb]); }
        float qn = 0.f;
        { const LAS char* qr = X + jj * PIT + (64 * g) * 2;
#pragma unroll 2
            for (int i = 0; i < 8; ++i) { const u32x4 v = *(const LAS u32x4*)(qr + 16 * i); float f[8]; unpack8(v, f);
                const f32x4 n0 = *(const LAS f32x4*)(npv + 64 * g + 8 * i), n1 = *(const LAS f32x4*)(npv + 64 * g + 8 * i + 4);
                qn += (f[0] * n0.x + f[1] * n0.y) + (f[2] * n0.z + f[3] * n0.w) + (f[4] * n1.x + f[5] * n1.y) + (f[6] * n1.z + f[7] * n1.w); } }
        qn += __shfl_xor(qn, 16); qn += __shfl_xor(qn, 32);
        const float bj = bc[jj], mp = mprev[item];
        float rmax = -INFINITY;
#pragma unroll
        for (int sb = 0; sb < 8; ++sb) { const f32x4 b4 = *(const LAS f32x4*)(bc + 16 * sb + 4 * g), l4 = *(const LAS f32x4*)(li + 16 * sb + 4 * g);
#pragma unroll
            for (int r = 0; r < 4; ++r) { const int s = 16 * sb + 4 * g + r; const float dm = (s <= jj) ? (bj - b4[r] + l4[r]) : -INFINITY; rmax = fmaxf(rmax, dm); } }
        rmax = fmaxf(rmax, __shfl_xor(rmax, 16)); rmax = fmaxf(rmax, __shfl_xor(rmax, 32));
        const float minter = bj + mp; mt = fmaxf(minter, rmax); inter = __expf(minter - mt);
        den = 0.f;
#pragma unroll
        for (int sb = 0; sb < 8; ++sb) { const f32x4 b4 = *(const LAS f32x4*)(bc + 16 * sb + 4 * g), l4 = *(const LAS f32x4*)(li + 16 * sb + 4 * g);
#pragma unroll
            for (int r = 0; r < 4; ++r) { const int s = 16 * sb + 4 * g + r; const float p = (s <= jj) ? __expf(bj - b4[r] + l4[r] - mt) : 0.f; const float v = S[sb][r] * p; S[sb][r] = v; den += v; } }
        den += __shfl_xor(den, 16); den += __shfl_xor(den, 32);
        den += inter * qn;
#pragma unroll
        for (int t = 0; t < 4; ++t) { u32x4 w; w.x = cvt_pk_bf16(S[2 * t][0], S[2 * t][1]); w.y = cvt_pk_bf16(S[2 * t][2], S[2 * t][3]); w.z = cvt_pk_bf16(S[2 * t + 1][0], S[2 * t + 1][1]); w.w = cvt_pk_bf16(S[2 * t + 1][2], S[2 * t + 1][3]); pf[t] = __builtin_bit_cast(bf16x8, w); }
    }
    f32x4 acc[16];
#pragma unroll
    for (int j = 0; j < 16; ++j) acc[j] = (f32x4){0.f, 0.f, 0.f, 0.f};
#pragma unroll 1
    for (int half = 0; half < 2; ++half) {
        __syncthreads();
        load_plain_commit(Y, pre, tid);
        if (half == 0) load_plain_issue(pre, Cst + (size_t)item * 65536 + 32768, 256, tid);
        else load_plain_issue(pre, proj + (size_t)t0 * NP + C_MV + h * 256, NP, tid);
        __syncthreads();
#pragma unroll 1
        for (int t = 0; t < 4; ++t) { const bf16x8 qb = rowfrag_perm(X, PIT, j0, half * 128 + 32 * t, lane);
#pragma unroll
            for (int hb = 0; hb < 2; ++hb) {
                bf16x8 cf[8];
#pragma unroll
                for (int nb = 0; nb < 8; ++nb) cf[nb] = trfrag(Y, PIT, 32 * t, 16 * (8 * hb + nb), lane);
                __builtin_amdgcn_sched_barrier(0);
#pragma unroll
                for (int nb = 0; nb < 8; ++nb) acc[8 * hb + nb] = mfma16(cf[nb], qb, acc[8 * hb + nb]); } }
    }
#pragma unroll
    for (int nb = 0; nb < 16; ++nb) acc[nb] = acc[nb] * inter;
    __syncthreads();
    load_plain_commit(X, pre, tid);
    __syncthreads();
#pragma unroll
    for (int t = 0; t < 4; ++t) if (2 * t <= wid) {
        bf16x8 vf[16];
#pragma unroll
        for (int nb = 0; nb < 16; ++nb) vf[nb] = trfrag(X, PIT, 32 * t, 16 * nb, lane);
        __builtin_amdgcn_sched_barrier(0);
#pragma unroll
        for (int nb = 0; nb < 16; ++nb) acc[nb] = mfma16(vf[nb], pf[t], acc[nb]); }
    const float rdn = 1.0f / fmaxf(fabsf(den), __expf(-mt));
    bf16_t* op = proj + (size_t)(t0 + jj) * NP + C_MO + h * 256 + 4 * g;
    u32x2 sgv[16];
#pragma unroll
    for (int nb = 0; nb < 16; ++nb) sgv[nb] = *(const u32x2*)(op + 16 * nb);
#pragma unroll
    for (int nb = 0; nb < 16; ++nb) { const u32x2 sg = sgv[nb];
        u32x2 w; w.x = cvt_pk_bf16(acc[nb][0] * rdn * bflo(sg.x), acc[nb][1] * rdn * bfhi(sg.x)); w.y = cvt_pk_bf16(acc[nb][2] * rdn * bflo(sg.y), acc[nb][3] * rdn * bfhi(sg.y));
        *(u32x2*)(op + 16 * nb) = w; }
    __syncthreads();
}

__device__ __forceinline__ void phase_qkprep(bf16_t* proj, const float* gqk  , const float2* rope) {
    const int tid = my_tid(), lane = tid & 63, wave = tid >> 6;
    const int gw = blockIdx.x * 8 + wave, NGW = gridDim.x * 8;
    const int grp = lane >> 2, u = lane & 3;
    for (int it = gw; it < TG * 2; it += NGW) {
        const int row = it >> 1, which = it & 1, pos = row & (SEQ - 1);
        bf16_t* p = proj + (size_t)row * NP + (which ? C_AK : C_AQ) + grp * 64 + 8 * u;
        const u32x4 a = *(const u32x4*)p, b = *(const u32x4*)(p + 32);
        float x1[8], x2[8]; unpack8(a, x1); unpack8(b, x2);
        float ss = 0.f;
#pragma unroll
        for (int e = 0; e < 8; ++e) ss += x1[e] * x1[e] + x2[e] * x2[e];
        ss += __shfl_xor(ss, 1); ss += __shfl_xor(ss, 2);
        const float rstd = 1.0f / sqrtf(ss * (1.0f / 64.0f) + 1e-6f) * (which ? 1.0f : 0.125f * 1.4426950408889634f);
        const float* gq = gqk + which * 64 + 8 * u;
        const float2* cs = rope + (size_t)pos * 32 + 8 * u;
        float o1[8], o2[8];
#pragma unroll
        for (int e = 0; e < 8; ++e) { const float y1 = x1[e] * rstd * gq[e], y2 = x2[e] * rstd * gq[32 + e]; const float2 t = cs[e]; o1[e] = y1 * t.x - y2 * t.y; o2[e] = y2 * t.x + y1 * t.y; }
        *(u32x4*)p = pack8(o1); *(u32x4*)(p + 32) = pack8(o2);
    }
}
__device__ __forceinline__ void phase_pool(const bf16_t* proj, bf16_t* pooled) {
    const int tid = my_tid();
    for (int idx = blockIdx.x * NTHR + tid; idx < (TG / 16) * 128; idx += gridDim.x * NTHR) {
        const int cgi = idx & 127, seg = idx >> 7, r0 = seg * 16, pos0 = r0 & (SEQ - 1), w = 2 << (cgi >> 5);
        const bf16_t* src = proj + (size_t)r0 * NP + C_PU + cgi * 8;
        float sum[8];
#pragma unroll
        for (int e = 0; e < 8; ++e) sum[e] = 0.f;
        if (pos0 > 0) for (int j = 1; j < w; ++j) { float f[8]; unpack8(*(const u32x4*)(src - (ptrdiff_t)j * NP), f);
#pragma unroll
            for (int e = 0; e < 8; ++e) sum[e] += f[e]; }
        for (int r = 0; r < 16; ++r) {
            float f[8]; unpack8(*(const u32x4*)(src + (ptrdiff_t)r * NP), f);
            const int pos = pos0 + r;
            if (r >= 1 && pos - w >= 0) { float o[8]; unpack8(*(const u32x4*)(src + (ptrdiff_t)(r - w) * NP), o);
#pragma unroll
                for (int e = 0; e < 8; ++e) sum[e] -= o[e]; }
            const float rc = 1.0f / (float)(pos + 1 < w ? pos + 1 : w);
            float out[8];
#pragma unroll
            for (int e = 0; e < 8; ++e) { sum[e] += f[e]; out[e] = sum[e] * rc - f[e]; }
            *(u32x4*)(pooled + (size_t)(r0 + r) * DM + cgi * 8) = pack8(out);
        }
    }
}

constexpr int APIT = 288, ATILE = 64 * APIT, ABUF = 2 * ATILE;
__device__ __forceinline__ void attn_qkexp(const LAS char* Kb, int k0, int q0, int wid, int lane, int g, int qpos, const bf16x8 (&qf)[2][2], const f32x4 negM, bf16x8 (&pf)[2][2]) {
    f32x4 s[2][4];
    {
        bf16x8 kf[2][4][2];
#pragma unroll
        for (int c = 0; c < 2; ++c)
#pragma unroll
            for (int kb = 0; kb < 4; ++kb)
#pragma unroll
                for (int ks = 0; ks < 2; ++ks) kf[c][kb][ks] = rowfrag(Kb, APIT, 16 * kb, c * 64 + 32 * ks, lane);
        __builtin_amdgcn_sched_barrier(0);
#pragma unroll
        for (int c = 0; c < 2; ++c)
#pragma unroll
            for (int kb = 0; kb < 4; ++kb) s[c][kb] = mfma16(kf[c][kb][0], qf[c][0], negM);
#pragma unroll
        for (int c = 0; c < 2; ++c)
#pragma unroll
            for (int kb = 0; kb < 4; ++kb) s[c][kb] = mfma16(kf[c][kb][1], qf[c][1], s[c][kb]);
    }
    if (k0 + 63 > q0 + 16 * wid) {
#pragma unroll
        for (int c = 0; c < 2; ++c)
#pragma unroll
            for (int kb = 0; kb < 4; ++kb)
#pragma unroll
                for (int r = 0; r < 4; ++r) if (k0 + 16 * kb + 4 * g + r > qpos) s[c][kb][r] = -INFINITY;
    }
#pragma unroll
    for (int c = 0; c < 2; ++c) {
#pragma unroll
        for (int kb = 0; kb < 4; ++kb)
#pragma unroll
            for (int r = 0; r < 4; ++r) s[c][kb][r] = __builtin_amdgcn_exp2f(s[c][kb][r]);
#pragma unroll
        for (int tt = 0; tt < 2; ++tt) { u32x4 w; w.x = cvt_pk_bf16(s[c][2 * tt][0], s[c][2 * tt][1]); w.y = cvt_pk_bf16(s[c][2 * tt][2], s[c][2 * tt][3]);
            w.z = cvt_pk_bf16(s[c][2 * tt + 1][0], s[c][2 * tt + 1][1]); w.w = cvt_pk_bf16(s[c][2 * tt + 1][2], s[c][2 * tt + 1][3]); pf[c][tt] = __builtin_bit_cast(bf16x8, w); }
    }
}
__device__ __forceinline__ void attn_pv(const LAS char* Vb, int lane, const bf16x8 (&pf)[2][2], const bf16x8 onesf, f32x4 (&O)[2][8], f32x4 (&Oe)[2]) {
    bf16x8 va[8], vb[8];
#pragma unroll
    for (int nb = 0; nb < 8; ++nb) va[nb] = trfrag(Vb, APIT, 0, 16 * nb, lane);
#pragma unroll
    for (int nb = 0; nb < 8; ++nb) vb[nb] = trfrag(Vb, APIT, 32, 16 * nb, lane);
    __builtin_amdgcn_sched_barrier(0);
    Oe[0] = mfma16(onesf, pf[0][0], Oe[0]); Oe[1] = mfma16(onesf, pf[1][0], Oe[1]);
#pragma unroll
    for (int nb = 0; nb < 8; ++nb) { O[0][nb] = mfma16(va[nb], pf[0][0], O[0][nb]); O[1][nb] = mfma16(va[nb], pf[1][0], O[1][nb]); }
    Oe[0] = mfma16(onesf, pf[0][1], Oe[0]); Oe[1] = mfma16(onesf, pf[1][1], Oe[1]);
#pragma unroll
    for (int nb = 0; nb < 8; ++nb) { O[0][nb] = mfma16(vb[nb], pf[0][1], O[0][nb]); O[1][nb] = mfma16(vb[nb], pf[1][1], O[1][nb]); }
}
__device__ __forceinline__ void attn_step_fast(const LAS char* Kb, const LAS char* Vb, int lane, const bf16x8 (&qf)[2][2], const f32x4 negM, const bf16x8 onesf, f32x4 (&O)[2][8], f32x4 (&Oe)[2]) {
    f32x4 s0[4], s1[4];
    bf16x8 p0[2], p1[2];
    {
        bf16x8 kf[2][4][2];
#pragma unroll
        for (int c = 0; c < 2; ++c)
#pragma unroll
            for (int kb = 0; kb < 4; ++kb)
#pragma unroll
                for (int ks = 0; ks < 2; ++ks) kf[c][kb][ks] = rowfrag(Kb, APIT, 16 * kb, c * 64 + 32 * ks, lane);
        __builtin_amdgcn_sched_barrier(0);
#pragma unroll
        for (int kb = 0; kb < 4; ++kb) s0[kb] = mfma16(kf[0][kb][0], qf[0][0], negM);
#pragma unroll
        for (int kb = 0; kb < 4; ++kb) s0[kb] = mfma16(kf[0][kb][1], qf[0][1], s0[kb]);
        __builtin_amdgcn_sched_barrier(0);
#pragma unroll
        for (int kb = 0; kb < 4; ++kb) s1[kb] = mfma16(kf[1][kb][0], qf[1][0], negM);
#pragma unroll
        for (int kb = 0; kb < 4; ++kb) s1[kb] = mfma16(kf[1][kb][1], qf[1][1], s1[kb]);
    }
#define ATT_EXPPACK(S, P) do { \
        _Pragma("unroll") for (int kb = 0; kb < 4; ++kb) _Pragma("unroll") for (int r = 0; r < 4; ++r) S[kb][r] = __builtin_amdgcn_exp2f(S[kb][r]); \
        _Pragma("unroll") for (int tt = 0; tt < 2; ++tt) { u32x4 w; w.x = cvt_pk_bf16(S[2 * tt][0], S[2 * tt][1]); w.y = cvt_pk_bf16(S[2 * tt][2], S[2 * tt][3]); \
            w.z = cvt_pk_bf16(S[2 * tt + 1][0], S[2 * tt + 1][1]); w.w = cvt_pk_bf16(S[2 * tt + 1][2], S[2 * tt + 1][3]); P[tt] = __builtin_bit_cast(bf16x8, w); } } while (0)
    ATT_EXPPACK(s0, p0);
#pragma unroll
    for (int i = 0; i < 8; ++i) { __builtin_amdgcn_sched_group_barrier(0x008, 1, 0); __builtin_amdgcn_sched_group_barrier(0x002, 3, 0); }
    __builtin_amdgcn_sched_barrier(0);
    bf16x8 va[8], vb[8];
#pragma unroll
    for (int nb = 0; nb < 8; ++nb) va[nb] = trfrag(Vb, APIT, 0, 16 * nb, lane);
#pragma unroll
    for (int nb = 0; nb < 8; ++nb) vb[nb] = trfrag(Vb, APIT, 32, 16 * nb, lane);
    __builtin_amdgcn_sched_barrier(0);
    Oe[0] = mfma16(onesf, p0[0], Oe[0]);
#pragma unroll
    for (int nb = 0; nb < 8; ++nb) O[0][nb] = mfma16(va[nb], p0[0], O[0][nb]);
    Oe[0] = mfma16(onesf, p0[1], Oe[0]);
#pragma unroll
    for (int nb = 0; nb < 8; ++nb) O[0][nb] = mfma16(vb[nb], p0[1], O[0][nb]);
    ATT_EXPPACK(s1, p1);
#pragma unroll
    for (int i = 0; i < 18; ++i) { __builtin_amdgcn_sched_group_barrier(0x008, 1, 0); __builtin_amdgcn_sched_group_barrier(0x002, 2, 0); }
    __builtin_amdgcn_sched_barrier(0);
    Oe[1] = mfma16(onesf, p1[0], Oe[1]);
#pragma unroll
    for (int nb = 0; nb < 8; ++nb) O[1][nb] = mfma16(va[nb], p1[0], O[1][nb]);
    Oe[1] = mfma16(onesf, p1[1], Oe[1]);
#pragma unroll
    for (int nb = 0; nb < 8; ++nb) O[1][nb] = mfma16(vb[nb], p1[1], O[1][nb]);
#undef ATT_EXPPACK
}
__device__ __forceinline__ void attn_item(LAS char* lds, bf16_t* proj, int bl, int h, int qb, float lam, float oscale, const float* gdh, float smax) {
    const int tid = my_tid(), lane = tid & 63, wid = __builtin_amdgcn_readfirstlane(tid >> 6), g = lane >> 4, fr = lane & 15;
    const size_t rowbase = (size_t)bl * SEQ; const int q0 = qb * 128, qpos = q0 + 16 * wid + fr;
    bf16_t* qp = proj + (rowbase + qpos) * NP + C_AQ + h * 128;
    bf16x8 qf[2][2];
#pragma unroll
    for (int c = 0; c < 2; ++c)
#pragma unroll
        for (int ks = 0; ks < 2; ++ks) qf[c][ks] = *(const bf16x8*)(qp + c * 64 + 32 * ks + 8 * g);
    f32x4 O[2][8], Oe[2];
#pragma unroll
    for (int c = 0; c < 2; ++c) { Oe[c] = (f32x4){0.f, 0.f, 0.f, 0.f};
#pragma unroll
        for (int nb = 0; nb < 8; ++nb) O[c][nb] = (f32x4){0.f, 0.f, 0.f, 0.f}; }
    const f32x4 negM = (f32x4){-smax, -smax, -smax, -smax};
    const short one16 = (fr == 0) ? (short)0x3F80 : (short)0;
    const bf16x8 onesf = (bf16x8){one16, one16, one16, one16, one16, one16, one16, one16};
    const int NT = 2 * (qb + 1);
    const int sr0 = tid >> 4, sc = tid & 15;
    const bf16_t* kg = proj + (rowbase + sr0) * NP + C_AK + h * 128 + sc * 8;
    const bf16_t* vg = proj + (rowbase + sr0) * NP + C_AV + h * 128 + sc * 8;
    const int soff = sr0 * APIT + sc * 16;
    u32x4 kr[2], vr[2];
#define ATT_LOAD(tile) do { _Pragma("unroll") for (int i = 0; i < 2; ++i) { kr[i] = *(const u32x4*)(kg + (size_t)(64 * (tile) + 32 * i) * NP); vr[i] = *(const u32x4*)(vg + (size_t)(64 * (tile) + 32 * i) * NP); } } while (0)
#define ATT_STORE(buf) do { LAS char* nb_ = lds + (buf) * ABUF; _Pragma("unroll") for (int i = 0; i < 2; ++i) { *(LAS u32x4*)(nb_ + soff + 32 * i * APIT) = kr[i]; *(LAS u32x4*)(nb_ + ATILE + soff + 32 * i * APIT) = vr[i]; } } while (0)
    ATT_LOAD(0); ATT_STORE(0);
    __syncthreads();
    const int qmaxw = q0 + 16 * wid + 15;
    int t = 0;
    for (; t < NT - 2; ++t) {
        ATT_LOAD(t + 1);
        const LAS char* Kb = lds + (t & 1) * ABUF;
#if ATT_FAST
        attn_step_fast(Kb, Kb + ATILE, lane, qf, negM, onesf, O, Oe);
#else
        { bf16x8 pq[2][2]; attn_qkexp(Kb, 64 * t, q0, wid, lane, g, qpos, qf, negM, pq); attn_pv(Kb + ATILE, lane, pq, onesf, O, Oe); }
#endif
        ATT_STORE((t + 1) & 1);
        BAR_LDS();
    }
    bf16x8 pf[2][2];
    for (; t < NT; ++t) {
        const int k0 = 64 * t;
        if (t + 1 < NT) ATT_LOAD(t + 1);
        if (k0 <= qmaxw) {
            const LAS char* Kb = lds + (t & 1) * ABUF;
            attn_qkexp(Kb, k0, q0, wid, lane, g, qpos, qf, negM, pf);
            attn_pv(Kb + ATILE, lane, pf, onesf, O, Oe);
        }
        if (t + 1 < NT) ATT_STORE((t + 1) & 1);
        BAR_LDS();
    }
#undef ATT_LOAD
#undef ATT_STORE
    const float l0 = __shfl(Oe[0][0], fr), l1 = __shfl(Oe[1][0], fr);
    const float r0 = 1.0f / l0, r1 = lam / l1;
    float ss = 0.f;
#pragma unroll
    for (int nb = 0; nb < 8; ++nb)
#pragma unroll
        for (int r = 0; r < 4; ++r) { const float o = O[0][nb][r] * r0 - O[1][nb][r] * r1; O[0][nb][r] = o; ss += o * o; }
    ss += __shfl_xor(ss, 16); ss += __shfl_xor(ss, 32);
    const float rstd = 1.0f / sqrtf(ss * (1.0f / 128.0f) + 1e-6f) * oscale;
    f32x4 ggv[8];
#pragma unroll
    for (int nb = 0; nb < 8; ++nb) ggv[nb] = *(const f32x4*)(gdh + 16 * nb + 4 * g);
#pragma unroll
    for (int nb = 0; nb < 8; ++nb) { const f32x4 gg = ggv[nb];
        u32x2 w; w.x = cvt_pk_bf16(O[0][nb][0] * rstd * gg.x, O[0][nb][1] * rstd * gg.y); w.y = cvt_pk_bf16(O[0][nb][2] * rstd * gg.z, O[0][nb][3] * rstd * gg.w);
        *(u32x2*)(qp + (C_PU - C_AQ) + 16 * nb + 4 * g) = w; }
}

#ifndef PH_ONLY
#define PH_ONLY -1
#endif
#define PHO(n) (PH_ONLY < 0 || PH_ONLY == (n))
#ifndef PROJ_ALIGN
#define PROJ_ALIGN true
#endif
#ifndef ATT_FAST
#define ATT_FAST 1
#endif
#ifndef DUP_K
#define DUP_K -1
#endif
__global__ void __launch_bounds__(NTHR, 2) fwd_kernel(Args a) {
    extern __shared__ __attribute__((aligned(16))) unsigned char lds_raw[];
    LAS unsigned char* lds = (LAS unsigned char*)lds_raw;
    cg::grid_group grid = cg::this_grid();
    unsigned char* ws = a.ws;
    bf16_t* proj = (bf16_t*)(ws + WS_PROJ);
    bf16_t* hn = (bf16_t*)(ws + WS_HN);
    bf16_t* Cst = (bf16_t*)(ws + WS_CST);
    float* gif = (float*)(ws + WS_GIF);
    float* gch = (float*)(ws + WS_MV); float* mloc = gch + 512; float* mprev = gch + 1024;
    float* nst = (float*)(ws + WS_NST);
    const int G = gridDim.x, bx = blockIdx.x;
    unsigned* barw = (unsigned*)ws;
    volatile LAS unsigned* bst = (volatile LAS unsigned*)(lds + LDS_BYTES - 64);
    if (threadIdx.x < 2) bst[threadIdx.x] = 0u;
    if (bx == 0) for (int i = threadIdx.x; i < XCD_BAR_WORDS; i += NTHR) barw[i] = 0u;
    __syncthreads();
    XcdBarrier xb; xb.bar = barw; xb.x = 0; xb.st = bst;
    bool xb_ready = false;
    for (int ph = a.ph_lo; ph < a.ph_hi; ++ph) {
        const int l = ph / 18, idx = ph % 18;
        const float* xsrc = (l == 0) ? a.in[0] : a.out;
        if (PHO(0) && idx == 0) {
            phase_weights(a, l, lds);
        } else if (idx <= 14) {
            const int grp = (idx - 1) / 7, k = (idx - 1) % 7;
            const size_t rowoff = (size_t)grp * TG;
            if (PHO(1) && k == 0) {
                for (int rep = 0; rep < (DUP_K == 0 ? 2 : 1); ++rep)
                phase_norm<true>(xsrc + rowoff * DM, a.in[1] + l * DM, hn, TG, a.in[2] + (size_t)l * DM * NIN, a.in[3] + l * 8, gif, lds);
            } else if (PHO(2) && k == 1) {
                pg8::Gemm gm{hn, (const bf16_t*)(ws + WS_WIN), TG, NP, DM, DM, 0}; pg8::StaticOrder S; S.init(TG, NP, G, bx);
                pg8::EpiProj E{proj, NP};
                for (int rep = 0; rep < (DUP_K == 1 ? 2 : 1); ++rep)
                pg8::gemm_phase<pg8::EpiProj, pg8::StaticOrder, PROJ_ALIGN, true>(lds, gm, S, E);
            } else if (PHO(3) && k == 2) {
                const float* convw = a.in[4] + (size_t)l * 4 * 2048;
                for (int rep = 0; rep < (DUP_K == 2 ? 2 : 1); ++rep)
                for (int it = bx; it < NBH * 32; it += G) m1_item((LAS char*)lds, proj, gif, Cst, nst, gch, mloc, convw, it >> 5, it & 31);
                phase_qkprep(proj, a.in[8] + l * 128, (const float2*)(ws + WS_ROPE));
                phase_pool(proj, hn);
            } else if (PHO(4) && k == 3) {
                phase_scan(Cst, nst, gch, mloc, mprev);
                const float* lp = a.in[9] + l * 256;
                float s01 = 0.f, s23 = 0.f;
                for (int i = 0; i < 64; ++i) { s01 += lp[i] * lp[64 + i]; s23 += lp[128 + i] * lp[192 + i]; }
                float mgq = 0.f, mgk = 0.f; { const float* gq = a.in[8] + l * 128; for (int i = 0; i < 64; ++i) { mgq = fmaxf(mgq, fabsf(gq[i])); mgk = fmaxf(mgk, fabsf(gq[64 + i])); } }
                const float smax = 64.0f * mgq * mgk * (0.125f * 1.4426950408889634f) * 1.01f + 0.25f;
                const float lam_init = 0.8f - 0.6f * expf(-0.3f * (float)l);
                const float lam = expf(s01) - expf(s23) + lam_init;
                for (int rep = 0; rep < (DUP_K == 3 ? 2 : 1); ++rep)
                for (int i = bx; i < GB * 8 * 32; i += G) {
                    const int r = i >> 8, j = i & 255, x = j & 7, y = j >> 3, bh = x + 8 * r, qb = (r & 1) ? 31 - y : y;
                    attn_item((LAS char*)lds, proj, bh >> 3, bh & 7, qb, lam, 1.0f - lam_init, a.in[10] + l * 128, smax);
                }
            } else if (PHO(5) && k == 4) {
                const float* convw = a.in[4] + (size_t)l * 4 * 2048;
                for (int it = bx; it < NBH * 32; it += G) m3_item((LAS char*)lds, proj, gif, Cst, nst, mprev, convw, it >> 5, it & 31);
            } else if (PHO(6) && k == 5) {
#pragma unroll 1
                for (int brr = 0; brr < (DUP_K == 5 ? 6 : 3); ++brr) { const int br = brr % 3;
                    pg8::Gemm gm; gm.M = TG; gm.N = DM;
                    if (br == 0) { gm.A = proj + C_MO; gm.Bt = (const bf16_t*)(ws + WS_WMO); gm.K = DM; gm.lda = NP; gm.a_pn_off = 0; }
                    else if (br == 1) { gm.A = hn; gm.Bt = (const bf16_t*)(ws + WS_WPOOL); gm.K = 256; gm.lda = DM; gm.a_pn_off = 256; }
                    else { gm.A = proj + C_PU; gm.Bt = (const bf16_t*)(ws + WS_WDIFF); gm.K = DM; gm.lda = NP; gm.a_pn_off = 0; }
                    pg8::StaticOrder S; S.init(TG, DM, G, bx);
                    pg8::EpiMerge E{proj + C_MQ, proj + C_GT + br * DM, NP, br == 0 ? 1 : 0};
                    pg8::gemm_phase<pg8::EpiMerge, pg8::StaticOrder, true, true>(lds, gm, S, E);
                }
            } else if (PHO(7)) {
                pg8::Gemm gm{proj + C_MQ, (const bf16_t*)(ws + WS_WOUT), TG, DM, DM, NP, 0}; pg8::StaticOrder S; S.init(TG, DM, G, bx);
                pg8::EpiResid E{xsrc + rowoff * DM, a.out + rowoff * DM, DM};
                pg8::gemm_phase<pg8::EpiResid, pg8::StaticOrder, true, true>(lds, gm, S, E);
            }
        } else if (PHO(8) && idx == 15) {
            phase_norm<false>(a.out, a.in[13] + l * DM, hn, TT, nullptr, nullptr, nullptr, lds);
        } else if (PHO(9) && idx == 16) {
            pg8::Gemm gm{hn, (const bf16_t*)(ws + WS_WGU), TT, 2 * FF, DM, DM, 0}; pg8::StaticOrder S; S.init(TT, 2 * FF, G, bx);
            pg8::EpiSwiGLU E{proj, FF};
            for (int rep = 0; rep < (DUP_K == 16 ? 2 : 1); ++rep)
            pg8::gemm_phase<pg8::EpiSwiGLU, pg8::StaticOrder, true, true>(lds, gm, S, E);
        } else if (PHO(10)) {
            pg8::Gemm gm{proj, (const bf16_t*)(ws + WS_WDN), TT, DM, FF, FF, 0}; pg8::StaticOrder S; S.init(TT, DM, G, bx);
            pg8::EpiResid E{a.out, a.out, DM};
            pg8::gemm_phase<pg8::EpiResid, pg8::StaticOrder, true, true>(lds, gm, S, E);
        }
        if (ph + 1 < a.ph_hi) {
            if (!xb_ready) { grid.sync(); xb = xcd_barrier_post(barw, bst); xb_ready = true; }
            else { xcd_barrier(xb); if (DUP_K == 100) { xcd_barrier(xb); xcd_barrier(xb); } }
        }
    }
}

extern "C" void kernel_launch(void* const* d_in, const int* in_sizes, int n_in, void* d_out, int out_size, void* d_ws, size_t ws_size, hipStream_t stream) {
    static int grid = 0;
    if (grid == 0) {
        if (n_in != 16 || out_size != TT * DM || ws_size < WS_END) { fprintf(stderr, "kernel_launch: unexpected shapes / workspace (%d inputs, out %d, ws %zu)\n", n_in, out_size, ws_size); grid = -1; return; }
        int dev = 0, cus = 0, per_cu = 0;
        hipGetDevice(&dev); hipDeviceGetAttribute(&cus, hipDeviceAttributeMultiprocessorCount, dev);
        hipFuncSetAttribute((const void*)fwd_kernel, hipFuncAttributeMaxDynamicSharedMemorySize, LDS_BYTES);
        hipOccupancyMaxActiveBlocksPerMultiprocessor(&per_cu, (const void*)fwd_kernel, NTHR, LDS_BYTES);
        (void)hipGetLastError();
        if (per_cu < 1) per_cu = 1;
        grid = cus * 1;
        if (grid <= 0) grid = 256;
    }
    if (grid < 0) return;
    Args a{};
    for (int i = 0; i < 16; ++i) a.in[i] = (const float*)d_in[i];
    a.out = (float*)d_out; a.ws = (unsigned char*)d_ws; a.ph_lo = 0; a.ph_hi = 36;
    void* args[] = {&a};
    hipError_t e = hipLaunchCooperativeKernel((const void*)fwd_kernel, dim3(grid), dim3(NTHR), args, LDS_BYTES, stream);
    if (e != hipSuccess) fprintf(stderr, "cooperative launch failed: %s (grid %d)\n", hipGetErrorString(e), grid);
}
```

```cpp
#include <hip/hip_runtime.h>
#include <hip/hip_cooperative_groups.h>
#include <cstdio>
#include <cstdint>
namespace cg = cooperative_groups;
namespace pg8 {
#define PG8_LAS __attribute__((address_space(3)))
typedef unsigned short bf16_t;
typedef short bf16x8 __attribute__((ext_vector_type(8)));
typedef float f32x4 __attribute__((ext_vector_type(4)));
typedef unsigned u32x4 __attribute__((ext_vector_type(4)));
constexpr int BM = 256, BK = 64, HALF = 128, HTB = HALF * BK * 2  , STAGE_BYTES = 8 * HTB, NXCD = 8, WGM = 8;

__host__ __device__ __forceinline__ int lds_byte(int r, int c) { const int st = (r >> 4) * 2 + (c >> 5), rr = r & 15, cc = c & 31, ob = rr * 64 + cc * 2; return st * 1024 + (ob ^ (((ob >> 9) & 1) << 5)); }
__host__ __device__ __forceinline__ void stage_rc(int b, int& R, int& C) { const int st = b / 1024, sb = b % 1024, swz = sb ^ (((sb >> 9) & 1) << 5); R = (st >> 1) * 16 + swz / 64; C = (st & 1) * 32 + (swz % 64) / 2; }
__host__ __device__ __forceinline__ int perm32(int rho) { const int n = rho >> 4, i = rho & 15; return 8 * (i >> 2) + 4 * n + (i & 3); }

struct Unit { int pm, pn; };
struct Gemm { const bf16_t* A; const bf16_t* Bt; int M, N, K, lda, a_pn_off; };

struct StaticOrder {
    int nM, nN, nwg, G, c;
    __host__ __device__ void init(int M, int N, int G_, int c_) { nM = M / BM; nN = N / BM; nwg = nM * nN; G = G_; c = c_; }
    __host__ __device__ bool next(int i, Unit& u) const {
        const long L = (long)i * G + c; if (L >= nwg) return false;
        int wgid = (int)L; { const int q = nwg / NXCD, r = nwg % NXCD, xcd = wgid % NXCD, off = wgid / NXCD; wgid = (xcd < r ? xcd * (q + 1) : r * (q + 1) + (xcd - r) * q) + off; }
        const int nig = WGM * nN, gid = wgid / nig, fm = gid * WGM, gsz = (nM - fm) < WGM ? (nM - fm) : WGM;
        u.pm = fm + ((wgid % nig) % gsz); u.pn = (wgid % nig) / gsz; return true;
    }
    __device__ __forceinline__ void a_ready(const Unit&) const {}
    __device__ __forceinline__ void done(const Unit&) const {}
};

typedef float f32x2_t __attribute__((ext_vector_type(2))); typedef __bf16 bf16x2_t __attribute__((ext_vector_type(2)));
__device__ __forceinline__ unsigned cvt_pk_bf16(float lo, float hi) { const f32x2_t v = {lo, hi}; const bf16x2_t b = __builtin_convertvector(v, bf16x2_t); return __builtin_bit_cast(unsigned, b); }
__device__ __forceinline__ float fsigmoid(float x) { return __builtin_amdgcn_rcpf(1.0f + __expf(-x)); }
__device__ __forceinline__ float bflo(unsigned u) { return __uint_as_float(u << 16); }
__device__ __forceinline__ float bfhi(unsigned u) { return __uint_as_float(u & 0xffff0000u); }

struct EpiProj {
    static constexpr bool PERM = true, AFTER_DRAIN = false;
    bf16_t* O; int ldc; size_t sec_stride;
    __device__ __forceinline__ void operator()(const f32x4 (&acc)[2][2][4][2], const Unit& u, int wr, int wc, int fr, int fq) const {
        const bool sg = (u.pn >= 12 && u.pn < 16) || (u.pn >= 32);
        const int row0 = u.pm * BM + wr * 64 + fr, col0 = (u.pn & 3) * BM + wc * 32 + 8 * fq;
        bf16_t* const Os = O + (size_t)(u.pn >> 2) * sec_stride;
#pragma unroll
        for (int ai = 0; ai < 2; ++ai)
#pragma unroll
            for (int m = 0; m < 4; ++m) { bf16_t* rowp = Os + (size_t)(row0 + ai * HALF + m * 16) * ldc + col0;
#pragma unroll
                for (int bj = 0; bj < 2; ++bj) { f32x4 v0 = acc[ai][bj][m][0], v1 = acc[ai][bj][m][1];
                    if (sg) {
#pragma unroll
                        for (int i = 0; i < 4; ++i) { v0[i] = fsigmoid(v0[i]); v1[i] = fsigmoid(v1[i]); } }
                    u32x4 w; w.x = cvt_pk_bf16(v0[0], v0[1]); w.y = cvt_pk_bf16(v0[2], v0[3]); w.z = cvt_pk_bf16(v1[0], v1[1]); w.w = cvt_pk_bf16(v1[2], v1[3]);
                    *(u32x4*)(rowp + bj * HALF) = w; } }
    }
};
struct EpiMerge {
    static constexpr bool PERM = true, AFTER_DRAIN = false;
    bf16_t* O; const bf16_t* Gt; int ld; int first;
    __device__ __forceinline__ void operator()(const f32x4 (&acc)[2][2][4][2], const Unit& u, int wr, int wc, int fr, int fq) const {
        const int row0 = u.pm * BM + wr * 64 + fr, col0 = u.pn * BM + wc * 32 + 8 * fq;
#pragma unroll
        for (int ai = 0; ai < 2; ++ai) {
            u32x4 gv[4][2], pv[4][2];
#pragma unroll
            for (int m = 0; m < 4; ++m)
#pragma unroll
                for (int bj = 0; bj < 2; ++bj) { const size_t ro = (size_t)(row0 + ai * HALF + m * 16) * ld + col0 + bj * HALF;
                    gv[m][bj] = *(const u32x4*)(Gt + ro); pv[m][bj] = first ? (u32x4){0u, 0u, 0u, 0u} : *(const u32x4*)(O + ro); }
#pragma unroll
            for (int m = 0; m < 4; ++m)
#pragma unroll
                for (int bj = 0; bj < 2; ++bj) { const size_t ro = (size_t)(row0 + ai * HALF + m * 16) * ld + col0 + bj * HALF;
                    const f32x4 v0 = acc[ai][bj][m][0], v1 = acc[ai][bj][m][1]; const u32x4 g4 = gv[m][bj], p4 = pv[m][bj];
                    float o[8];
                    o[0] = v0[0] * bflo(g4.x) + bflo(p4.x); o[1] = v0[1] * bfhi(g4.x) + bfhi(p4.x); o[2] = v0[2] * bflo(g4.y) + bflo(p4.y); o[3] = v0[3] * bfhi(g4.y) + bfhi(p4.y);
                    o[4] = v1[0] * bflo(g4.z) + bflo(p4.z); o[5] = v1[1] * bfhi(g4.z) + bfhi(p4.z); o[6] = v1[2] * bflo(g4.w) + bflo(p4.w); o[7] = v1[3] * bfhi(g4.w) + bfhi(p4.w);
                    u32x4 w; w.x = cvt_pk_bf16(o[0], o[1]); w.y = cvt_pk_bf16(o[2], o[3]); w.z = cvt_pk_bf16(o[4], o[5]); w.w = cvt_pk_bf16(o[6], o[7]);
                    *(u32x4*)(O + ro) = w; }
        }
    }
};
struct EpiResid {
    static constexpr bool PERM = false, AFTER_DRAIN = false;
    const float* base; float* out; int ldc;
    __device__ __forceinline__ void operator()(const f32x4 (&acc)[2][2][4][2], const Unit& u, int wr, int wc, int fr, int fq) const {
        const int row0 = u.pm * BM + wr * 64 + fr, col0 = u.pn * BM + wc * 32 + 4 * fq;
#pragma unroll
        for (int ai = 0; ai < 2; ++ai) {
            f32x4 b[4][2][2];
#pragma unroll
            for (int m = 0; m < 4; ++m) { const size_t off = (size_t)(row0 + ai * HALF + m * 16) * ldc + col0;
#pragma unroll
                for (int bj = 0; bj < 2; ++bj)
#pragma unroll
                    for (int n = 0; n < 2; ++n) b[m][bj][n] = *(const f32x4*)(base + off + bj * HALF + n * 16); }
#pragma unroll
            for (int m = 0; m < 4; ++m) { const size_t off = (size_t)(row0 + ai * HALF + m * 16) * ldc + col0;
#pragma unroll
                for (int bj = 0; bj < 2; ++bj)
#pragma unroll
                    for (int n = 0; n < 2; ++n) *(f32x4*)(out + off + bj * HALF + n * 16) = b[m][bj][n] + acc[ai][bj][m][n]; }
        }
    }
};
struct EpiSwiGLU {
    static constexpr bool PERM = true, AFTER_DRAIN = false;
    bf16_t* O; int ldc;
    __device__ __forceinline__ void operator()(const f32x4 (&acc)[2][2][4][2], const Unit& u, int wr, int wc, int fr, int fq) const {
        const int row0 = u.pm * BM + wr * 64 + fr, col0 = u.pn * HALF + wc * 32 + 8 * fq;
#pragma unroll
        for (int ai = 0; ai < 2; ++ai)
#pragma unroll
            for (int m = 0; m < 4; ++m) { bf16_t* rowp = O + (size_t)(row0 + ai * HALF + m * 16) * ldc + col0;
                float o[8];
#pragma unroll
                for (int n = 0; n < 2; ++n)
#pragma unroll
                    for (int i = 0; i < 4; ++i) { const float gt = acc[ai][0][m][n][i], up = acc[ai][1][m][n][i]; o[n * 4 + i] = gt * fsigmoid(gt) * up; }
                u32x4 w; w.x = cvt_pk_bf16(o[0], o[1]); w.y = cvt_pk_bf16(o[2], o[3]); w.z = cvt_pk_bf16(o[4], o[5]); w.w = cvt_pk_bf16(o[6], o[7]);
                *(u32x4*)rowp = w; }
    }
};
template <class Epi, class Sched, bool ALIGN_EPI = false, bool SP2 = false>
__device__ __forceinline__ void gemm_phase(PG8_LAS unsigned char* lds, const Gemm g, const Sched& S, const Epi& E) {
    int tid_ = threadIdx.x; asm volatile("" : "+v"(tid_)); const int tid = tid_, wid = __builtin_amdgcn_readfirstlane(tid >> 6), lane = tid & 63, wr = wid >> 2, wc = wid & 3, fr = lane & 15, fq = lane >> 4;
    const int K = g.K, nt = K / BK;
    unsigned voffA[2], voffB[2];
#pragma unroll
    for (int i = 0; i < 2; ++i) { int R, C; stage_rc(tid * 16 + i * 8192, R, C); const int Rb = Epi::PERM ? ((R & ~31) + perm32(R & 31)) : R;
        voffA[i] = (unsigned)(R * g.lda + C) * 2u; voffB[i] = (unsigned)(Rb * K + C) * 2u; }
    const size_t kstep = (size_t)(BK * 2);
    const size_t hstepA = (size_t)HALF * g.lda * 2, hstepB = (size_t)HALF * K * 2;
    const size_t tstepA = 2 * hstepA, tstepB = 2 * hstepB, pnoffA = (size_t)g.a_pn_off * 2;
    const unsigned ldsw = (unsigned)wid * 1024u;
    const int aoff = lds_byte(wr * 64 + fr, fq * 8), boff = lds_byte(wc * 32 + fr, fq * 8);
#define PG8_SA(b, h) (((b) * 2 + (h)) * HTB)
#define PG8_SB(b, h) ((4 + (b) * 2 + (h)) * HTB)
#define PG8_STAGE(bufoff, gbase, voff) do { _Pragma("unroll") for (int _i = 0; _i < 2; ++_i) \
        __builtin_amdgcn_global_load_lds((const unsigned*)((const char*)(gbase) + (voff)[_i]), (PG8_LAS unsigned*)(lds + (bufoff) + ldsw + _i * 8192), 16, 0, 0); } while (0)
#define PG8_LDA(dst, b, h) do { _Pragma("unroll") for (int m = 0; m < 4; ++m) _Pragma("unroll") for (int k = 0; k < 2; ++k) dst[m][k] = *(const PG8_LAS bf16x8*)(lds + PG8_SA(b, h) + aoff + m * 2048 + k * 1024); } while (0)
#define PG8_LDB(dst, b, h) do { _Pragma("unroll") for (int n = 0; n < 2; ++n) _Pragma("unroll") for (int k = 0; k < 2; ++k) dst[n][k] = *(const PG8_LAS bf16x8*)(lds + PG8_SB(b, h) + boff + n * 2048 + k * 1024); } while (0)
#define PG8_MMA(ai, bj, At, Bt) do { __builtin_amdgcn_s_setprio(1); _Pragma("unroll") for (int m = 0; m < 4; ++m) _Pragma("unroll") for (int n = 0; n < 2; ++n) _Pragma("unroll") for (int k = 0; k < 2; ++k) \
        acc[ai][bj][m][n] = __builtin_amdgcn_mfma_f32_16x16x32_bf16(Bt[n][k], At[m][k], acc[ai][bj][m][n], 0, 0, 0); __builtin_amdgcn_s_setprio(0); } while (0)
#define PG8_WAIT_V(n) asm volatile("s_waitcnt vmcnt(" #n ")" ::: "memory")
#define PG8_WAIT_L(n) asm volatile("s_waitcnt lgkmcnt(" #n ")" ::: "memory")
#define PG8_BAR __builtin_amdgcn_s_barrier()
#define PG8_SCHED __builtin_amdgcn_sched_barrier(0)
    Unit cur, nxt; int ui = 0;
    if (!S.next(0, cur)) return;
    f32x4 acc[2][2][4][2];
#pragma unroll
    for (int a = 0; a < 2; ++a)
#pragma unroll
        for (int b = 0; b < 2; ++b)
#pragma unroll
            for (int m = 0; m < 4; ++m)
#pragma unroll
                for (int n = 0; n < 2; ++n) acc[a][b][m][n] = (f32x4){0.f, 0.f, 0.f, 0.f};
    bf16x8 At[4][2], B0[2][2], B1[2][2];
    const char* cA = (const char*)g.A + (size_t)cur.pm * tstepA + (size_t)cur.pn * pnoffA; const char* cB = (const char*)g.Bt + (size_t)cur.pn * tstepB;
    S.a_ready(cur);
    if constexpr (SP2) {
        PG8_STAGE(PG8_SB(0, 0), cB, voffB); PG8_STAGE(PG8_SB(0, 1), cB + hstepB, voffB); PG8_STAGE(PG8_SA(0, 0), cA, voffA); PG8_STAGE(PG8_SA(0, 1), cA + hstepA, voffA);
        if (wr == 1) PG8_BAR;
        PG8_WAIT_V(2); PG8_BAR;
        PG8_STAGE(PG8_SB(1, 0), cB + kstep, voffB); PG8_STAGE(PG8_SA(1, 0), cA + kstep, voffA); PG8_STAGE(PG8_SB(1, 1), cB + hstepB + kstep, voffB);
        PG8_WAIT_V(6); PG8_BAR;
    } else {
        PG8_STAGE(PG8_SB(0, 0), cB, voffB); PG8_STAGE(PG8_SA(0, 0), cA, voffA); PG8_STAGE(PG8_SB(0, 1), cB + hstepB, voffB); PG8_STAGE(PG8_SA(0, 1), cA + hstepA, voffA);
        if (wr == 1) PG8_BAR;
        PG8_WAIT_V(4); PG8_BAR;
        PG8_STAGE(PG8_SB(1, 0), cB + kstep, voffB); PG8_STAGE(PG8_SA(1, 0), cA + kstep, voffA); PG8_STAGE(PG8_SB(1, 1), cB + hstepB + kstep, voffB);
        PG8_WAIT_V(6); PG8_BAR;
    }
    for (;;) {
        const bool has_next = S.next(ui + 1, nxt);
        const char* nA = has_next ? (const char*)g.A + (size_t)nxt.pm * tstepA + (size_t)nxt.pn * pnoffA : cA; const char* nB = has_next ? (const char*)g.Bt + (size_t)nxt.pn * tstepB : cB;
        for (int t = 0; t < nt; t += 2) {
            const bool last = (t == nt - 2);
            const char* a1 = cA + (size_t)(t + 1) * kstep;
            const char* a2 = last ? nA : cA + (size_t)(t + 2) * kstep; const char* b2 = last ? nB : cB + (size_t)(t + 2) * kstep;
            const char* a3 = a2 + kstep; const char* b3 = b2 + kstep;
            if (last && has_next) S.a_ready(nxt);
            if constexpr (SP2) {
            PG8_LDB(B0, 0, 0); PG8_LDB(B1, 0, 1); PG8_SCHED; PG8_LDA(At, 0, 0); PG8_STAGE(PG8_SA(1, 1), a1 + hstepA, voffA);
            PG8_WAIT_V(8); PG8_WAIT_L(0); PG8_BAR; PG8_MMA(0, 0, At, B0); PG8_MMA(0, 1, At, B1); PG8_BAR; PG8_SCHED;
            PG8_LDA(At, 0, 1); PG8_STAGE(PG8_SB(0, 0), b2, voffB); PG8_STAGE(PG8_SB(0, 1), b2 + hstepB, voffB); PG8_STAGE(PG8_SA(0, 0), a2, voffA);
            PG8_WAIT_V(8); PG8_WAIT_L(0); PG8_BAR; PG8_MMA(1, 0, At, B0); PG8_MMA(1, 1, At, B1); PG8_BAR; PG8_SCHED;
            PG8_LDB(B0, 1, 0); PG8_LDB(B1, 1, 1); PG8_SCHED; PG8_LDA(At, 1, 0); PG8_STAGE(PG8_SA(0, 1), a2 + hstepA, voffA);
            PG8_WAIT_V(8); PG8_WAIT_L(0); PG8_BAR; PG8_MMA(0, 0, At, B0); PG8_MMA(0, 1, At, B1); PG8_BAR; PG8_SCHED;
            PG8_LDA(At, 1, 1); PG8_STAGE(PG8_SB(1, 0), b3, voffB); PG8_STAGE(PG8_SB(1, 1), b3 + hstepB, voffB); PG8_STAGE(PG8_SA(1, 0), a3, voffA);
            PG8_WAIT_V(8); PG8_WAIT_L(0); PG8_BAR; PG8_MMA(1, 0, At, B0); PG8_MMA(1, 1, At, B1); PG8_BAR; PG8_SCHED;
            } else {
            PG8_LDB(B0, 0, 0); PG8_SCHED; PG8_LDA(At, 0, 0); PG8_STAGE(PG8_SA(1, 1), a1 + hstepA, voffA);
            PG8_WAIT_L(8); PG8_BAR; PG8_WAIT_L(0); PG8_MMA(0, 0, At, B0); PG8_BAR; PG8_SCHED;
            PG8_LDB(B1, 0, 1); PG8_STAGE(PG8_SB(0, 0), b2, voffB);
            PG8_BAR; PG8_WAIT_L(0); PG8_MMA(0, 1, At, B1); PG8_BAR;
            PG8_LDA(At, 0, 1); PG8_STAGE(PG8_SA(0, 0), a2, voffA);
            PG8_BAR; PG8_WAIT_L(0); PG8_MMA(1, 0, At, B0); PG8_BAR; PG8_SCHED;
            PG8_STAGE(PG8_SB(0, 1), b2 + hstepB, voffB);
            PG8_WAIT_V(6); PG8_BAR; PG8_MMA(1, 1, At, B1); PG8_BAR;
            PG8_LDB(B0, 1, 0); PG8_SCHED; PG8_LDA(At, 1, 0); PG8_STAGE(PG8_SA(0, 1), a2 + hstepA, voffA);
            PG8_WAIT_L(8); PG8_BAR; PG8_WAIT_L(0); PG8_MMA(0, 0, At, B0); PG8_BAR; PG8_SCHED;
            PG8_LDB(B1, 1, 1); PG8_STAGE(PG8_SB(1, 0), b3, voffB);
            PG8_BAR; PG8_WAIT_L(0); PG8_MMA(0, 1, At, B1); PG8_BAR;
            PG8_LDA(At, 1, 1); PG8_STAGE(PG8_SA(1, 0), a3, voffA);
            PG8_BAR; PG8_WAIT_L(0); PG8_MMA(1, 0, At, B0); PG8_BAR; PG8_SCHED;
            PG8_STAGE(PG8_SB(1, 1), b3 + hstepB, voffB);
            PG8_WAIT_V(6); PG8_BAR; PG8_MMA(1, 1, At, B1); PG8_BAR;
            }
        }
        if constexpr (ALIGN_EPI) { if (wr == 0) PG8_BAR; }
        if constexpr (!Epi::AFTER_DRAIN) { E(acc, cur, wr, wc, fr, fq); S.done(cur); }
        if (!has_next) break;
#pragma unroll
        for (int a = 0; a < 2; ++a)
#pragma unroll
            for (int b = 0; b < 2; ++b)
#pragma unroll
                for (int m = 0; m < 4; ++m)
#pragma unroll
                    for (int n = 0; n < 2; ++n) acc[a][b][m][n] = (f32x4){0.f, 0.f, 0.f, 0.f};
        cur = nxt; cA = nA; cB = nB; ++ui;
        if constexpr (ALIGN_EPI) { if (wr == 1) PG8_BAR; }
    }
    PG8_WAIT_V(0);
    if constexpr (!ALIGN_EPI) { if (wr == 0) PG8_BAR; }
    PG8_BAR;
    if constexpr (Epi::AFTER_DRAIN) { E.fused(acc, cur, wr, wc, fr, fq, lds, wid, lane); S.done(cur); }
#undef PG8_SA
#undef PG8_SB
#undef PG8_STAGE
#undef PG8_LDA
#undef PG8_LDB
#undef PG8_MMA
#undef PG8_WAIT_V
#undef PG8_WAIT_L
#undef PG8_BAR
#undef PG8_SCHED
}
}

#define LAS __attribute__((address_space(3)))
typedef unsigned short bf16_t;
typedef short bf16x8 __attribute__((ext_vector_type(8)));
typedef short s16x4 __attribute__((ext_vector_type(4)));
typedef float f32x4 __attribute__((ext_vector_type(4)));
typedef unsigned u32x4 __attribute__((ext_vector_type(4)));
typedef unsigned u32x2 __attribute__((ext_vector_type(2)));
using pg8::cvt_pk_bf16; using pg8::bflo; using pg8::bfhi; using pg8::fsigmoid;

constexpr int DM = 1024, NBATCH = 8, SEQ = 4096, TT = NBATCH * SEQ, NIN = 11272, NP = 11264, FF = 2816;
constexpr int GB = 4, TG = GB * SEQ, NGRP = NBATCH / GB;
constexpr int NBH = GB * 4;
constexpr int LDS_BYTES = 147456;
constexpr int NTHR = 512;
constexpr int PP = 1024;
#define SEC(C) ((size_t)((C) / 1024) * ((size_t)TG * 1024) + (size_t)((C) % 1024))
constexpr int C_MQ = 0, C_MK = 1024, C_MV = 2048, C_MO = 3072, C_PU = 4096, C_AQ = 5120, C_AK = 6144, C_AV = 7168, C_GT = 8192;
constexpr size_t MiB = 1u << 20;
constexpr size_t WS_ROPE = 1 * MiB;
constexpr size_t WS_WIN = 2 * MiB, WS_WMO = 24 * MiB, WS_WPOOL = 26 * MiB, WS_WDIFF = 27 * MiB, WS_WOUT = 29 * MiB, WS_WGU = 31 * MiB, WS_WDN = 42 * MiB;
constexpr size_t WS_GIF = 48 * MiB;
constexpr size_t WS_MV = 48 * MiB + 512 * 1024;
constexpr size_t WS_NST = 49 * MiB;
constexpr size_t WS_HN = 50 * MiB;
constexpr size_t WS_CST = 82 * MiB;
constexpr size_t WS_PROJ = 146 * MiB;
constexpr size_t WS_END = 498 * MiB;

__device__ __forceinline__ int my_tid() { int t = threadIdx.x; asm volatile("" : "+v"(t)); return t; }
__device__ __forceinline__ float wave_sum(float v) {
#pragma unroll
    for (int o = 1; o < 64; o <<= 1) v += __shfl_xor(v, o);
    return v;
}
__device__ __forceinline__ float wave_max(float v) {
#pragma unroll
    for (int o = 1; o < 64; o <<= 1) v = fmaxf(v, __shfl_xor(v, o));
    return v;
}
typedef short v4i16_t __attribute__((ext_vector_type(4)));
__device__ __forceinline__ s16x4 vtr(const LAS char* p) { return __builtin_bit_cast(s16x4, __builtin_amdgcn_ds_read_tr16_b64_v4i16((LAS v4i16_t*)p)); }
__device__ __forceinline__ bf16x8 trfrag(const LAS char* base, int pitch, int k0, int n0, int lane) {
    const int g = lane >> 4, q = (lane & 15) >> 2, p = lane & 3;
    const LAS char* a = base + (k0 + 4 * g + q) * pitch + (n0 + 4 * p) * 2;
    const s16x4 lo = vtr(a), hi = vtr(a + 16 * pitch);
    return (bf16x8){lo[0], lo[1], lo[2], lo[3], hi[0], hi[1], hi[2], hi[3]};
}
__device__ __forceinline__ bf16x8 rowfrag(const LAS char* base, int pitch, int r0, int c0, int lane) {
    return *(const LAS bf16x8*)(base + (r0 + (lane & 15)) * pitch + (c0 + 8 * (lane >> 4)) * 2);
}
__device__ __forceinline__ bf16x8 rowfrag_perm(const LAS char* base, int pitch, int r0, int c0, int lane) {
    const LAS char* a = base + (r0 + (lane & 15)) * pitch + (c0 + 4 * (lane >> 4)) * 2;
    const s16x4 lo = *(const LAS s16x4*)a, hi = *(const LAS s16x4*)(a + 32);
    return (bf16x8){lo[0], lo[1], lo[2], lo[3], hi[0], hi[1], hi[2], hi[3]};
}
__device__ __forceinline__ f32x4 mfma16(bf16x8 a, bf16x8 b, f32x4 c) { return __builtin_amdgcn_mfma_f32_16x16x32_bf16(a, b, c, 0, 0, 0); }
__device__ __forceinline__ void unpack8(const u32x4 v, float (&f)[8]) {
    f[0] = bflo(v.x); f[1] = bfhi(v.x); f[2] = bflo(v.y); f[3] = bfhi(v.y); f[4] = bflo(v.z); f[5] = bfhi(v.z); f[6] = bflo(v.w); f[7] = bfhi(v.w);
}
__device__ __forceinline__ u32x4 pack8(const float (&f)[8]) {
    u32x4 w; w.x = cvt_pk_bf16(f[0], f[1]); w.y = cvt_pk_bf16(f[2], f[3]); w.z = cvt_pk_bf16(f[4], f[5]); w.w = cvt_pk_bf16(f[6], f[7]); return w;
}
#define LDS_WAIT() asm volatile("s_waitcnt lgkmcnt(0)" ::: "memory")
#define BAR_LDS() do { asm volatile("s_waitcnt lgkmcnt(0)" ::: "memory"); __builtin_amdgcn_s_barrier(); asm volatile("" ::: "memory"); } while (0)

struct Args { const float* in[16]; float* out; unsigned char* ws; int ph_lo, ph_hi; };
#define XB_TMO      128
#define XB_XCNT(j)  (256  + 64 * (j))
#define XB_XSUB(j)  (1280 + 64 * (j))
#define XB_XGEN(j)  (2304 + 64 * (j))
#define XB_TOP      3328
#define XB_TOPGEN   3392
#define XCD_BAR_WORDS 3456
#define XB_SPIN_CAP (1u << 18)

__device__ __forceinline__ unsigned xb_ld(unsigned* p)              { return __hip_atomic_load(p, __ATOMIC_RELAXED, __HIP_MEMORY_SCOPE_AGENT); }
__device__ __forceinline__ unsigned xb_add(unsigned* p, unsigned v) { return __hip_atomic_fetch_add(p, v, __ATOMIC_RELAXED, __HIP_MEMORY_SCOPE_AGENT); }
__device__ __forceinline__ unsigned xb_xcc_id() { return (unsigned)__builtin_amdgcn_s_getreg((3 << 11) | 20) & 0xFu; }
#define XB_SPIN(cond, bar) do { unsigned _sp = 0; while (cond) { __builtin_amdgcn_s_sleep(1); \
    if ((++_sp & 255u) == 0u) { if (xb_ld(&(bar)[XB_TMO])) break; if (_sp > XB_SPIN_CAP) { atomicAdd(&(bar)[XB_TMO], 1u); break; } } } } while (0)

struct XcdBarrier {
    unsigned* bar; unsigned x;
    volatile LAS unsigned* st;
};

__device__ __forceinline__ XcdBarrier xcd_barrier_post(unsigned* bar, volatile LAS unsigned* st) {
    XcdBarrier b; b.bar = bar; b.x = xb_xcc_id(); b.st = st;
    if (threadIdx.x == 0) (void)xb_add(&bar[XB_XCNT(b.x)], 1u);
    return b;
}
__device__ __forceinline__ void xcd_barrier_complete(unsigned* bar, unsigned x, unsigned& nloc, unsigned& nx) {
    const unsigned G = gridDim.x * gridDim.y * gridDim.z;
    unsigned sum, cnt, mine, sp = 0u;
    for (;;) {
        sum = 0u; cnt = 0u; mine = 0u;
#pragma unroll
        for (unsigned j = 0; j < 16; ++j) { const unsigned c = xb_ld(&bar[XB_XCNT(j)]); sum += c; cnt += (c > 0u) ? 1u : 0u; mine = (j == x) ? c : mine; }
        if (sum == G) break;
        __builtin_amdgcn_s_sleep(1);
        if ((++sp & 255u) == 0u) { if (xb_ld(&bar[XB_TMO])) break; if (sp > XB_SPIN_CAP) { atomicAdd(&bar[XB_TMO], 1u); break; } }
    }
    nloc = mine > 0u ? mine : 1u; nx = cnt > 0u ? cnt : 1u;
}

__device__ __forceinline__ void xcd_barrier(const XcdBarrier& b) {
    asm volatile("s_waitcnt vmcnt(0)" ::: "memory");
    __syncthreads();
    if (threadIdx.x == 0) {
        unsigned* bar = b.bar;
        __builtin_amdgcn_s_waitcnt(0);
        unsigned nloc = b.st[0], nx = b.st[1];
        if (nloc == 0u) { xcd_barrier_complete(bar, b.x, nloc, nx); b.st[0] = nloc; b.st[1] = nx; }
        const unsigned old = xb_add(&bar[XB_XSUB(b.x)], 1u);
        const unsigned gen = old / nloc;
        if (old + 1u == (gen + 1u) * nloc) {
            __builtin_amdgcn_fence(__ATOMIC_RELEASE, "agent");
            asm volatile("s_waitcnt vmcnt(0)" ::: "memory");
            const unsigned og = xb_add(&bar[XB_TOP], 1u);
            const unsigned tg = og / nx;
            if (og + 1u == (tg + 1u) * nx) xb_add(&bar[XB_TOPGEN], 1u);
            else XB_SPIN(xb_ld(&bar[XB_TOPGEN]) == tg, bar);
            __builtin_amdgcn_fence(__ATOMIC_ACQUIRE, "agent");
            xb_add(&bar[XB_XGEN(b.x)], 1u);
            asm volatile("s_waitcnt vmcnt(0)" ::: "memory");
        } else {
            XB_SPIN(xb_ld(&bar[XB_XGEN(b.x)]) == gen, bar);
            __builtin_amdgcn_fence(__ATOMIC_ACQUIRE, "agent");
            asm volatile("s_waitcnt vmcnt(0)" ::: "memory");
        }
    }
    __syncthreads();
}


__device__ __forceinline__ void cvt_item(const float* W, int ldw, int k0, int srccol0, bf16_t* WT, int K, int dstrow0, const float* rowscale, LAS float* scr, int lane) {
#pragma unroll 8
    for (int i = 0; i < 32; ++i) { const int kk = 2 * i + (lane >> 5); scr[kk * 33 + (lane & 31)] = W[(size_t)(k0 + kk) * ldw + srccol0 + (lane & 31)]; }
    LDS_WAIT();
    const int c = lane & 7;
#pragma unroll
    for (int j = 0; j < 4; ++j) { const int n = (lane >> 3) + 8 * j; const LAS float* s = scr + (8 * c) * 33 + n;
        const float sc = rowscale ? rowscale[n] : 1.0f;
        u32x4 o; o.x = cvt_pk_bf16(s[0 * 33] * sc, s[1 * 33] * sc); o.y = cvt_pk_bf16(s[2 * 33] * sc, s[3 * 33] * sc); o.z = cvt_pk_bf16(s[4 * 33] * sc, s[5 * 33] * sc); o.w = cvt_pk_bf16(s[6 * 33] * sc, s[7 * 33] * sc);
        *(u32x4*)(WT + (size_t)(dstrow0 + n) * K + k0 + 8 * c) = o; }
    LDS_WAIT();
}
__device__ __forceinline__ void phase_weights(const Args& a, int l, LAS unsigned char* lds) {
    const int tid = my_tid(), lane = tid & 63, wave = tid >> 6;
    LAS float* scr = (LAS float*)(lds + wave * 8704);
    const int gw = blockIdx.x * 8 + wave, NGW = gridDim.x * 8;
    unsigned char* ws = a.ws;
    const float* w_in = a.in[2] + (size_t)l * DM * NIN;
    const float* w_mo = a.in[5] + (size_t)l * DM * DM;
    const float* w_pool = a.in[6] + (size_t)l * 4 * 256 * 256;
    const float* pscale = a.in[7] + (size_t)l * DM;
    const float* w_diff = a.in[11] + (size_t)l * DM * DM;
    const float* w_out = a.in[12] + (size_t)l * DM * DM;
    const float* w_gu = a.in[14] + (size_t)l * DM * 2 * FF;
    const float* w_dn = a.in[15] + (size_t)l * FF * DM;
    constexpr int I0 = 16 * (NP / 32), I1 = 16 * 32, I2 = 4 * 4 * 8, I3 = I1, I4 = I1, I5 = 16 * (2 * FF / 32), I6 = (FF / 64) * 32;
    constexpr int NIT = I0 + I1 + I2 + I3 + I4 + I5 + I6;
    for (int it = gw; it < NIT; it += NGW) {
        int r = it;
        if (r < I0) { const int nb = r % (NP / 32), kb = r / (NP / 32), n0 = nb * 32; cvt_item(w_in, NIN, kb * 64, n0 < 4096 ? n0 : n0 + 8, (bf16_t*)(ws + WS_WIN), DM, n0, nullptr, scr, lane); continue; } r -= I0;
        if (r < I1) { const int nb = r % 32, kb = r / 32; cvt_item(w_mo, DM, kb * 64, nb * 32, (bf16_t*)(ws + WS_WMO), DM, nb * 32, nullptr, scr, lane); continue; } r -= I1;
        if (r < I2) { const int g = r / 32, q = r % 32, nb = q % 8, kb = q / 8; cvt_item(w_pool + g * 65536, 256, kb * 64, nb * 32, (bf16_t*)(ws + WS_WPOOL), 256, g * 256 + nb * 32, pscale + g * 256 + nb * 32, scr, lane); continue; } r -= I2;
        if (r < I3) { const int nb = r % 32, kb = r / 32; cvt_item(w_diff, DM, kb * 64, nb * 32, (bf16_t*)(ws + WS_WDIFF), DM, nb * 32, nullptr, scr, lane); continue; } r -= I3;
        if (r < I4) { const int nb = r % 32, kb = r / 32; cvt_item(w_out, DM, kb * 64, nb * 32, (bf16_t*)(ws + WS_WOUT), DM, nb * 32, nullptr, scr, lane); continue; } r -= I4;
        if (r < I5) { const int nb = r % (2 * FF / 32), kb = r / (2 * FF / 32), n0 = nb * 32, pn = n0 >> 8, wi = n0 & 255;
            const int sc0 = wi < 128 ? 128 * pn + wi : FF + 128 * pn + (wi - 128);
            cvt_item(w_gu, 2 * FF, kb * 64, sc0, (bf16_t*)(ws + WS_WGU), DM, n0, nullptr, scr, lane); continue; } r -= I5;
        { const int nb = r % 32, kb = r / 32; cvt_item(w_dn, DM, kb * 64, nb * 32, (bf16_t*)(ws + WS_WDN), FF, nb * 32, nullptr, scr, lane); }
    }
    if (l == 0) {
        float2* tab = (float2*)(ws + WS_ROPE);
        for (int e = blockIdx.x * NTHR + tid; e < SEQ * 32; e += gridDim.x * NTHR) {
            const int pos = e >> 5, i = e & 31;
            double inv = 1.0; const double rr = 0.74989420933245582730;
            for (int j = 0; j < i; ++j) inv *= rr;
            const double t2 = inv * inv; double cs = 1.0, sn = inv, tc = 1.0, tsn = inv;
#pragma unroll
            for (int n = 1; n <= 12; ++n) { tc *= -t2 / (double)((2 * n - 1) * (2 * n)); cs += tc; tsn *= -t2 / (double)((2 * n) * (2 * n + 1)); sn += tsn; }
            double zr = 1.0, zi = 0.0, br = cs, bi = sn;
            for (int b = 0; b < 12; ++b) { if ((pos >> b) & 1) { const double nr = zr * br - zi * bi, ni = zr * bi + zi * br; zr = nr; zi = ni; } const double sr = br * br - bi * bi, si = 2.0 * br * bi; br = sr; bi = si; }
            tab[e] = make_float2((float)zr, (float)zi);
        }
    }
}

template <bool GATES>
__device__ __forceinline__ void phase_norm(const float* x, const float* gain, bf16_t* hn, int nrows, const float* w_in_l, const float* bif, float* gif, LAS unsigned char* lds) {
    const int tid = my_tid(), lane = tid & 63, wave = tid >> 6;
    LAS float* wif = (LAS float*)lds;
    f32x4 wr[GATES ? 8 : 1][4];
    if (GATES) {
        for (int i = 0; i < 16; ++i) { const int idx = tid + NTHR * i, k = idx >> 3, e = idx & 7; wif[e * 1024 + k] = w_in_l[(size_t)k * NIN + 4096 + e]; }
        __syncthreads();
#pragma unroll
        for (int e = 0; e < 8; ++e)
#pragma unroll
            for (int j = 0; j < 4; ++j) wr[e][j] = *(const LAS f32x4*)(wif + e * 1024 + 4 * lane + 256 * j);
    }
    const int gw = blockIdx.x * 8 + wave, NGW = gridDim.x * 8;
    f32x4 gv[4];
#pragma unroll
    for (int j = 0; j < 4; ++j) gv[j] = *(const f32x4*)(gain + 4 * lane + 256 * j);
    f32x4 v[4], nx[4];
    if (gw < nrows) { const f32x4* xr = (const f32x4*)(x + (size_t)gw * DM) + lane;
#pragma unroll
        for (int j = 0; j < 4; ++j) nx[j] = xr[64 * j]; }
    for (int row = gw; row < nrows; row += NGW) {
        float ss = 0.f;
#pragma unroll
        for (int j = 0; j < 4; ++j) v[j] = nx[j];
        if (row + NGW < nrows) { const f32x4* xr = (const f32x4*)(x + (size_t)(row + NGW) * DM) + lane;
#pragma unroll
            for (int j = 0; j < 4; ++j) nx[j] = xr[64 * j]; }
#pragma unroll
        for (int j = 0; j < 4; ++j) ss += (v[j].x * v[j].x + v[j].y * v[j].y) + (v[j].z * v[j].z + v[j].w * v[j].w);
        const float rstd = 1.0f / sqrtf(wave_sum(ss) * (1.0f / DM) + 1e-6f);
        u32x2* o8 = (u32x2*)(hn + (size_t)row * DM) + lane;
#pragma unroll
        for (int j = 0; j < 4; ++j) { v[j] = v[j] * rstd * gv[j]; u32x2 w; w.x = cvt_pk_bf16(v[j].x, v[j].y); w.y = cvt_pk_bf16(v[j].z, v[j].w); o8[64 * j] = w; }
        if (GATES) {
            float ga[8];
#pragma unroll
            for (int e = 0; e < 8; ++e) { float s = 0.f;
#pragma unroll
                for (int j = 0; j < 4; ++j) { const f32x4 w = wr[e][j]; s += (v[j].x * w.x + v[j].y * w.y) + (v[j].z * w.z + v[j].w * w.w); }
                ga[e] = s; }
            float h4[4], h2[2], h1;
            { const bool up = (lane & 32) != 0;
#pragma unroll
              for (int i = 0; i < 4; ++i) { const float mine = up ? ga[4 + i] : ga[i], other = up ? ga[i] : ga[4 + i]; h4[i] = mine + __shfl_xor(other, 32); } }
            { const bool up = (lane & 16) != 0;
#pragma unroll
              for (int i = 0; i < 2; ++i) { const float mine = up ? h4[2 + i] : h4[i], other = up ? h4[i] : h4[2 + i]; h2[i] = mine + __shfl_xor(other, 16); } }
            { const bool up = (lane & 8) != 0; const float mine = up ? h2[1] : h2[0], other = up ? h2[0] : h2[1]; h1 = mine + __shfl_xor(other, 8); }
            h1 += __shfl_xor(h1, 4); h1 += __shfl_xor(h1, 2); h1 += __shfl_xor(h1, 1);
            if ((lane & 7) == 0) {
                const int e = 4 * (lane >> 5) + 2 * ((lane >> 4) & 1) + ((lane >> 3) & 1);
                const float pre = h1 + bif[e];
                gif[(size_t)row * 8 + e] = (e < 4) ? pre : (fminf(pre, 0.f) - log1pf(__expf(-fabsf(pre))));
            }
        }
    }
    __syncthreads();
}

constexpr int PIT = 544;
constexpr int XOFF = 0, YOFF = 128 * PIT, VECOFF = 2 * 128 * PIT;
__device__ __forceinline__ void load_plain(LAS char* dst, const bf16_t* src, size_t gpitch, int tid) {
#pragma unroll
    for (int i = 0; i < 8; ++i) { const int id = tid + NTHR * i, row = id >> 5, cc = id & 31;
        const u32x4 v = *(const u32x4*)(src + (size_t)row * gpitch + cc * 8);
        *(LAS u32x4*)(dst + row * PIT + cc * 16) = v; }
}
__device__ __forceinline__ void load_plain_issue(u32x4 (&pre)[8], const bf16_t* src, size_t gpitch, int tid) {
#pragma unroll
    for (int i = 0; i < 8; ++i) { const int id = tid + NTHR * i, row = id >> 5, cc = id & 31; pre[i] = *(const u32x4*)(src + (size_t)row * gpitch + cc * 8); }
}
__device__ __forceinline__ void load_plain_commit(LAS char* dst, const u32x4 (&pre)[8], int tid) {
#pragma unroll
    for (int i = 0; i < 8; ++i) { const int id = tid + NTHR * i, row = id >> 5, cc = id & 31; *(LAS u32x4*)(dst + row * PIT + cc * 16) = pre[i]; }
}
__device__ __forceinline__ void load_conv(LAS char* dst, const bf16_t* src, int pos0, const float* cw  , const LAS float* rowscale, float cscale, int tid) {
    const int cg = tid & 31, rs = tid >> 5, r0 = rs * 8;
    u32x4 rw[11];
#pragma unroll
    for (int j = 0; j < 11; ++j) { const int rr = r0 - 3 + j;
        if (j >= 3 || pos0 + rr >= 0) rw[j] = *(const u32x4*)(src + (ptrdiff_t)rr * PP + cg * 8); else rw[j] = (u32x4){0u, 0u, 0u, 0u}; }
    float w[4][8];
#pragma unroll
    for (int j = 0; j < 4; ++j) { const f32x4 a = *(const f32x4*)(cw + j * 2048 + cg * 8), b = *(const f32x4*)(cw + j * 2048 + cg * 8 + 4);
        w[j][0] = a.x; w[j][1] = a.y; w[j][2] = a.z; w[j][3] = a.w; w[j][4] = b.x; w[j][5] = b.y; w[j][6] = b.z; w[j][7] = b.w; }
    float sc8[8];
#pragma unroll
    for (int r = 0; r < 8; ++r) sc8[r] = rowscale ? rowscale[r0 + r] : cscale;
    float u[3][8];
#pragma unroll
    for (int j = 0; j < 3; ++j) unpack8(rw[j], u[j]);
#pragma unroll
    for (int r = 0; r < 8; ++r) {
        float x[8]; unpack8(rw[3 + r], x);
        const float sc = sc8[r];
        float o[8];
#pragma unroll
        for (int e = 0; e < 8; ++e) { const float cv = (w[0][e] * u[0][e] + w[1][e] * u[1][e]) + (w[2][e] * u[2][e] + w[3][e] * x[e]); o[e] = cv * fsigmoid(cv) * sc;
            u[0][e] = u[1][e]; u[1][e] = u[2][e]; u[2][e] = x[e]; }
        *(LAS u32x4*)(dst + (r0 + r) * PIT + cg * 16) = pack8(o);
    }
}
__device__ __forceinline__ void load_gates(LAS float* vec, const float* gif, int t0, int h, int tid) {
    LAS float* li = vec; LAS float* bc = vec + 128; LAS float* tot = vec + 256;
    const int lane = tid & 63;
    float v = 0.f;
    if (tid < 128) { li[tid] = gif[(size_t)(t0 + tid) * 8 + h]; v = gif[(size_t)(t0 + tid) * 8 + 4 + h];
#pragma unroll
        for (int o = 1; o < 64; o <<= 1) { const float uu = __shfl_up(v, o); if (lane >= o) v += uu; }
        if (tid == 63) tot[0] = v; }
    __syncthreads();
    if (tid < 128) { if (tid >= 64) v += tot[0]; bc[tid] = v; }
}

__device__ __forceinline__ void m1_item(LAS char* lds, const bf16_t* proj, const float* gif, bf16_t* Cst, float* nst, float* gch, float* mloc, const float* convw, int bhl, int c) {
    const int tid = my_tid(), lane = tid & 63, wid = __builtin_amdgcn_readfirstlane(tid >> 6), g = lane >> 4, fr = lane & 15;
    const int bl = bhl >> 2, h = bhl & 3, item = bhl * 32 + c, t0 = bl * SEQ + c * 128;
    LAS char* X = lds + XOFF; LAS char* Y = lds + YOFF; LAS float* vec = (LAS float*)(lds + VECOFF);
    LAS float* li = vec; LAS float* bc = vec + 128; LAS float* es = vec + 272;
    load_gates(vec, gif, t0, h, tid);
    __syncthreads();
    const float gtot = bc[127];
    const float w0 = gtot - bc[lane] + li[lane], w1 = gtot - bc[lane + 64] + li[lane + 64];
    const float ml = wave_max(fmaxf(w0, w1));
    if (tid < 128) es[tid] = __expf(gtot - bc[tid] + li[tid] - ml);
    if (tid == 0) { gch[item] = gtot; mloc[item] = ml; }
    __syncthreads();
    { u32x4 pv[8]; load_plain_issue(pv, proj + SEC(C_MV) + (size_t)t0 * PP + h * 256, PP, tid);
      load_conv(X, proj + SEC(C_MK) + (size_t)t0 * PP + h * 256, c * 128, convw + 1024 + h * 256, es, 1.0f, tid);
      load_plain_commit(Y, pv, tid); }
    __syncthreads();
    { float sn = 0.f; const LAS char* xc = X + ((tid >> 8) * 64) * PIT + (tid & 255) * 2;
#pragma unroll 16
        for (int r = 0; r < 64; ++r) sn += __uint_as_float((unsigned)(*(const LAS unsigned short*)(xc + r * PIT)) << 16);
        vec[400 + tid] = sn; }
    bf16_t* Co = Cst + (size_t)item * 65536;
#pragma unroll 1
    for (int hk = 0; hk < 2; ++hk) {
        f32x4 acc[2][8];
#pragma unroll
        for (int i = 0; i < 2; ++i)
#pragma unroll
            for (int j = 0; j < 8; ++j) acc[i][j] = (f32x4){0.f, 0.f, 0.f, 0.f};
        const LAS char* Xh = X + hk * 256;
#pragma unroll 1
        for (int t = 0; t < 4; ++t) {
            const bf16x8 v0 = trfrag(Y, PIT, 32 * t, 16 * (2 * wid), lane), v1 = trfrag(Y, PIT, 32 * t, 16 * (2 * wid + 1), lane);
            bf16x8 kf[8];
#pragma unroll
            for (int kb = 0; kb < 8; ++kb) kf[kb] = trfrag(Xh, PIT, 32 * t, 16 * kb, lane);
            __builtin_amdgcn_sched_barrier(0);
#pragma unroll
            for (int kb = 0; kb < 8; ++kb) { acc[0][kb] = mfma16(v0, kf[kb], acc[0][kb]); acc[1][kb] = mfma16(v1, kf[kb], acc[1][kb]); }
        }
#pragma unroll
        for (int i = 0; i < 2; ++i)
#pragma unroll
            for (int kb = 0; kb < 8; ++kb) { u32x2 w; w.x = cvt_pk_bf16(acc[i][kb][0], acc[i][kb][1]); w.y = cvt_pk_bf16(acc[i][kb][2], acc[i][kb][3]);
                *(u32x2*)(Co + (size_t)(128 * hk + 16 * kb + fr) * 256 + 16 * (2 * wid + i) + 4 * g) = w; }
    }
    __syncthreads();
    if (tid < 256) nst[(size_t)item * 256 + tid] = vec[400 + tid] + vec[656 + tid];
    __syncthreads();
}

__device__ __forceinline__ void phase_scan(bf16_t* Cst, float* nst, const float* gch, const float* mloc, float* mprev) {
    const int tid = my_tid();
    for (int i = blockIdx.x * NTHR + tid; i < NBH * 8192 + NBH * 256; i += gridDim.x * NTHR) {
        if (i < NBH * 8192) {
            const int bh = i >> 13, e8 = i & 8191;
            float st[8];
#pragma unroll
            for (int e = 0; e < 8; ++e) st[e] = 0.f;
            float m = -1e30f;
            for (int c0 = 0; c0 < 32; c0 += 8) {
                u32x4 ld[8];
#pragma unroll
                for (int j = 0; j < 8; ++j) ld[j] = *(const u32x4*)(Cst + ((size_t)(bh * 32 + c0 + j) * 65536 + e8 * 8));
#pragma unroll
                for (int j = 0; j < 8; ++j) { const int c = c0 + j; const float gc = gch[bh * 32 + c], mc = mloc[bh * 32 + c];
                    const float mn = fmaxf(gc + m, mc), aa = __expf(gc + m - mn), bb = __expf(mc - mn);
                    float lc[8]; unpack8(ld[j], lc);
                    *(u32x4*)(Cst + ((size_t)(bh * 32 + c) * 65536 + e8 * 8)) = pack8(st);
#pragma unroll
                    for (int e = 0; e < 8; ++e) st[e] = aa * st[e] + bb * lc[e];
                    if (e8 == 0) mprev[bh * 32 + c] = m;
                    m = mn; }
            }
        } else {
            const int j = i - NBH * 8192, bh = j >> 8, k = j & 255;
            float st = 0.f, m = -1e30f;
            for (int c = 0; c < 32; ++c) { const float gc = gch[bh * 32 + c], mc = mloc[bh * 32 + c];
                const float mn = fmaxf(gc + m, mc), aa = __expf(gc + m - mn), bb = __expf(mc - mn);
                const size_t o = (size_t)(bh * 32 + c) * 256 + k; const float lc = nst[o]; nst[o] = st; st = aa * st + bb * lc; m = mn; }
        }
    }
}

__device__ __forceinline__ void m3_item(LAS char* lds, bf16_t* proj, const float* gif, const bf16_t* Cst, const float* nst, const float* mprev, const float* convw, int bhl, int c) {
    const int tid = my_tid(), lane = tid & 63, wid = __builtin_amdgcn_readfirstlane(tid >> 6), g = lane >> 4, fr = lane & 15;
    const int bl = bhl >> 2, h = bhl & 3, item = bhl * 32 + c, t0 = bl * SEQ + c * 128;
    LAS char* X = lds + XOFF; LAS char* Y = lds + YOFF; LAS float* vec = (LAS float*)(lds + VECOFF);
    LAS float* li = vec; LAS float* bc = vec + 128; LAS float* npv = vec + 272;
    load_gates(vec, gif, t0, h, tid);
    if (tid < 256) npv[tid] = nst[(size_t)item * 256 + tid];
    load_conv(X, proj + SEC(C_MQ) + (size_t)t0 * PP + h * 256, c * 128, convw + h * 256, nullptr, 0.0625f, tid);
    load_conv(Y, proj + SEC(C_MK) + (size_t)t0 * PP + h * 256, c * 128, convw + 1024 + h * 256, nullptr, 1.0f, tid);
    __syncthreads();
    const int j0 = 16 * wid, jj = j0 + fr;
    bf16x8 pf[4]; float den, inter, mt;
    u32x4 pre[8];
    load_plain_issue(pre, Cst + (size_t)item * 65536, 256, tid);
    {
        f32x4 S[8];
#pragma unroll
        for (int sb = 0; sb < 8; ++sb) S[sb] = (f32x4){0.f, 0.f, 0.f, 0.f};
#pragma unroll 1
        for (int t = 0; t < 8; ++t) { const bf16x8 qb = rowfrag(X, PIT, j0, 32 * t, lane);
            bf16x8 kf[8];
#pragma unroll
            for (int sb = 0; sb < 8; ++sb) kf[sb] = rowfrag(Y, PIT, 16 * sb, 32 * t, lane);
            __builtin_amdgcn_sched_barrier(0);
#pragma unroll
            for (int sb = 0; sb < 8; ++sb) S[sb] = mfma16(kf[sb], qb, S[sb]); }
        float qn = 0.f;
        { const LAS char* qr = X + jj * PIT + (64 * g) * 2;
#pragma unroll 2
            for (int i = 0; i < 8; ++i) { const u32x4 v = *(const LAS u32x4*)(qr + 16 * i); float f[8]; unpack8(v, f);
                const f32x4 n0 = *(const LAS f32x4*)(npv + 64 * g + 8 * i), n1 = *(const LAS f32x4*)(npv + 64 * g + 8 * i + 4);
                qn += (f[0] * n0.x + f[1] * n0.y) + (f[2] * n0.z + f[3] * n0.w) + (f[4] * n1.x + f[5] * n1.y) + (f[6] * n1.z + f[7] * n1.w); } }
        qn += __shfl_xor(qn, 16); qn += __shfl_xor(qn, 32);
        const float bj = bc[jj], mp = mprev[item];
        float rmax = -INFINITY;
#pragma unroll
        for (int sb = 0; sb < 8; ++sb) { const f32x4 b4 = *(const LAS f32x4*)(bc + 16 * sb + 4 * g), l4 = *(const LAS f32x4*)(li + 16 * sb + 4 * g);
#pragma unroll
            for (int r = 0; r < 4; ++r) { const int s = 16 * sb + 4 * g + r; const float dm = (s <= jj) ? (bj - b4[r] + l4[r]) : -INFINITY; rmax = fmaxf(rmax, dm); } }
        rmax = fmaxf(rmax, __shfl_xor(rmax, 16)); rmax = fmaxf(rmax, __shfl_xor(rmax, 32));
        const float minter = bj + mp; mt = fmaxf(minter, rmax); inter = __expf(minter - mt);
        den = 0.f;
#pragma unroll
        for (int sb = 0; sb < 8; ++sb) { const f32x4 b4 = *(const LAS f32x4*)(bc + 16 * sb + 4 * g), l4 = *(const LAS f32x4*)(li + 16 * sb + 4 * g);
#pragma unroll
            for (int r = 0; r < 4; ++r) { const int s = 16 * sb + 4 * g + r; const float p = (s <= jj) ? __expf(bj - b4[r] + l4[r] - mt) : 0.f; const float v = S[sb][r] * p; S[sb][r] = v; den += v; } }
        den += __shfl_xor(den, 16); den += __shfl_xor(den, 32);
        den += inter * qn;
#pragma unroll
        for (int t = 0; t < 4; ++t) { u32x4 w; w.x = cvt_pk_bf16(S[2 * t][0], S[2 * t][1]); w.y = cvt_pk_bf16(S[2 * t][2], S[2 * t][3]); w.z = cvt_pk_bf16(S[2 * t + 1][0], S[2 * t + 1][1]); w.w = cvt_pk_bf16(S[2 * t + 1][2], S[2 * t + 1][3]); pf[t] = __builtin_bit_cast(bf16x8, w); }
    }
    f32x4 acc[16];
#pragma unroll
    for (int j = 0; j < 16; ++j) acc[j] = (f32x4){0.f, 0.f, 0.f, 0.f};
#pragma unroll 1
    for (int half = 0; half < 2; ++half) {
        __syncthreads();
        load_plain_commit(Y, pre, tid);
        if (half == 0) load_plain_issue(pre, Cst + (size_t)item * 65536 + 32768, 256, tid);
        else load_plain_issue(pre, proj + SEC(C_MV) + (size_t)t0 * PP + h * 256, PP, tid);
        __syncthreads();
#pragma unroll 1
        for (int t = 0; t < 4; ++t) { const bf16x8 qb = rowfrag_perm(X, PIT, j0, half * 128 + 32 * t, lane);
#pragma unroll
            for (int hb = 0; hb < 2; ++hb) {
                bf16x8 cf[8];
#pragma unroll
                for (int nb = 0; nb < 8; ++nb) cf[nb] = trfrag(Y, PIT, 32 * t, 16 * (8 * hb + nb), lane);
                __builtin_amdgcn_sched_barrier(0);
#pragma unroll
                for (int nb = 0; nb < 8; ++nb) acc[8 * hb + nb] = mfma16(cf[nb], qb, acc[8 * hb + nb]); } }
    }
#pragma unroll
    for (int nb = 0; nb < 16; ++nb) acc[nb] = acc[nb] * inter;
    __syncthreads();
    load_plain_commit(X, pre, tid);
    __syncthreads();
#pragma unroll
    for (int t = 0; t < 4; ++t) if (2 * t <= wid) {
        bf16x8 vf[16];
#pragma unroll
        for (int nb = 0; nb < 16; ++nb) vf[nb] = trfrag(X, PIT, 32 * t, 16 * nb, lane);
        __builtin_amdgcn_sched_barrier(0);
#pragma unroll
        for (int nb = 0; nb < 16; ++nb) acc[nb] = mfma16(vf[nb], pf[t], acc[nb]); }
    const float rdn = 1.0f / fmaxf(fabsf(den), __expf(-mt));
    bf16_t* op = proj + SEC(C_MO) + (size_t)(t0 + jj) * PP + h * 256 + 4 * g;
    u32x2 sgv[16];
#pragma unroll
    for (int nb = 0; nb < 16; ++nb) sgv[nb] = *(const u32x2*)(op + 16 * nb);
#pragma unroll
    for (int nb = 0; nb < 16; ++nb) { const u32x2 sg = sgv[nb];
        u32x2 w; w.x = cvt_pk_bf16(acc[nb][0] * rdn * bflo(sg.x), acc[nb][1] * rdn * bfhi(sg.x)); w.y = cvt_pk_bf16(acc[nb][2] * rdn * bflo(sg.y), acc[nb][3] * rdn * bfhi(sg.y));
        *(u32x2*)(op + 16 * nb) = w; }
    __syncthreads();
}

__device__ __forceinline__ void phase_qkprep(bf16_t* proj, const float* gqk  , const float2* rope) {
    const int tid = my_tid(), lane = tid & 63, wave = tid >> 6;
    const int gw = blockIdx.x * 8 + wave, NGW = gridDim.x * 8;
    const int grp = lane >> 2, u = lane & 3;
    for (int it = gw; it < TG * 2; it += NGW) {
        const int row = it >> 1, which = it & 1, pos = row & (SEQ - 1);
        bf16_t* p = proj + (which ? SEC(C_AK) : SEC(C_AQ)) + (size_t)row * PP + grp * 64 + 8 * u;
        const u32x4 a = *(const u32x4*)p, b = *(const u32x4*)(p + 32);
        float x1[8], x2[8]; unpack8(a, x1); unpack8(b, x2);
        float ss = 0.f;
#pragma unroll
        for (int e = 0; e < 8; ++e) ss += x1[e] * x1[e] + x2[e] * x2[e];
        ss += __shfl_xor(ss, 1); ss += __shfl_xor(ss, 2);
        const float rstd = 1.0f / sqrtf(ss * (1.0f / 64.0f) + 1e-6f) * (which ? 1.0f : 0.125f * 1.4426950408889634f);
        const float* gq = gqk + which * 64 + 8 * u;
        const float2* cs = rope + (size_t)pos * 32 + 8 * u;
        float o1[8], o2[8];
#pragma unroll
        for (int e = 0; e < 8; ++e) { const float y1 = x1[e] * rstd * gq[e], y2 = x2[e] * rstd * gq[32 + e]; const float2 t = cs[e]; o1[e] = y1 * t.x - y2 * t.y; o2[e] = y2 * t.x + y1 * t.y; }
        *(u32x4*)p = pack8(o1); *(u32x4*)(p + 32) = pack8(o2);
    }
}
__device__ __forceinline__ void phase_pool(const bf16_t* proj, bf16_t* pooled) {
    const int tid = my_tid();
    for (int idx = blockIdx.x * NTHR + tid; idx < (TG / 16) * 128; idx += gridDim.x * NTHR) {
        const int cgi = idx & 127, seg = idx >> 7, r0 = seg * 16, pos0 = r0 & (SEQ - 1), w = 2 << (cgi >> 5);
        const bf16_t* src = proj + SEC(C_PU) + (size_t)r0 * PP + cgi * 8;
        float sum[8];
#pragma unroll
        for (int e = 0; e < 8; ++e) sum[e] = 0.f;
        if (pos0 > 0) for (int j = 1; j < w; ++j) { float f[8]; unpack8(*(const u32x4*)(src - (ptrdiff_t)j * PP), f);
#pragma unroll
            for (int e = 0; e < 8; ++e) sum[e] += f[e]; }
        for (int r = 0; r < 16; ++r) {
            float f[8]; unpack8(*(const u32x4*)(src + (ptrdiff_t)r * PP), f);
            const int pos = pos0 + r;
            if (r >= 1 && pos - w >= 0) { float o[8]; unpack8(*(const u32x4*)(src + (ptrdiff_t)(r - w) * PP), o);
#pragma unroll
                for (int e = 0; e < 8; ++e) sum[e] -= o[e]; }
            const float rc = 1.0f / (float)(pos + 1 < w ? pos + 1 : w);
            float out[8];
#pragma unroll
            for (int e = 0; e < 8; ++e) { sum[e] += f[e]; out[e] = sum[e] * rc - f[e]; }
            *(u32x4*)(pooled + (size_t)(r0 + r) * DM + cgi * 8) = pack8(out);
        }
    }
}

constexpr int APIT = 288, ATILE = 64 * APIT, ABUF = 2 * ATILE;
__device__ __forceinline__ void attn_qkexp(const LAS char* Kb, int k0, int q0, int wid, int lane, int g, int qpos, const bf16x8 (&qf)[2][2], const f32x4 negM, bf16x8 (&pf)[2][2]) {
    f32x4 s[2][4];
    {
        bf16x8 kf[2][4][2];
#pragma unroll
        for (int c = 0; c < 2; ++c)
#pragma unroll
            for (int kb = 0; kb < 4; ++kb)
#pragma unroll
                for (int ks = 0; ks < 2; ++ks) kf[c][kb][ks] = rowfrag(Kb, APIT, 16 * kb, c * 64 + 32 * ks, lane);
        __builtin_amdgcn_sched_barrier(0);
#pragma unroll
        for (int c = 0; c < 2; ++c)
#pragma unroll
            for (int kb = 0; kb < 4; ++kb) s[c][kb] = mfma16(kf[c][kb][0], qf[c][0], negM);
#pragma unroll
        for (int c = 0; c < 2; ++c)
#pragma unroll
            for (int kb = 0; kb < 4; ++kb) s[c][kb] = mfma16(kf[c][kb][1], qf[c][1], s[c][kb]);
    }
    if (k0 + 63 > q0 + 16 * wid) {
#pragma unroll
        for (int c = 0; c < 2; ++c)
#pragma unroll
            for (int kb = 0; kb < 4; ++kb)
#pragma unroll
                for (int r = 0; r < 4; ++r) if (k0 + 16 * kb + 4 * g + r > qpos) s[c][kb][r] = -INFINITY;
    }
#pragma unroll
    for (int c = 0; c < 2; ++c) {
#pragma unroll
        for (int kb = 0; kb < 4; ++kb)
#pragma unroll
            for (int r = 0; r < 4; ++r) s[c][kb][r] = __builtin_amdgcn_exp2f(s[c][kb][r]);
#pragma unroll
        for (int tt = 0; tt < 2; ++tt) { u32x4 w; w.x = cvt_pk_bf16(s[c][2 * tt][0], s[c][2 * tt][1]); w.y = cvt_pk_bf16(s[c][2 * tt][2], s[c][2 * tt][3]);
            w.z = cvt_pk_bf16(s[c][2 * tt + 1][0], s[c][2 * tt + 1][1]); w.w = cvt_pk_bf16(s[c][2 * tt + 1][2], s[c][2 * tt + 1][3]); pf[c][tt] = __builtin_bit_cast(bf16x8, w); }
    }
}
__device__ __forceinline__ void attn_pv(const LAS char* Vb, int lane, const bf16x8 (&pf)[2][2], const bf16x8 onesf, f32x4 (&O)[2][8], f32x4 (&Oe)[2]) {
    bf16x8 va[8], vb[8];
#pragma unroll
    for (int nb = 0; nb < 8; ++nb) va[nb] = trfrag(Vb, APIT, 0, 16 * nb, lane);
#pragma unroll
    for (int nb = 0; nb < 8; ++nb) vb[nb] = trfrag(Vb, APIT, 32, 16 * nb, lane);
    __builtin_amdgcn_sched_barrier(0);
    Oe[0] = mfma16(onesf, pf[0][0], Oe[0]); Oe[1] = mfma16(onesf, pf[1][0], Oe[1]);
#pragma unroll
    for (int nb = 0; nb < 8; ++nb) { O[0][nb] = mfma16(va[nb], pf[0][0], O[0][nb]); O[1][nb] = mfma16(va[nb], pf[1][0], O[1][nb]); }
    Oe[0] = mfma16(onesf, pf[0][1], Oe[0]); Oe[1] = mfma16(onesf, pf[1][1], Oe[1]);
#pragma unroll
    for (int nb = 0; nb < 8; ++nb) { O[0][nb] = mfma16(vb[nb], pf[0][1], O[0][nb]); O[1][nb] = mfma16(vb[nb], pf[1][1], O[1][nb]); }
}
__device__ __forceinline__ void attn_step_fast(const LAS char* Kb, const LAS char* Vb, int lane, const bf16x8 (&qf)[2][2], const f32x4 negM, const bf16x8 onesf, f32x4 (&O)[2][8], f32x4 (&Oe)[2]) {
    f32x4 s0[4], s1[4];
    bf16x8 p0[2], p1[2];
    {
        bf16x8 kf[2][4][2];
#pragma unroll
        for (int c = 0; c < 2; ++c)
#pragma unroll
            for (int kb = 0; kb < 4; ++kb)
#pragma unroll
                for (int ks = 0; ks < 2; ++ks) kf[c][kb][ks] = rowfrag(Kb, APIT, 16 * kb, c * 64 + 32 * ks, lane);
        __builtin_amdgcn_sched_barrier(0);
#pragma unroll
        for (int kb = 0; kb < 4; ++kb) s0[kb] = mfma16(kf[0][kb][0], qf[0][0], negM);
#pragma unroll
        for (int kb = 0; kb < 4; ++kb) s0[kb] = mfma16(kf[0][kb][1], qf[0][1], s0[kb]);
        __builtin_amdgcn_sched_barrier(0);
#pragma unroll
        for (int kb = 0; kb < 4; ++kb) s1[kb] = mfma16(kf[1][kb][0], qf[1][0], negM);
#pragma unroll
        for (int kb = 0; kb < 4; ++kb) s1[kb] = mfma16(kf[1][kb][1], qf[1][1], s1[kb]);
    }
#define ATT_EXPPACK(S, P) do { \
        _Pragma("unroll") for (int kb = 0; kb < 4; ++kb) _Pragma("unroll") for (int r = 0; r < 4; ++r) S[kb][r] = __builtin_amdgcn_exp2f(S[kb][r]); \
        _Pragma("unroll") for (int tt = 0; tt < 2; ++tt) { u32x4 w; w.x = cvt_pk_bf16(S[2 * tt][0], S[2 * tt][1]); w.y = cvt_pk_bf16(S[2 * tt][2], S[2 * tt][3]); \
            w.z = cvt_pk_bf16(S[2 * tt + 1][0], S[2 * tt + 1][1]); w.w = cvt_pk_bf16(S[2 * tt + 1][2], S[2 * tt + 1][3]); P[tt] = __builtin_bit_cast(bf16x8, w); } } while (0)
    ATT_EXPPACK(s0, p0);
#pragma unroll
    for (int i = 0; i < 8; ++i) { __builtin_amdgcn_sched_group_barrier(0x008, 1, 0); __builtin_amdgcn_sched_group_barrier(0x002, 3, 0); }
    __builtin_amdgcn_sched_barrier(0);
    bf16x8 va[8], vb[8];
#pragma unroll
    for (int nb = 0; nb < 8; ++nb) va[nb] = trfrag(Vb, APIT, 0, 16 * nb, lane);
#pragma unroll
    for (int nb = 0; nb < 8; ++nb) vb[nb] = trfrag(Vb, APIT, 32, 16 * nb, lane);
    __builtin_amdgcn_sched_barrier(0);
    Oe[0] = mfma16(onesf, p0[0], Oe[0]);
#pragma unroll
    for (int nb = 0; nb < 8; ++nb) O[0][nb] = mfma16(va[nb], p0[0], O[0][nb]);
    Oe[0] = mfma16(onesf, p0[1], Oe[0]);
#pragma unroll
    for (int nb = 0; nb < 8; ++nb) O[0][nb] = mfma16(vb[nb], p0[1], O[0][nb]);
    ATT_EXPPACK(s1, p1);
#pragma unroll
    for (int i = 0; i < 18; ++i) { __builtin_amdgcn_sched_group_barrier(0x008, 1, 0); __builtin_amdgcn_sched_group_barrier(0x002, 2, 0); }
    __builtin_amdgcn_sched_barrier(0);
    Oe[1] = mfma16(onesf, p1[0], Oe[1]);
#pragma unroll
    for (int nb = 0; nb < 8; ++nb) O[1][nb] = mfma16(va[nb], p1[0], O[1][nb]);
    Oe[1] = mfma16(onesf, p1[1], Oe[1]);
#pragma unroll
    for (int nb = 0; nb < 8; ++nb) O[1][nb] = mfma16(vb[nb], p1[1], O[1][nb]);
#undef ATT_EXPPACK
}
__device__ __forceinline__ void attn_item(LAS char* lds, bf16_t* proj, int bl, int h, int qb, float lam, float oscale, const float* gdh, float smax) {
    const int tid = my_tid(), lane = tid & 63, wid = __builtin_amdgcn_readfirstlane(tid >> 6), g = lane >> 4, fr = lane & 15;
    const size_t rowbase = (size_t)bl * SEQ; const int q0 = qb * 128, qpos = q0 + 16 * wid + fr;
    bf16_t* qp = proj + SEC(C_AQ) + (rowbase + qpos) * PP + h * 128;
    bf16x8 qf[2][2];
#pragma unroll
    for (int c = 0; c < 2; ++c)
#pragma unroll
        for (int ks = 0; ks < 2; ++ks) qf[c][ks] = *(const bf16x8*)(qp + c * 64 + 32 * ks + 8 * g);
    f32x4 O[2][8], Oe[2];
#pragma unroll
    for (int c = 0; c < 2; ++c) { Oe[c] = (f32x4){0.f, 0.f, 0.f, 0.f};
#pragma unroll
        for (int nb = 0; nb < 8; ++nb) O[c][nb] = (f32x4){0.f, 0.f, 0.f, 0.f}; }
    const f32x4 negM = (f32x4){-smax, -smax, -smax, -smax};
    const short one16 = (fr == 0) ? (short)0x3F80 : (short)0;
    const bf16x8 onesf = (bf16x8){one16, one16, one16, one16, one16, one16, one16, one16};
    const int NT = 2 * (qb + 1);
    const int sr0 = tid >> 4, sc = tid & 15;
    const bf16_t* kg = proj + SEC(C_AK) + (rowbase + sr0) * PP + h * 128 + sc * 8;
    const bf16_t* vg = proj + SEC(C_AV) + (rowbase + sr0) * PP + h * 128 + sc * 8;
    const int soff = sr0 * APIT + sc * 16;
    u32x4 kr[2], vr[2];
#define ATT_LOAD(tile) do { _Pragma("unroll") for (int i = 0; i < 2; ++i) { kr[i] = *(const u32x4*)(kg + (size_t)(64 * (tile) + 32 * i) * PP); vr[i] = *(const u32x4*)(vg + (size_t)(64 * (tile) + 32 * i) * PP); } } while (0)
#define ATT_STORE(buf) do { LAS char* nb_ = lds + (buf) * ABUF; _Pragma("unroll") for (int i = 0; i < 2; ++i) { *(LAS u32x4*)(nb_ + soff + 32 * i * APIT) = kr[i]; *(LAS u32x4*)(nb_ + ATILE + soff + 32 * i * APIT) = vr[i]; } } while (0)
    ATT_LOAD(0); ATT_STORE(0);
    __syncthreads();
    const int qmaxw = q0 + 16 * wid + 15;
    int t = 0;
    for (; t < NT - 2; ++t) {
        ATT_LOAD(t + 1);
        const LAS char* Kb = lds + (t & 1) * ABUF;
#if ATT_FAST
        attn_step_fast(Kb, Kb + ATILE, lane, qf, negM, onesf, O, Oe);
#else
        { bf16x8 pq[2][2]; attn_qkexp(Kb, 64 * t, q0, wid, lane, g, qpos, qf, negM, pq); attn_pv(Kb + ATILE, lane, pq, onesf, O, Oe); }
#endif
        ATT_STORE((t + 1) & 1);
        BAR_LDS();
    }
    bf16x8 pf[2][2];
    for (; t < NT; ++t) {
        const int k0 = 64 * t;
        if (t + 1 < NT) ATT_LOAD(t + 1);
        if (k0 <= qmaxw) {
            const LAS char* Kb = lds + (t & 1) * ABUF;
            attn_qkexp(Kb, k0, q0, wid, lane, g, qpos, qf, negM, pf);
            attn_pv(Kb + ATILE, lane, pf, onesf, O, Oe);
        }
        if (t + 1 < NT) ATT_STORE((t + 1) & 1);
        BAR_LDS();
    }
#undef ATT_LOAD
#undef ATT_STORE
    const float l0 = __shfl(Oe[0][0], fr), l1 = __shfl(Oe[1][0], fr);
    const float r0 = 1.0f / l0, r1 = lam / l1;
    float ss = 0.f;
#pragma unroll
    for (int nb = 0; nb < 8; ++nb)
#pragma unroll
        for (int r = 0; r < 4; ++r) { const float o = O[0][nb][r] * r0 - O[1][nb][r] * r1; O[0][nb][r] = o; ss += o * o; }
    ss += __shfl_xor(ss, 16); ss += __shfl_xor(ss, 32);
    const float rstd = 1.0f / sqrtf(ss * (1.0f / 128.0f) + 1e-6f) * oscale;
    f32x4 ggv[8];
#pragma unroll
    for (int nb = 0; nb < 8; ++nb) ggv[nb] = *(const f32x4*)(gdh + 16 * nb + 4 * g);
#pragma unroll
    for (int nb = 0; nb < 8; ++nb) { const f32x4 gg = ggv[nb];
        u32x2 w; w.x = cvt_pk_bf16(O[0][nb][0] * rstd * gg.x, O[0][nb][1] * rstd * gg.y); w.y = cvt_pk_bf16(O[0][nb][2] * rstd * gg.z, O[0][nb][3] * rstd * gg.w);
        *(u32x2*)(qp + ((ptrdiff_t)SEC(C_PU) - (ptrdiff_t)SEC(C_AQ)) + 16 * nb + 4 * g) = w; }
}

#ifndef PH_ONLY
#define PH_ONLY -1
#endif
#define PHO(n) (PH_ONLY < 0 || PH_ONLY == (n))
#ifndef PROJ_ALIGN
#define PROJ_ALIGN true
#endif
#ifndef ATT_FAST
#define ATT_FAST 1
#endif
#ifndef DUP_K
#define DUP_K -1
#endif
__global__ void __launch_bounds__(NTHR, 2) fwd_kernel(Args a) {
    extern __shared__ __attribute__((aligned(16))) unsigned char lds_raw[];
    LAS unsigned char* lds = (LAS unsigned char*)lds_raw;
    cg::grid_group grid = cg::this_grid();
    unsigned char* ws = a.ws;
    bf16_t* proj = (bf16_t*)(ws + WS_PROJ);
    bf16_t* hn = (bf16_t*)(ws + WS_HN);
    bf16_t* Cst = (bf16_t*)(ws + WS_CST);
    float* gif = (float*)(ws + WS_GIF);
    float* gch = (float*)(ws + WS_MV); float* mloc = gch + 512; float* mprev = gch + 1024;
    float* nst = (float*)(ws + WS_NST);
    const int G = gridDim.x, bx = blockIdx.x;
    unsigned* barw = (unsigned*)ws;
    volatile LAS unsigned* bst = (volatile LAS unsigned*)(lds + LDS_BYTES - 64);
    if (threadIdx.x < 2) bst[threadIdx.x] = 0u;
    if (bx == 0) for (int i = threadIdx.x; i < XCD_BAR_WORDS; i += NTHR) barw[i] = 0u;
    __syncthreads();
    XcdBarrier xb; xb.bar = barw; xb.x = 0; xb.st = bst;
    bool xb_ready = false;
    for (int ph = a.ph_lo; ph < a.ph_hi; ++ph) {
        const int l = ph / 18, idx = ph % 18;
        const float* xsrc = (l == 0) ? a.in[0] : a.out;
        if (PHO(0) && idx == 0) {
            phase_weights(a, l, lds);
        } else if (idx <= 14) {
            const int grp = (idx - 1) / 7, k = (idx - 1) % 7;
            const size_t rowoff = (size_t)grp * TG;
            if (PHO(1) && k == 0) {
                for (int rep = 0; rep < (DUP_K == 0 ? 2 : 1); ++rep)
                phase_norm<true>(xsrc + rowoff * DM, a.in[1] + l * DM, hn, TG, a.in[2] + (size_t)l * DM * NIN, a.in[3] + l * 8, gif, lds);
            } else if (PHO(2) && k == 1) {
                pg8::Gemm gm{hn, (const bf16_t*)(ws + WS_WIN), TG, NP, DM, DM, 0}; pg8::StaticOrder S; S.init(TG, NP, G, bx);
                pg8::EpiProj E{proj, PP, (size_t)TG * 1024};
                for (int rep = 0; rep < (DUP_K == 1 ? 2 : 1); ++rep)
                pg8::gemm_phase<pg8::EpiProj, pg8::StaticOrder, PROJ_ALIGN, true>(lds, gm, S, E);
            } else if (PHO(3) && k == 2) {
                const float* convw = a.in[4] + (size_t)l * 4 * 2048;
                for (int rep = 0; rep < (DUP_K == 2 ? 2 : 1); ++rep)
                for (int it = bx; it < NBH * 32; it += G) m1_item((LAS char*)lds, proj, gif, Cst, nst, gch, mloc, convw, it >> 5, it & 31);
                phase_qkprep(proj, a.in[8] + l * 128, (const float2*)(ws + WS_ROPE));
                phase_pool(proj, hn);
            } else if (PHO(4) && k == 3) {
                phase_scan(Cst, nst, gch, mloc, mprev);
                const float* lp = a.in[9] + l * 256;
                float s01 = 0.f, s23 = 0.f;
                for (int i = 0; i < 64; ++i) { s01 += lp[i] * lp[64 + i]; s23 += lp[128 + i] * lp[192 + i]; }
                float mgq = 0.f, mgk = 0.f; { const float* gq = a.in[8] + l * 128; for (int i = 0; i < 64; ++i) { mgq = fmaxf(mgq, fabsf(gq[i])); mgk = fmaxf(mgk, fabsf(gq[64 + i])); } }
                const float smax = 64.0f * mgq * mgk * (0.125f * 1.4426950408889634f) * 1.01f + 0.25f;
                const float lam_init = 0.8f - 0.6f * expf(-0.3f * (float)l);
                const float lam = expf(s01) - expf(s23) + lam_init;
                for (int rep = 0; rep < (DUP_K == 3 ? 2 : 1); ++rep)
                for (int i = bx; i < GB * 8 * 32; i += G) {
                    const int r = i >> 8, j = i & 255, x = j & 7, y = j >> 3, bh = x + 8 * r, qb = (r & 1) ? 31 - y : y;
                    attn_item((LAS char*)lds, proj, bh >> 3, bh & 7, qb, lam, 1.0f - lam_init, a.in[10] + l * 128, smax);
                }
            } else if (PHO(5) && k == 4) {
                const float* convw = a.in[4] + (size_t)l * 4 * 2048;
                for (int it = bx; it < NBH * 32; it += G) m3_item((LAS char*)lds, proj, gif, Cst, nst, mprev, convw, it >> 5, it & 31);
            } else if (PHO(6) && k == 5) {
#pragma unroll 1
                for (int brr = 0; brr < (DUP_K == 5 ? 6 : 3); ++brr) { const int br = brr % 3;
                    pg8::Gemm gm; gm.M = TG; gm.N = DM;
                    if (br == 0) { gm.A = proj + SEC(C_MO); gm.Bt = (const bf16_t*)(ws + WS_WMO); gm.K = DM; gm.lda = PP; gm.a_pn_off = 0; }
                    else if (br == 1) { gm.A = hn; gm.Bt = (const bf16_t*)(ws + WS_WPOOL); gm.K = 256; gm.lda = DM; gm.a_pn_off = 256; }
                    else { gm.A = proj + SEC(C_PU); gm.Bt = (const bf16_t*)(ws + WS_WDIFF); gm.K = DM; gm.lda = PP; gm.a_pn_off = 0; }
                    pg8::StaticOrder S; S.init(TG, DM, G, bx);
                    pg8::EpiMerge E{proj + SEC(C_MQ), proj + SEC(C_GT) + (size_t)br * ((size_t)TG * 1024), PP, br == 0 ? 1 : 0};
                    pg8::gemm_phase<pg8::EpiMerge, pg8::StaticOrder, true, true>(lds, gm, S, E);
                }
            } else if (PHO(7)) {
                pg8::Gemm gm{proj + SEC(C_MQ), (const bf16_t*)(ws + WS_WOUT), TG, DM, DM, PP, 0}; pg8::StaticOrder S; S.init(TG, DM, G, bx);
                pg8::EpiResid E{xsrc + rowoff * DM, a.out + rowoff * DM, DM};
                pg8::gemm_phase<pg8::EpiResid, pg8::StaticOrder, true, true>(lds, gm, S, E);
            }
        } else if (PHO(8) && idx == 15) {
            phase_norm<false>(a.out, a.in[13] + l * DM, hn, TT, nullptr, nullptr, nullptr, lds);
        } else if (PHO(9) && idx == 16) {
            pg8::Gemm gm{hn, (const bf16_t*)(ws + WS_WGU), TT, 2 * FF, DM, DM, 0}; pg8::StaticOrder S; S.init(TT, 2 * FF, G, bx);
            pg8::EpiSwiGLU E{proj, FF};
            for (int rep = 0; rep < (DUP_K == 16 ? 2 : 1); ++rep)
            pg8::gemm_phase<pg8::EpiSwiGLU, pg8::StaticOrder, true, true>(lds, gm, S, E);
        } else if (PHO(10)) {
            pg8::Gemm gm{proj, (const bf16_t*)(ws + WS_WDN), TT, DM, FF, FF, 0}; pg8::StaticOrder S; S.init(TT, DM, G, bx);
            pg8::EpiResid E{a.out, a.out, DM};
            pg8::gemm_phase<pg8::EpiResid, pg8::StaticOrder, true, true>(lds, gm, S, E);
        }
        if (ph + 1 < a.ph_hi) {
            if (!xb_ready) { grid.sync(); xb = xcd_barrier_post(barw, bst); xb_ready = true; }
            else { xcd_barrier(xb); if (DUP_K == 100) { xcd_barrier(xb); xcd_barrier(xb); } }
        }
    }
}

extern "C" void kernel_launch(void* const* d_in, const int* in_sizes, int n_in, void* d_out, int out_size, void* d_ws, size_t ws_size, hipStream_t stream) {
    static int grid = 0;
    if (grid == 0) {
        if (n_in != 16 || out_size != TT * DM || ws_size < WS_END) { fprintf(stderr, "kernel_launch: unexpected shapes / workspace (%d inputs, out %d, ws %zu)\n", n_in, out_size, ws_size); grid = -1; return; }
        int dev = 0, cus = 0, per_cu = 0;
        hipGetDevice(&dev); hipDeviceGetAttribute(&cus, hipDeviceAttributeMultiprocessorCount, dev);
        hipFuncSetAttribute((const void*)fwd_kernel, hipFuncAttributeMaxDynamicSharedMemorySize, LDS_BYTES);
        hipOccupancyMaxActiveBlocksPerMultiprocessor(&per_cu, (const void*)fwd_kernel, NTHR, LDS_BYTES);
        (void)hipGetLastError();
        if (per_cu < 1) per_cu = 1;
        grid = cus * 1;
        if (grid <= 0) grid = 256;
    }
    if (grid < 0) return;
    Args a{};
    for (int i = 0; i < 16; ++i) a.in[i] = (const float*)d_in[i];
    a.out = (float*)d_out; a.ws = (unsigned char*)d_ws; a.ph_lo = 0; a.ph_hi = 36;
    void* args[] = {&a};
    hipError_t e = hipLaunchCooperativeKernel((const void*)fwd_kernel, dim3(grid), dim3(NTHR), args, LDS_BYTES, stream);
    if (e != hipSuccess) fprintf(stderr, "cooperative launch failed: %s (grid %d)\n", hipGetErrorString(e), grid);
}
```

```cpp
#include <hip/hip_runtime.h>
#include <hip/hip_cooperative_groups.h>
#include <cstdio>
#include <cstdint>
namespace cg = cooperative_groups;
namespace pg8 {
#define PG8_LAS __attribute__((address_space(3)))
typedef unsigned short bf16_t;
typedef short bf16x8 __attribute__((ext_vector_type(8)));
typedef float f32x4 __attribute__((ext_vector_type(4)));
typedef unsigned u32x4 __attribute__((ext_vector_type(4)));
constexpr int BM = 256, BK = 64, HALF = 128, HTB = HALF * BK * 2  , STAGE_BYTES = 8 * HTB, NXCD = 8, WGM = 8;

__host__ __device__ __forceinline__ int lds_byte(int r, int c) { const int st = (r >> 4) * 2 + (c >> 5), rr = r & 15, cc = c & 31, ob = rr * 64 + cc * 2; return st * 1024 + (ob ^ (((ob >> 9) & 1) << 5)); }
__host__ __device__ __forceinline__ void stage_rc(int b, int& R, int& C) { const int st = b / 1024, sb = b % 1024, swz = sb ^ (((sb >> 9) & 1) << 5); R = (st >> 1) * 16 + swz / 64; C = (st & 1) * 32 + (swz % 64) / 2; }
__host__ __device__ __forceinline__ int perm32(int rho) { const int n = rho >> 4, i = rho & 15; return 8 * (i >> 2) + 4 * n + (i & 3); }

struct Unit { int pm, pn; };
struct Gemm { const bf16_t* A; const bf16_t* Bt; int M, N, K, lda, a_pn_off; };

struct StaticOrder {
    int nM, nN, nwg, G, c;
    __host__ __device__ void init(int M, int N, int G_, int c_) { nM = M / BM; nN = N / BM; nwg = nM * nN; G = G_; c = c_; }
    __host__ __device__ bool next(int i, Unit& u) const {
        const long L = (long)i * G + c; if (L >= nwg) return false;
        int wgid = (int)L; { const int q = nwg / NXCD, r = nwg % NXCD, xcd = wgid % NXCD, off = wgid / NXCD; wgid = (xcd < r ? xcd * (q + 1) : r * (q + 1) + (xcd - r) * q) + off; }
        const int nig = WGM * nN, gid = wgid / nig, fm = gid * WGM, gsz = (nM - fm) < WGM ? (nM - fm) : WGM;
        u.pm = fm + ((wgid % nig) % gsz); u.pn = (wgid % nig) / gsz; return true;
    }
    __device__ __forceinline__ void a_ready(const Unit&) const {}
    __device__ __forceinline__ void done(const Unit&) const {}
};

typedef float f32x2_t __attribute__((ext_vector_type(2))); typedef __bf16 bf16x2_t __attribute__((ext_vector_type(2)));
__device__ __forceinline__ unsigned cvt_pk_bf16(float lo, float hi) { const f32x2_t v = {lo, hi}; const bf16x2_t b = __builtin_convertvector(v, bf16x2_t); return __builtin_bit_cast(unsigned, b); }
__device__ __forceinline__ float fsigmoid(float x) { return __builtin_amdgcn_rcpf(1.0f + __expf(-x)); }
__device__ __forceinline__ float bflo(unsigned u) { return __uint_as_float(u << 16); }
__device__ __forceinline__ float bfhi(unsigned u) { return __uint_as_float(u & 0xffff0000u); }

struct EpiProj {
    static constexpr bool PERM = true, AFTER_DRAIN = false;
    bf16_t* O; int ldc; size_t sec_stride;
    __device__ __forceinline__ void operator()(const f32x4 (&acc)[2][2][4][2], const Unit& u, int wr, int wc, int fr, int fq) const {
        const bool sg = (u.pn >= 12 && u.pn < 16) || (u.pn >= 32);
        const int row0 = u.pm * BM + wr * 64 + fr, col0 = (u.pn & 3) * BM + wc * 32 + 8 * fq;
        bf16_t* const Os = O + (size_t)(u.pn >> 2) * sec_stride;
#pragma unroll
        for (int ai = 0; ai < 2; ++ai)
#pragma unroll
            for (int m = 0; m < 4; ++m) { bf16_t* rowp = Os + (size_t)(row0 + ai * HALF + m * 16) * ldc + col0;
#pragma unroll
                for (int bj = 0; bj < 2; ++bj) { f32x4 v0 = acc[ai][bj][m][0], v1 = acc[ai][bj][m][1];
                    if (sg) {
#pragma unroll
                        for (int i = 0; i < 4; ++i) { v0[i] = fsigmoid(v0[i]); v1[i] = fsigmoid(v1[i]); } }
                    u32x4 w; w.x = cvt_pk_bf16(v0[0], v0[1]); w.y = cvt_pk_bf16(v0[2], v0[3]); w.z = cvt_pk_bf16(v1[0], v1[1]); w.w = cvt_pk_bf16(v1[2], v1[3]);
                    *(u32x4*)(rowp + bj * HALF) = w; } }
    }
};
struct EpiMerge {
    static constexpr bool PERM = true, AFTER_DRAIN = false;
    bf16_t* O; const bf16_t* Gt; int ld; int first;
    __device__ __forceinline__ void operator()(const f32x4 (&acc)[2][2][4][2], const Unit& u, int wr, int wc, int fr, int fq) const {
        const int row0 = u.pm * BM + wr * 64 + fr, col0 = u.pn * BM + wc * 32 + 8 * fq;
#pragma unroll
        for (int ai = 0; ai < 2; ++ai) {
            u32x4 gv[4][2], pv[4][2];
#pragma unroll
            for (int m = 0; m < 4; ++m)
#pragma unroll
                for (int bj = 0; bj < 2; ++bj) { const size_t ro = (size_t)(row0 + ai * HALF + m * 16) * ld + col0 + bj * HALF;
                    gv[m][bj] = *(const u32x4*)(Gt + ro); pv[m][bj] = first ? (u32x4){0u, 0u, 0u, 0u} : *(const u32x4*)(O + ro); }
#pragma unroll
            for (int m = 0; m < 4; ++m)
#pragma unroll
                for (int bj = 0; bj < 2; ++bj) { const size_t ro = (size_t)(row0 + ai * HALF + m * 16) * ld + col0 + bj * HALF;
                    const f32x4 v0 = acc[ai][bj][m][0], v1 = acc[ai][bj][m][1]; const u32x4 g4 = gv[m][bj], p4 = pv[m][bj];
                    float o[8];
                    o[0] = v0[0] * bflo(g4.x) + bflo(p4.x); o[1] = v0[1] * bfhi(g4.x) + bfhi(p4.x); o[2] = v0[2] * bflo(g4.y) + bflo(p4.y); o[3] = v0[3] * bfhi(g4.y) + bfhi(p4.y);
                    o[4] = v1[0] * bflo(g4.z) + bflo(p4.z); o[5] = v1[1] * bfhi(g4.z) + bfhi(p4.z); o[6] = v1[2] * bflo(g4.w) + bflo(p4.w); o[7] = v1[3] * bfhi(g4.w) + bfhi(p4.w);
                    u32x4 w; w.x = cvt_pk_bf16(o[0], o[1]); w.y = cvt_pk_bf16(o[2], o[3]); w.z = cvt_pk_bf16(o[4], o[5]); w.w = cvt_pk_bf16(o[6], o[7]);
                    *(u32x4*)(O + ro) = w; }
        }
    }
};
struct EpiResid {
    static constexpr bool PERM = false, AFTER_DRAIN = false;
    const float* base; float* out; int ldc;
    __device__ __forceinline__ void operator()(const f32x4 (&acc)[2][2][4][2], const Unit& u, int wr, int wc, int fr, int fq) const {
        const int row0 = u.pm * BM + wr * 64 + fr, col0 = u.pn * BM + wc * 32 + 4 * fq;
#pragma unroll
        for (int ai = 0; ai < 2; ++ai) {
            f32x4 b[4][2][2];
#pragma unroll
            for (int m = 0; m < 4; ++m) { const size_t off = (size_t)(row0 + ai * HALF + m * 16) * ldc + col0;
#pragma unroll
                for (int bj = 0; bj < 2; ++bj)
#pragma unroll
                    for (int n = 0; n < 2; ++n) b[m][bj][n] = *(const f32x4*)(base + off + bj * HALF + n * 16); }
#pragma unroll
            for (int m = 0; m < 4; ++m) { const size_t off = (size_t)(row0 + ai * HALF + m * 16) * ldc + col0;
#pragma unroll
                for (int bj = 0; bj < 2; ++bj)
#pragma unroll
                    for (int n = 0; n < 2; ++n) *(f32x4*)(out + off + bj * HALF + n * 16) = b[m][bj][n] + acc[ai][bj][m][n]; }
        }
    }
};
struct EpiSwiGLU {
    static constexpr bool PERM = true, AFTER_DRAIN = false;
    bf16_t* O; int ldc;
    __device__ __forceinline__ void operator()(const f32x4 (&acc)[2][2][4][2], const Unit& u, int wr, int wc, int fr, int fq) const {
        const int row0 = u.pm * BM + wr * 64 + fr, col0 = u.pn * HALF + wc * 32 + 8 * fq;
#pragma unroll
        for (int ai = 0; ai < 2; ++ai)
#pragma unroll
            for (int m = 0; m < 4; ++m) { bf16_t* rowp = O + (size_t)(row0 + ai * HALF + m * 16) * ldc + col0;
                float o[8];
#pragma unroll
                for (int n = 0; n < 2; ++n)
#pragma unroll
                    for (int i = 0; i < 4; ++i) { const float gt = acc[ai][0][m][n][i], up = acc[ai][1][m][n][i]; o[n * 4 + i] = gt * fsigmoid(gt) * up; }
                u32x4 w; w.x = cvt_pk_bf16(o[0], o[1]); w.y = cvt_pk_bf16(o[2], o[3]); w.z = cvt_pk_bf16(o[4], o[5]); w.w = cvt_pk_bf16(o[6], o[7]);
                *(u32x4*)rowp = w; }
    }
};
template <class Epi, class Sched, bool ALIGN_EPI = false, bool SP2 = false>
__device__ __forceinline__ void gemm_phase(PG8_LAS unsigned char* lds, const Gemm g, const Sched& S, const Epi& E) {
    int tid_ = threadIdx.x; asm volatile("" : "+v"(tid_)); const int tid = tid_, wid = __builtin_amdgcn_readfirstlane(tid >> 6), lane = tid & 63, wr = wid >> 2, wc = wid & 3, fr = lane & 15, fq = lane >> 4;
    const int K = g.K, nt = K / BK;
    unsigned voffA[2], voffB[2];
#pragma unroll
    for (int i = 0; i < 2; ++i) { int R, C; stage_rc(tid * 16 + i * 8192, R, C); const int Rb = Epi::PERM ? ((R & ~31) + perm32(R & 31)) : R;
        voffA[i] = (unsigned)(R * g.lda + C) * 2u; voffB[i] = (unsigned)(Rb * K + C) * 2u; }
    const size_t kstep = (size_t)(BK * 2);
    const size_t hstepA = (size_t)HALF * g.lda * 2, hstepB = (size_t)HALF * K * 2;
    const size_t tstepA = 2 * hstepA, tstepB = 2 * hstepB, pnoffA = (size_t)g.a_pn_off * 2;
    const unsigned ldsw = (unsigned)wid * 1024u;
    const int aoff = lds_byte(wr * 64 + fr, fq * 8), boff = lds_byte(wc * 32 + fr, fq * 8);
#define PG8_SA(b, h) (((b) * 2 + (h)) * HTB)
#define PG8_SB(b, h) ((4 + (b) * 2 + (h)) * HTB)
#define PG8_STAGE(bufoff, gbase, voff) do { _Pragma("unroll") for (int _i = 0; _i < 2; ++_i) \
        __builtin_amdgcn_global_load_lds((const unsigned*)((const char*)(gbase) + (voff)[_i]), (PG8_LAS unsigned*)(lds + (bufoff) + ldsw + _i * 8192), 16, 0, 0); } while (0)
#define PG8_LDA(dst, b, h) do { _Pragma("unroll") for (int m = 0; m < 4; ++m) _Pragma("unroll") for (int k = 0; k < 2; ++k) dst[m][k] = *(const PG8_LAS bf16x8*)(lds + PG8_SA(b, h) + aoff + m * 2048 + k * 1024); } while (0)
#define PG8_LDB(dst, b, h) do { _Pragma("unroll") for (int n = 0; n < 2; ++n) _Pragma("unroll") for (int k = 0; k < 2; ++k) dst[n][k] = *(const PG8_LAS bf16x8*)(lds + PG8_SB(b, h) + boff + n * 2048 + k * 1024); } while (0)
#define PG8_MMA(ai, bj, At, Bt) do { __builtin_amdgcn_s_setprio(1); _Pragma("unroll") for (int m = 0; m < 4; ++m) _Pragma("unroll") for (int n = 0; n < 2; ++n) _Pragma("unroll") for (int k = 0; k < 2; ++k) \
        acc[ai][bj][m][n] = __builtin_amdgcn_mfma_f32_16x16x32_bf16(Bt[n][k], At[m][k], acc[ai][bj][m][n], 0, 0, 0); __builtin_amdgcn_s_setprio(0); } while (0)
#define PG8_WAIT_V(n) asm volatile("s_waitcnt vmcnt(" #n ")" ::: "memory")
#define PG8_WAIT_L(n) asm volatile("s_waitcnt lgkmcnt(" #n ")" ::: "memory")
#define PG8_BAR __builtin_amdgcn_s_barrier()
#define PG8_SCHED __builtin_amdgcn_sched_barrier(0)
    Unit cur, nxt; int ui = 0;
    if (!S.next(0, cur)) return;
    f32x4 acc[2][2][4][2];
#pragma unroll
    for (int a = 0; a < 2; ++a)
#pragma unroll
        for (int b = 0; b < 2; ++b)
#pragma unroll
            for (int m = 0; m < 4; ++m)
#pragma unroll
                for (int n = 0; n < 2; ++n) acc[a][b][m][n] = (f32x4){0.f, 0.f, 0.f, 0.f};
    bf16x8 At[4][2], B0[2][2], B1[2][2];
    const char* cA = (const char*)g.A + (size_t)cur.pm * tstepA + (size_t)cur.pn * pnoffA; const char* cB = (const char*)g.Bt + (size_t)cur.pn * tstepB;
    S.a_ready(cur);
    if constexpr (SP2) {
        PG8_STAGE(PG8_SB(0, 0), cB, voffB); PG8_STAGE(PG8_SB(0, 1), cB + hstepB, voffB); PG8_STAGE(PG8_SA(0, 0), cA, voffA); PG8_STAGE(PG8_SA(0, 1), cA + hstepA, voffA);
        if (wr == 1) PG8_BAR;
        PG8_WAIT_V(2); PG8_BAR;
        PG8_STAGE(PG8_SB(1, 0), cB + kstep, voffB); PG8_STAGE(PG8_SA(1, 0), cA + kstep, voffA); PG8_STAGE(PG8_SB(1, 1), cB + hstepB + kstep, voffB);
        PG8_WAIT_V(6); PG8_BAR;
    } else {
        PG8_STAGE(PG8_SB(0, 0), cB, voffB); PG8_STAGE(PG8_SA(0, 0), cA, voffA); PG8_STAGE(PG8_SB(0, 1), cB + hstepB, voffB); PG8_STAGE(PG8_SA(0, 1), cA + hstepA, voffA);
        if (wr == 1) PG8_BAR;
        PG8_WAIT_V(4); PG8_BAR;
        PG8_STAGE(PG8_SB(1, 0), cB + kstep, voffB); PG8_STAGE(PG8_SA(1, 0), cA + kstep, voffA); PG8_STAGE(PG8_SB(1, 1), cB + hstepB + kstep, voffB);
        PG8_WAIT_V(6); PG8_BAR;
    }
    for (;;) {
        const bool has_next = S.next(ui + 1, nxt);
        const char* nA = has_next ? (const char*)g.A + (size_t)nxt.pm * tstepA + (size_t)nxt.pn * pnoffA : cA; const char* nB = has_next ? (const char*)g.Bt + (size_t)nxt.pn * tstepB : cB;
        for (int t = 0; t < nt; t += 2) {
            const bool last = (t == nt - 2);
            const char* a1 = cA + (size_t)(t + 1) * kstep;
            const char* a2 = last ? nA : cA + (size_t)(t + 2) * kstep; const char* b2 = last ? nB : cB + (size_t)(t + 2) * kstep;
            const char* a3 = a2 + kstep; const char* b3 = b2 + kstep;
            if (last && has_next) S.a_ready(nxt);
            if constexpr (SP2) {
            PG8_LDB(B0, 0, 0); PG8_LDB(B1, 0, 1); PG8_SCHED; PG8_LDA(At, 0, 0); PG8_STAGE(PG8_SA(1, 1), a1 + hstepA, voffA);
            PG8_WAIT_V(8); PG8_WAIT_L(0); PG8_BAR; PG8_MMA(0, 0, At, B0); PG8_MMA(0, 1, At, B1); PG8_BAR; PG8_SCHED;
            PG8_LDA(At, 0, 1); PG8_STAGE(PG8_SB(0, 0), b2, voffB); PG8_STAGE(PG8_SB(0, 1), b2 + hstepB, voffB); PG8_STAGE(PG8_SA(0, 0), a2, voffA);
            PG8_WAIT_V(8); PG8_WAIT_L(0); PG8_BAR; PG8_MMA(1, 0, At, B0); PG8_MMA(1, 1, At, B1); PG8_BAR; PG8_SCHED;
            PG8_LDB(B0, 1, 0); PG8_LDB(B1, 1, 1); PG8_SCHED; PG8_LDA(At, 1, 0); PG8_STAGE(PG8_SA(0, 1), a2 + hstepA, voffA);
            PG8_WAIT_V(8); PG8_WAIT_L(0); PG8_BAR; PG8_MMA(0, 0, At, B0); PG8_MMA(0, 1, At, B1); PG8_BAR; PG8_SCHED;
            PG8_LDA(At, 1, 1); PG8_STAGE(PG8_SB(1, 0), b3, voffB); PG8_STAGE(PG8_SB(1, 1), b3 + hstepB, voffB); PG8_STAGE(PG8_SA(1, 0), a3, voffA);
            PG8_WAIT_V(8); PG8_WAIT_L(0); PG8_BAR; PG8_MMA(1, 0, At, B0); PG8_MMA(1, 1, At, B1); PG8_BAR; PG8_SCHED;
            } else {
            PG8_LDB(B0, 0, 0); PG8_SCHED; PG8_LDA(At, 0, 0); PG8_STAGE(PG8_SA(1, 1), a1 + hstepA, voffA);
            PG8_WAIT_L(8); PG8_BAR; PG8_WAIT_L(0); PG8_MMA(0, 0, At, B0); PG8_BAR; PG8_SCHED;
            PG8_LDB(B1, 0, 1); PG8_STAGE(PG8_SB(0, 0), b2, voffB);
            PG8_BAR; PG8_WAIT_L(0); PG8_MMA(0, 1, At, B1); PG8_BAR;
            PG8_LDA(At, 0, 1); PG8_STAGE(PG8_SA(0, 0), a2, voffA);
            PG8_BAR; PG8_WAIT_L(0); PG8_MMA(1, 0, At, B0); PG8_BAR; PG8_SCHED;
            PG8_STAGE(PG8_SB(0, 1), b2 + hstepB, voffB);
            PG8_WAIT_V(6); PG8_BAR; PG8_MMA(1, 1, At, B1); PG8_BAR;
            PG8_LDB(B0, 1, 0); PG8_SCHED; PG8_LDA(At, 1, 0); PG8_STAGE(PG8_SA(0, 1), a2 + hstepA, voffA);
            PG8_WAIT_L(8); PG8_BAR; PG8_WAIT_L(0); PG8_MMA(0, 0, At, B0); PG8_BAR; PG8_SCHED;
            PG8_LDB(B1, 1, 1); PG8_STAGE(PG8_SB(1, 0), b3, voffB);
            PG8_BAR; PG8_WAIT_L(0); PG8_MMA(0, 1, At, B1); PG8_BAR;
            PG8_LDA(At, 1, 1); PG8_STAGE(PG8_SA(1, 0), a3, voffA);
            PG8_BAR; PG8_WAIT_L(0); PG8_MMA(1, 0, At, B0); PG8_BAR; PG8_SCHED;
            PG8_STAGE(PG8_SB(1, 1), b3 + hstepB, voffB);
            PG8_WAIT_V(6); PG8_BAR; PG8_MMA(1, 1, At, B1); PG8_BAR;
            }
        }
        if constexpr (ALIGN_EPI) { if (wr == 0) PG8_BAR; }
        if constexpr (!Epi::AFTER_DRAIN) { E(acc, cur, wr, wc, fr, fq); S.done(cur); }
        if (!has_next) break;
#pragma unroll
        for (int a = 0; a < 2; ++a)
#pragma unroll
            for (int b = 0; b < 2; ++b)
#pragma unroll
                for (int m = 0; m < 4; ++m)
#pragma unroll
                    for (int n = 0; n < 2; ++n) acc[a][b][m][n] = (f32x4){0.f, 0.f, 0.f, 0.f};
        cur = nxt; cA = nA; cB = nB; ++ui;
        if constexpr (ALIGN_EPI) { if (wr == 1) PG8_BAR; }
    }
    PG8_WAIT_V(0);
    if constexpr (!ALIGN_EPI) { if (wr == 0) PG8_BAR; }
    PG8_BAR;
    if constexpr (Epi::AFTER_DRAIN) { E.fused(acc, cur, wr, wc, fr, fq, lds, wid, lane); S.done(cur); }
#undef PG8_SA
#undef PG8_SB
#undef PG8_STAGE
#undef PG8_LDA
#undef PG8_LDB
#undef PG8_MMA
#undef PG8_WAIT_V
#undef PG8_WAIT_L
#undef PG8_BAR
#undef PG8_SCHED
}
}

#define LAS __attribute__((address_space(3)))
typedef unsigned short bf16_t;
typedef short bf16x8 __attribute__((ext_vector_type(8)));
typedef short s16x4 __attribute__((ext_vector_type(4)));
typedef float f32x4 __attribute__((ext_vector_type(4)));
typedef unsigned u32x4 __attribute__((ext_vector_type(4)));
typedef unsigned u32x2 __attribute__((ext_vector_type(2)));
using pg8::cvt_pk_bf16; using pg8::bflo; using pg8::bfhi; using pg8::fsigmoid;

constexpr int DM = 1024, NBATCH = 8, SEQ = 4096, TT = NBATCH * SEQ, NIN = 11272, NP = 11264, FF = 2816;
constexpr int GB = 4, TG = GB * SEQ, NGRP = NBATCH / GB;
constexpr int NBH = GB * 4;
constexpr int LDS_BYTES = 147456;
constexpr int NTHR = 512;
constexpr int PP = 1024;
#define SEC(C) ((size_t)((C) / 1024) * ((size_t)TG * 1024) + (size_t)((C) % 1024))
constexpr int C_MQ = 0, C_MK = 1024, C_MV = 2048, C_MO = 3072, C_PU = 4096, C_AQ = 5120, C_AK = 6144, C_AV = 7168, C_GT = 8192;
constexpr size_t MiB = 1u << 20;
constexpr size_t WS_ROPE = 1 * MiB;
constexpr size_t WS_WIN = 2 * MiB, WS_WMO = 24 * MiB, WS_WPOOL = 26 * MiB, WS_WDIFF = 27 * MiB, WS_WOUT = 29 * MiB, WS_WGU = 31 * MiB, WS_WDN = 42 * MiB;
constexpr size_t WS_GIF = 48 * MiB;
constexpr size_t WS_MV = 48 * MiB + 512 * 1024;
constexpr size_t WS_NST = 49 * MiB;
constexpr size_t WS_HN = 50 * MiB;
constexpr size_t WS_CST = 82 * MiB;
constexpr size_t WS_PROJ = 146 * MiB;
constexpr size_t WS_END = 498 * MiB;

__device__ __forceinline__ int my_tid() { int t = threadIdx.x; asm volatile("" : "+v"(t)); return t; }
__device__ __forceinline__ float wave_sum(float v) {
#pragma unroll
    for (int o = 1; o < 64; o <<= 1) v += __shfl_xor(v, o);
    return v;
}
__device__ __forceinline__ float wave_max(float v) {
#pragma unroll
    for (int o = 1; o < 64; o <<= 1) v = fmaxf(v, __shfl_xor(v, o));
    return v;
}
typedef short v4i16_t __attribute__((ext_vector_type(4)));
__device__ __forceinline__ s16x4 vtr(const LAS char* p) { return __builtin_bit_cast(s16x4, __builtin_amdgcn_ds_read_tr16_b64_v4i16((LAS v4i16_t*)p)); }
__device__ __forceinline__ bf16x8 trfrag(const LAS char* base, int pitch, int k0, int n0, int lane) {
    const int g = lane >> 4, q = (lane & 15) >> 2, p = lane & 3;
    const LAS char* a = base + (k0 + 4 * g + q) * pitch + (n0 + 4 * p) * 2;
    const s16x4 lo = vtr(a), hi = vtr(a + 16 * pitch);
    return (bf16x8){lo[0], lo[1], lo[2], lo[3], hi[0], hi[1], hi[2], hi[3]};
}
__device__ __forceinline__ bf16x8 rowfrag(const LAS char* base, int pitch, int r0, int c0, int lane) {
    return *(const LAS bf16x8*)(base + (r0 + (lane & 15)) * pitch + (c0 + 8 * (lane >> 4)) * 2);
}
__device__ __forceinline__ bf16x8 rowfrag_perm(const LAS char* base, int pitch, int r0, int c0, int lane) {
    const LAS char* a = base + (r0 + (lane & 15)) * pitch + (c0 + 4 * (lane >> 4)) * 2;
    const s16x4 lo = *(const LAS s16x4*)a, hi = *(const LAS s16x4*)(a + 32);
    return (bf16x8){lo[0], lo[1], lo[2], lo[3], hi[0], hi[1], hi[2], hi[3]};
}
__device__ __forceinline__ f32x4 mfma16(bf16x8 a, bf16x8 b, f32x4 c) { return __builtin_amdgcn_mfma_f32_16x16x32_bf16(a, b, c, 0, 0, 0); }
__device__ __forceinline__ void unpack8(const u32x4 v, float (&f)[8]) {
    f[0] = bflo(v.x); f[1] = bfhi(v.x); f[2] = bflo(v.y); f[3] = bfhi(v.y); f[4] = bflo(v.z); f[5] = bfhi(v.z); f[6] = bflo(v.w); f[7] = bfhi(v.w);
}
__device__ __forceinline__ u32x4 pack8(const float (&f)[8]) {
    u32x4 w; w.x = cvt_pk_bf16(f[0], f[1]); w.y = cvt_pk_bf16(f[2], f[3]); w.z = cvt_pk_bf16(f[4], f[5]); w.w = cvt_pk_bf16(f[6], f[7]); return w;
}
#define LDS_WAIT() asm volatile("s_waitcnt lgkmcnt(0)" ::: "memory")
#define BAR_LDS() do { asm volatile("s_waitcnt lgkmcnt(0)" ::: "memory"); __builtin_amdgcn_s_barrier(); asm volatile("" ::: "memory"); } while (0)

struct Args { const float* in[16]; float* out; unsigned char* ws; int ph_lo, ph_hi; };
#define XB_TMO      128
#define XB_XCNT(j)  (256  + 64 * (j))
#define XB_XSUB(j)  (1280 + 64 * (j))
#define XB_XGEN(j)  (2304 + 64 * (j))
#define XB_TOP      3328
#define XB_TOPGEN   3392
#define XCD_BAR_WORDS 3456
#define XB_SPIN_CAP (1u << 18)

__device__ __forceinline__ unsigned xb_ld(unsigned* p)              { return __hip_atomic_load(p, __ATOMIC_RELAXED, __HIP_MEMORY_SCOPE_AGENT); }
__device__ __forceinline__ unsigned xb_add(unsigned* p, unsigned v) { return __hip_atomic_fetch_add(p, v, __ATOMIC_RELAXED, __HIP_MEMORY_SCOPE_AGENT); }
__device__ __forceinline__ unsigned xb_xcc_id() { return (unsigned)__builtin_amdgcn_s_getreg((3 << 11) | 20) & 0xFu; }
#define XB_SPIN(cond, bar) do { unsigned _sp = 0; while (cond) { __builtin_amdgcn_s_sleep(1); \
    if ((++_sp & 255u) == 0u) { if (xb_ld(&(bar)[XB_TMO])) break; if (_sp > XB_SPIN_CAP) { atomicAdd(&(bar)[XB_TMO], 1u); break; } } } } while (0)

struct XcdBarrier {
    unsigned* bar; unsigned x;
    volatile LAS unsigned* st;
};

__device__ __forceinline__ XcdBarrier xcd_barrier_post(unsigned* bar, volatile LAS unsigned* st) {
    XcdBarrier b; b.bar = bar; b.x = xb_xcc_id(); b.st = st;
    if (threadIdx.x == 0) (void)xb_add(&bar[XB_XCNT(b.x)], 1u);
    return b;
}
__device__ __forceinline__ void xcd_barrier_complete(unsigned* bar, unsigned x, unsigned& nloc, unsigned& nx) {
    const unsigned G = gridDim.x * gridDim.y * gridDim.z;
    unsigned sum, cnt, mine, sp = 0u;
    for (;;) {
        sum = 0u; cnt = 0u; mine = 0u;
#pragma unroll
        for (unsigned j = 0; j < 16; ++j) { const unsigned c = xb_ld(&bar[XB_XCNT(j)]); sum += c; cnt += (c > 0u) ? 1u : 0u; mine = (j == x) ? c : mine; }
        if (sum == G) break;
        __builtin_amdgcn_s_sleep(1);
        if ((++sp & 255u) == 0u) { if (xb_ld(&bar[XB_TMO])) break; if (sp > XB_SPIN_CAP) { atomicAdd(&bar[XB_TMO], 1u); break; } }
    }
    nloc = mine > 0u ? mine : 1u; nx = cnt > 0u ? cnt : 1u;
}

__device__ __forceinline__ void xcd_barrier(const XcdBarrier& b) {
    asm volatile("s_waitcnt vmcnt(0)" ::: "memory");
    __syncthreads();
    if (threadIdx.x == 0) {
        unsigned* bar = b.bar;
        __builtin_amdgcn_s_waitcnt(0);
        unsigned nloc = b.st[0], nx = b.st[1];
        if (nloc == 0u) { xcd_barrier_complete(bar, b.x, nloc, nx); b.st[0] = nloc; b.st[1] = nx; }
        const unsigned old = xb_add(&bar[XB_XSUB(b.x)], 1u);
        const unsigned gen = old / nloc;
        if (old + 1u == (gen + 1u) * nloc) {
            __builtin_amdgcn_fence(__ATOMIC_RELEASE, "agent");
            asm volatile("s_waitcnt vmcnt(0)" ::: "memory");
            const unsigned og = xb_add(&bar[XB_TOP], 1u);
            const unsigned tg = og / nx;
            if (og + 1u == (tg + 1u) * nx) xb_add(&bar[XB_TOPGEN], 1u);
            else XB_SPIN(xb_ld(&bar[XB_TOPGEN]) == tg, bar);
            __builtin_amdgcn_fence(__ATOMIC_ACQUIRE, "agent");
            xb_add(&bar[XB_XGEN(b.x)], 1u);
            asm volatile("s_waitcnt vmcnt(0)" ::: "memory");
        } else {
            XB_SPIN(xb_ld(&bar[XB_XGEN(b.x)]) == gen, bar);
            __builtin_amdgcn_fence(__ATOMIC_ACQUIRE, "agent");
            asm volatile("s_waitcnt vmcnt(0)" ::: "memory");
        }
    }
    __syncthreads();
}


__device__ __forceinline__ void cvt_item(const float* W, int ldw, int k0, int srccol0, bf16_t* WT, int K, int dstrow0, const float* rowscale, LAS float* scr, int lane) {
#pragma unroll 8
    for (int i = 0; i < 32; ++i) { const int kk = 2 * i + (lane >> 5); scr[kk * 33 + (lane & 31)] = W[(size_t)(k0 + kk) * ldw + srccol0 + (lane & 31)]; }
    LDS_WAIT();
    const int c = lane & 7;
#pragma unroll
    for (int j = 0; j < 4; ++j) { const int n = (lane >> 3) + 8 * j; const LAS float* s = scr + (8 * c) * 33 + n;
        const float sc = rowscale ? rowscale[n] : 1.0f;
        u32x4 o; o.x = cvt_pk_bf16(s[0 * 33] * sc, s[1 * 33] * sc); o.y = cvt_pk_bf16(s[2 * 33] * sc, s[3 * 33] * sc); o.z = cvt_pk_bf16(s[4 * 33] * sc, s[5 * 33] * sc); o.w = cvt_pk_bf16(s[6 * 33] * sc, s[7 * 33] * sc);
        *(u32x4*)(WT + (size_t)(dstrow0 + n) * K + k0 + 8 * c) = o; }
    LDS_WAIT();
}
__device__ __forceinline__ void phase_weights(const Args& a, int l, LAS unsigned char* lds) {
    const int tid = my_tid(), lane = tid & 63, wave = tid >> 6;
    LAS float* scr = (LAS float*)(lds + wave * 8704);
    const int gw = blockIdx.x * 8 + wave, NGW = gridDim.x * 8;
    unsigned char* ws = a.ws;
    const float* w_in = a.in[2] + (size_t)l * DM * NIN;
    const float* w_mo = a.in[5] + (size_t)l * DM * DM;
    const float* w_pool = a.in[6] + (size_t)l * 4 * 256 * 256;
    const float* pscale = a.in[7] + (size_t)l * DM;
    const float* w_diff = a.in[11] + (size_t)l * DM * DM;
    const float* w_out = a.in[12] + (size_t)l * DM * DM;
    const float* w_gu = a.in[14] + (size_t)l * DM * 2 * FF;
    const float* w_dn = a.in[15] + (size_t)l * FF * DM;
    constexpr int I0 = 16 * (NP / 32), I1 = 16 * 32, I2 = 4 * 4 * 8, I3 = I1, I4 = I1, I5 = 16 * (2 * FF / 32), I6 = (FF / 64) * 32;
    constexpr int NIT = I0 + I1 + I2 + I3 + I4 + I5 + I6;
    for (int it = gw; it < NIT; it += NGW) {
        int r = it;
        if (r < I0) { const int nb = r % (NP / 32), kb = r / (NP / 32), n0 = nb * 32; cvt_item(w_in, NIN, kb * 64, n0 < 4096 ? n0 : n0 + 8, (bf16_t*)(ws + WS_WIN), DM, n0, nullptr, scr, lane); continue; } r -= I0;
        if (r < I1) { const int nb = r % 32, kb = r / 32; cvt_item(w_mo, DM, kb * 64, nb * 32, (bf16_t*)(ws + WS_WMO), DM, nb * 32, nullptr, scr, lane); continue; } r -= I1;
        if (r < I2) { const int g = r / 32, q = r % 32, nb = q % 8, kb = q / 8; cvt_item(w_pool + g * 65536, 256, kb * 64, nb * 32, (bf16_t*)(ws + WS_WPOOL), 256, g * 256 + nb * 32, pscale + g * 256 + nb * 32, scr, lane); continue; } r -= I2;
        if (r < I3) { const int nb = r % 32, kb = r / 32; cvt_item(w_diff, DM, kb * 64, nb * 32, (bf16_t*)(ws + WS_WDIFF), DM, nb * 32, nullptr, scr, lane); continue; } r -= I3;
        if (r < I4) { const int nb = r % 32, kb = r / 32; cvt_item(w_out, DM, kb * 64, nb * 32, (bf16_t*)(ws + WS_WOUT), DM, nb * 32, nullptr, scr, lane); continue; } r -= I4;
        if (r < I5) { const int nb = r % (2 * FF / 32), kb = r / (2 * FF / 32), n0 = nb * 32, pn = n0 >> 8, wi = n0 & 255;
            const int sc0 = wi < 128 ? 128 * pn + wi : FF + 128 * pn + (wi - 128);
            cvt_item(w_gu, 2 * FF, kb * 64, sc0, (bf16_t*)(ws + WS_WGU), DM, n0, nullptr, scr, lane); continue; } r -= I5;
        { const int nb = r % 32, kb = r / 32; cvt_item(w_dn, DM, kb * 64, nb * 32, (bf16_t*)(ws + WS_WDN), FF, nb * 32, nullptr, scr, lane); }
    }
    if (l == 0) {
        float2* tab = (float2*)(ws + WS_ROPE);
        for (int e = blockIdx.x * NTHR + tid; e < SEQ * 32; e += gridDim.x * NTHR) {
            const int pos = e >> 5, i = e & 31;
            double inv = 1.0; const double rr = 0.74989420933245582730;
            for (int j = 0; j < i; ++j) inv *= rr;
            const double t2 = inv * inv; double cs = 1.0, sn = inv, tc = 1.0, tsn = inv;
#pragma unroll
            for (int n = 1; n <= 12; ++n) { tc *= -t2 / (double)((2 * n - 1) * (2 * n)); cs += tc; tsn *= -t2 / (double)((2 * n) * (2 * n + 1)); sn += tsn; }
            double zr = 1.0, zi = 0.0, br = cs, bi = sn;
            for (int b = 0; b < 12; ++b) { if ((pos >> b) & 1) { const double nr = zr * br - zi * bi, ni = zr * bi + zi * br; zr = nr; zi = ni; } const double sr = br * br - bi * bi, si = 2.0 * br * bi; br = sr; bi = si; }
            tab[e] = make_float2((float)zr, (float)zi);
        }
    }
}

template <bool GATES>
__device__ __forceinline__ void phase_norm(const float* x, const float* gain, bf16_t* hn, int nrows, const float* w_in_l, const float* bif, float* gif, LAS unsigned char* lds) {
    const int tid = my_tid(), lane = tid & 63, wave = tid >> 6;
    LAS float* wif = (LAS float*)lds;
    f32x4 wr[GATES ? 8 : 1][4];
    if (GATES) {
        for (int i = 0; i < 16; ++i) { const int idx = tid + NTHR * i, k = idx >> 3, e = idx & 7; wif[e * 1024 + k] = w_in_l[(size_t)k * NIN + 4096 + e]; }
        __syncthreads();
#pragma unroll
        for (int e = 0; e < 8; ++e)
#pragma unroll
            for (int j = 0; j < 4; ++j) wr[e][j] = *(const LAS f32x4*)(wif + e * 1024 + 4 * lane + 256 * j);
    }
    const int gw = blockIdx.x * 8 + wave, NGW = gridDim.x * 8;
    f32x4 gv[4];
#pragma unroll
    for (int j = 0; j < 4; ++j) gv[j] = *(const f32x4*)(gain + 4 * lane + 256 * j);
    f32x4 v[4], nx[4];
    if (gw < nrows) { const f32x4* xr = (const f32x4*)(x + (size_t)gw * DM) + lane;
#pragma unroll
        for (int j = 0; j < 4; ++j) nx[j] = xr[64 * j]; }
    for (int row = gw; row < nrows; row += NGW) {
        float ss = 0.f;
#pragma unroll
        for (int j = 0; j < 4; ++j) v[j] = nx[j];
        if (row + NGW < nrows) { const f32x4* xr = (const f32x4*)(x + (size_t)(row + NGW) * DM) + lane;
#pragma unroll
            for (int j = 0; j < 4; ++j) nx[j] = xr[64 * j]; }
#pragma unroll
        for (int j = 0; j < 4; ++j) ss += (v[j].x * v[j].x + v[j].y * v[j].y) + (v[j].z * v[j].z + v[j].w * v[j].w);
        const float rstd = 1.0f / sqrtf(wave_sum(ss) * (1.0f / DM) + 1e-6f);
        u32x2* o8 = (u32x2*)(hn + (size_t)row * DM) + lane;
#pragma unroll
        for (int j = 0; j < 4; ++j) { v[j] = v[j] * rstd * gv[j]; u32x2 w; w.x = cvt_pk_bf16(v[j].x, v[j].y); w.y = cvt_pk_bf16(v[j].z, v[j].w); o8[64 * j] = w; }
        if (GATES) {
            float ga[8];
#pragma unroll
            for (int e = 0; e < 8; ++e) { float s = 0.f;
#pragma unroll
                for (int j = 0; j < 4; ++j) { const f32x4 w = wr[e][j]; s += (v[j].x * w.x + v[j].y * w.y) + (v[j].z * w.z + v[j].w * w.w); }
                ga[e] = s; }
            float h4[4], h2[2], h1;
            { const bool up = (lane & 32) != 0;
#pragma unroll
              for (int i = 0; i < 4; ++i) { const float mine = up ? ga[4 + i] : ga[i], other = up ? ga[i] : ga[4 + i]; h4[i] = mine + __shfl_xor(other, 32); } }
            { const bool up = (lane & 16) != 0;
#pragma unroll
              for (int i = 0; i < 2; ++i) { const float mine = up ? h4[2 + i] : h4[i], other = up ? h4[i] : h4[2 + i]; h2[i] = mine + __shfl_xor(other, 16); } }
            { const bool up = (lane & 8) != 0; const float mine = up ? h2[1] : h2[0], other = up ? h2[0] : h2[1]; h1 = mine + __shfl_xor(other, 8); }
            h1 += __shfl_xor(h1, 4); h1 += __shfl_xor(h1, 2); h1 += __shfl_xor(h1, 1);
            if ((lane & 7) == 0) {
                const int e = 4 * (lane >> 5) + 2 * ((lane >> 4) & 1) + ((lane >> 3) & 1);
                const float pre = h1 + bif[e];
                gif[(size_t)row * 8 + e] = (e < 4) ? pre : (fminf(pre, 0.f) - log1pf(__expf(-fabsf(pre))));
            }
        }
    }
    __syncthreads();
}

constexpr int PIT = 544;
constexpr int XOFF = 0, YOFF = 128 * PIT, VECOFF = 2 * 128 * PIT;
__device__ __forceinline__ void load_plain(LAS char* dst, const bf16_t* src, size_t gpitch, int tid) {
#pragma unroll
    for (int i = 0; i < 8; ++i) { const int id = tid + NTHR * i, row = id >> 5, cc = id & 31;
        const u32x4 v = *(const u32x4*)(src + (size_t)row * gpitch + cc * 8);
        *(LAS u32x4*)(dst + row * PIT + cc * 16) = v; }
}
__device__ __forceinline__ void load_plain_issue(u32x4 (&pre)[8], const bf16_t* src, size_t gpitch, int tid) {
#pragma unroll
    for (int i = 0; i < 8; ++i) { const int id = tid + NTHR * i, row = id >> 5, cc = id & 31; pre[i] = *(const u32x4*)(src + (size_t)row * gpitch + cc * 8); }
}
__device__ __forceinline__ void load_plain_commit(LAS char* dst, const u32x4 (&pre)[8], int tid) {
#pragma unroll
    for (int i = 0; i < 8; ++i) { const int id = tid + NTHR * i, row = id >> 5, cc = id & 31; *(LAS u32x4*)(dst + row * PIT + cc * 16) = pre[i]; }
}
__device__ __forceinline__ void load_conv(LAS char* dst, const bf16_t* src, int pos0, const float* cw  , const LAS float* rowscale, float cscale, int tid) {
    const int cg = tid & 31, rs = tid >> 5, r0 = rs * 8;
    u32x4 rw[11];
#pragma unroll
    for (int j = 0; j < 11; ++j) { const int rr = r0 - 3 + j;
        if (j >= 3 || pos0 + rr >= 0) rw[j] = *(const u32x4*)(src + (ptrdiff_t)rr * PP + cg * 8); else rw[j] = (u32x4){0u, 0u, 0u, 0u}; }
    float w[4][8];
#pragma unroll
    for (int j = 0; j < 4; ++j) { const f32x4 a = *(const f32x4*)(cw + j * 2048 + cg * 8), b = *(const f32x4*)(cw + j * 2048 + cg * 8 + 4);
        w[j][0] = a.x; w[j][1] = a.y; w[j][2] = a.z; w[j][3] = a.w; w[j][4] = b.x; w[j][5] = b.y; w[j][6] = b.z; w[j][7] = b.w; }
    float sc8[8];
#pragma unroll
    for (int r = 0; r < 8; ++r) sc8[r] = rowscale ? rowscale[r0 + r] : cscale;
    float u[3][8];
#pragma unroll
    for (int j = 0; j < 3; ++j) unpack8(rw[j], u[j]);
#pragma unroll
    for (int r = 0; r < 8; ++r) {
        float x[8]; unpack8(rw[3 + r], x);
        const float sc = sc8[r];
        float o[8];
#pragma unroll
        for (int e = 0; e < 8; ++e) { const float cv = (w[0][e] * u[0][e] + w[1][e] * u[1][e]) + (w[2][e] * u[2][e] + w[3][e] * x[e]); o[e] = cv * fsigmoid(cv) * sc;
            u[0][e] = u[1][e]; u[1][e] = u[2][e]; u[2][e] = x[e]; }
        *(LAS u32x4*)(dst + (r0 + r) * PIT + cg * 16) = pack8(o);
    }
}
__device__ __forceinline__ void load_conv_issue(u32x4 (&rw)[11], const bf16_t* src, int pos0, int tid) {
    const int cg = tid & 31, r0 = (tid >> 5) * 8;
#pragma unroll
    for (int j = 0; j < 11; ++j) { const int rr = r0 - 3 + j;
        if (j >= 3 || pos0 + rr >= 0) rw[j] = *(const u32x4*)(src + (ptrdiff_t)rr * PP + cg * 8); else rw[j] = (u32x4){0u, 0u, 0u, 0u}; }
}
__device__ __forceinline__ void load_conv_finish(LAS char* dst, const u32x4 (&rw)[11], const float* cw, const LAS float* rowscale, float cscale, int tid) {
    const int cg = tid & 31, r0 = (tid >> 5) * 8;
    float w[4][8];
#pragma unroll
    for (int j = 0; j < 4; ++j) { const f32x4 a = *(const f32x4*)(cw + j * 2048 + cg * 8), b = *(const f32x4*)(cw + j * 2048 + cg * 8 + 4);
        w[j][0] = a.x; w[j][1] = a.y; w[j][2] = a.z; w[j][3] = a.w; w[j][4] = b.x; w[j][5] = b.y; w[j][6] = b.z; w[j][7] = b.w; }
    float sc8[8];
#pragma unroll
    for (int r = 0; r < 8; ++r) sc8[r] = rowscale ? rowscale[r0 + r] : cscale;
    float u[3][8];
#pragma unroll
    for (int j = 0; j < 3; ++j) unpack8(rw[j], u[j]);
#pragma unroll
    for (int r = 0; r < 8; ++r) {
        float x[8]; unpack8(rw[3 + r], x);
        const float sc = sc8[r];
        float o[8];
#pragma unroll
        for (int e = 0; e < 8; ++e) { const float cv = (w[0][e] * u[0][e] + w[1][e] * u[1][e]) + (w[2][e] * u[2][e] + w[3][e] * x[e]); o[e] = cv * fsigmoid(cv) * sc;
            u[0][e] = u[1][e]; u[1][e] = u[2][e]; u[2][e] = x[e]; }
        *(LAS u32x4*)(dst + (r0 + r) * PIT + cg * 16) = pack8(o);
    }
}
__device__ __forceinline__ void load_gates(LAS float* vec, const float* gif, int t0, int h, int tid) {
    LAS float* li = vec; LAS float* bc = vec + 128; LAS float* tot = vec + 256;
    const int lane = tid & 63;
    float v = 0.f;
    if (tid < 128) { li[tid] = gif[(size_t)(t0 + tid) * 8 + h]; v = gif[(size_t)(t0 + tid) * 8 + 4 + h];
#pragma unroll
        for (int o = 1; o < 64; o <<= 1) { const float uu = __shfl_up(v, o); if (lane >= o) v += uu; }
        if (tid == 63) tot[0] = v; }
    __syncthreads();
    if (tid < 128) { if (tid >= 64) v += tot[0]; bc[tid] = v; }
}

__device__ __forceinline__ void m1_phase(LAS char* lds, const bf16_t* proj, const float* gif, bf16_t* Cst, float* nst, float* gch, float* mloc, const float* convw, int bx, int G) {
    const int tid = my_tid(), lane = tid & 63, wid = __builtin_amdgcn_readfirstlane(tid >> 6), g = lane >> 4, fr = lane & 15;
    LAS char* X = lds + XOFF; LAS char* Y = lds + YOFF; LAS float* vec = (LAS float*)(lds + VECOFF);
    LAS float* li = vec; LAS float* bc = vec + 128; LAS float* tot = vec + 256; LAS float* es = vec + 272;
    u32x4 rk[11]; float liv = 0.f, lfv = 0.f;
#define M1_ISSUE(it_) do { const int bhl_ = (it_) >> 5, c_ = (it_) & 31, h_ = bhl_ & 3, t0_ = (bhl_ >> 2) * SEQ + c_ * 128; \
        load_conv_issue(rk, proj + SEC(C_MK) + (size_t)t0_ * PP + h_ * 256, c_ * 128, tid); \
        if (tid < 128) { liv = gif[(size_t)(t0_ + tid) * 8 + h_]; lfv = gif[(size_t)(t0_ + tid) * 8 + 4 + h_]; } } while (0)
    if (bx >= NBH * 32) return;
    M1_ISSUE(bx);
    for (int it = bx; it < NBH * 32; it += G) {
        const int bhl = it >> 5, h = bhl & 3, item = it;
        u32x4 pv[8]; load_plain_issue(pv, proj + SEC(C_MV) + (size_t)((bhl >> 2) * SEQ + (it & 31) * 128) * PP + h * 256, PP, tid);
        float v = lfv;
        if (tid < 128) { li[tid] = liv;
#pragma unroll
            for (int o = 1; o < 64; o <<= 1) { const float uu = __shfl_up(v, o); if (lane >= o) v += uu; }
            if (tid == 63) tot[0] = v; }
        BAR_LDS();
        if (tid < 128) { if (tid >= 64) v += tot[0]; bc[tid] = v; }
        BAR_LDS();
        const float gtot = bc[127];
        const float w0 = gtot - bc[lane] + li[lane], w1 = gtot - bc[lane + 64] + li[lane + 64];
        const float ml = wave_max(fmaxf(w0, w1));
        if (tid < 128) es[tid] = __expf(gtot - bc[tid] + li[tid] - ml);
        if (tid == 0) { gch[item] = gtot; mloc[item] = ml; }
        BAR_LDS();
        load_conv_finish(X, rk, convw + 1024 + h * 256, es, 1.0f, tid);
        load_plain_commit(Y, pv, tid);
        BAR_LDS();
        if (it + G < NBH * 32) M1_ISSUE(it + G);
        { float sn = 0.f; const LAS char* xc = X + ((tid >> 8) * 64) * PIT + (tid & 255) * 2;
#pragma unroll 16
            for (int r = 0; r < 64; ++r) sn += __uint_as_float((unsigned)(*(const LAS unsigned short*)(xc + r * PIT)) << 16);
            vec[400 + tid] = sn; }
        bf16_t* Co = Cst + (size_t)item * 65536;
#pragma unroll 1
        for (int hk = 0; hk < 2; ++hk) {
            f32x4 acc[2][8];
#pragma unroll
            for (int i = 0; i < 2; ++i)
#pragma unroll
                for (int j = 0; j < 8; ++j) acc[i][j] = (f32x4){0.f, 0.f, 0.f, 0.f};
            const LAS char* Xh = X + hk * 256;
#pragma unroll 1
            for (int t = 0; t < 4; ++t) {
                const bf16x8 v0 = trfrag(Y, PIT, 32 * t, 16 * (2 * wid), lane), v1 = trfrag(Y, PIT, 32 * t, 16 * (2 * wid + 1), lane);
#pragma unroll
                for (int kh = 0; kh < 2; ++kh) {
                    bf16x8 kf[4];
#pragma unroll
                    for (int kb = 0; kb < 4; ++kb) kf[kb] = trfrag(Xh, PIT, 32 * t, 16 * (4 * kh + kb), lane);
                    __builtin_amdgcn_sched_barrier(0);
#pragma unroll
                    for (int kb = 0; kb < 4; ++kb) { acc[0][4 * kh + kb] = mfma16(v0, kf[kb], acc[0][4 * kh + kb]); acc[1][4 * kh + kb] = mfma16(v1, kf[kb], acc[1][4 * kh + kb]); } }
            }
#pragma unroll
            for (int i = 0; i < 2; ++i)
#pragma unroll
                for (int kb = 0; kb < 8; ++kb) { u32x2 w; w.x = cvt_pk_bf16(acc[i][kb][0], acc[i][kb][1]); w.y = cvt_pk_bf16(acc[i][kb][2], acc[i][kb][3]);
                    *(u32x2*)(Co + (size_t)(128 * hk + 16 * kb + fr) * 256 + 16 * (2 * wid + i) + 4 * g) = w; }
        }
        BAR_LDS();
        if (tid < 256) nst[(size_t)item * 256 + tid] = vec[400 + tid] + vec[656 + tid];
        BAR_LDS();
    }
#undef M1_ISSUE
}

__device__ __forceinline__ void phase_scan(bf16_t* Cst, float* nst, const float* gch, const float* mloc, float* mprev) {
    const int tid = my_tid();
    for (int i = blockIdx.x * NTHR + tid; i < NBH * 8192 + NBH * 256; i += gridDim.x * NTHR) {
        if (i < NBH * 8192) {
            const int bh = i >> 13, e8 = i & 8191;
            float st[8];
#pragma unroll
            for (int e = 0; e < 8; ++e) st[e] = 0.f;
            float m = -1e30f;
            for (int c0 = 0; c0 < 32; c0 += 8) {
                u32x4 ld[8];
#pragma unroll
                for (int j = 0; j < 8; ++j) ld[j] = *(const u32x4*)(Cst + ((size_t)(bh * 32 + c0 + j) * 65536 + e8 * 8));
#pragma unroll
                for (int j = 0; j < 8; ++j) { const int c = c0 + j; const float gc = gch[bh * 32 + c], mc = mloc[bh * 32 + c];
                    const float mn = fmaxf(gc + m, mc), aa = __expf(gc + m - mn), bb = __expf(mc - mn);
                    float lc[8]; unpack8(ld[j], lc);
                    *(u32x4*)(Cst + ((size_t)(bh * 32 + c) * 65536 + e8 * 8)) = pack8(st);
#pragma unroll
                    for (int e = 0; e < 8; ++e) st[e] = aa * st[e] + bb * lc[e];
                    if (e8 == 0) mprev[bh * 32 + c] = m;
                    m = mn; }
            }
        } else {
            const int j = i - NBH * 8192, bh = j >> 8, k = j & 255;
            float st = 0.f, m = -1e30f;
            for (int c = 0; c < 32; ++c) { const float gc = gch[bh * 32 + c], mc = mloc[bh * 32 + c];
                const float mn = fmaxf(gc + m, mc), aa = __expf(gc + m - mn), bb = __expf(mc - mn);
                const size_t o = (size_t)(bh * 32 + c) * 256 + k; const float lc = nst[o]; nst[o] = st; st = aa * st + bb * lc; m = mn; }
        }
    }
}

__device__ __forceinline__ void m3_item(LAS char* lds, bf16_t* proj, const float* gif, const bf16_t* Cst, const float* nst, const float* mprev, const float* convw, int bhl, int c) {
    const int tid = my_tid(), lane = tid & 63, wid = __builtin_amdgcn_readfirstlane(tid >> 6), g = lane >> 4, fr = lane & 15;
    const int bl = bhl >> 2, h = bhl & 3, item = bhl * 32 + c, t0 = bl * SEQ + c * 128;
    LAS char* X = lds + XOFF; LAS char* Y = lds + YOFF; LAS float* vec = (LAS float*)(lds + VECOFF);
    LAS float* li = vec; LAS float* bc = vec + 128; LAS float* npv = vec + 272;
    load_gates(vec, gif, t0, h, tid);
    if (tid < 256) npv[tid] = nst[(size_t)item * 256 + tid];
    load_conv(X, proj + SEC(C_MQ) + (size_t)t0 * PP + h * 256, c * 128, convw + h * 256, nullptr, 0.0625f, tid);
    load_conv(Y, proj + SEC(C_MK) + (size_t)t0 * PP + h * 256, c * 128, convw + 1024 + h * 256, nullptr, 1.0f, tid);
    __syncthreads();
    const int j0 = 16 * wid, jj = j0 + fr;
    bf16x8 pf[4]; float den, inter, mt;
    u32x4 pre[8];
    load_plain_issue(pre, Cst + (size_t)item * 65536, 256, tid);
    {
        f32x4 S[8];
#pragma unroll
        for (int sb = 0; sb < 8; ++sb) S[sb] = (f32x4){0.f, 0.f, 0.f, 0.f};
#pragma unroll 1
        for (int t = 0; t < 8; ++t) { const bf16x8 qb = rowfrag(X, PIT, j0, 32 * t, lane);
            bf16x8 kf[8];
#pragma unroll
            for (int sb = 0; sb < 8; ++sb) kf[sb] = rowfrag(Y, PIT, 16 * sb, 32 * t, lane);
            __builtin_amdgcn_sched_barrier(0);
#pragma unroll
            for (int sb = 0; sb < 8; ++sb) S[sb] = mfma16(kf[sb], qb, S[sb]); }
        float qn = 0.f;
        { const LAS char* qr = X + jj * PIT + (64 * g) * 2;
#pragma unroll 2
            for (int i = 0; i < 8; ++i) { const u32x4 v = *(const LAS u32x4*)(qr + 16 * i); float f[8]; unpack8(v, f);
                const f32x4 n0 = *(const LAS f32x4*)(npv + 64 * g + 8 * i), n1 = *(const LAS f32x4*)(npv + 64 * g + 8 * i + 4);
                qn += (f[0] * n0.x + f[1] * n0.y) + (f[2] * n0.z + f[3] * n0.w) + (f[4] * n1.x + f[5] * n1.y) + (f[6] * n1.z + f[7] * n1.w); } }
        qn += __shfl_xor(qn, 16); qn += __shfl_xor(qn, 32);
        const float bj = bc[jj], mp = mprev[item];
        float rmax = -INFINITY;
#pragma unroll
        for (int sb = 0; sb < 8; ++sb) { const f32x4 b4 = *(const LAS f32x4*)(bc + 16 * sb + 4 * g), l4 = *(const LAS f32x4*)(li + 16 * sb + 4 * g);
#pragma unroll
            for (int r = 0; r < 4; ++r) { const int s = 16 * sb + 4 * g + r; const float dm = (s <= jj) ? (bj - b4[r] + l4[r]) : -INFINITY; rmax = fmaxf(rmax, dm); } }
        rmax = fmaxf(rmax, __shfl_xor(rmax, 16)); rmax = fmaxf(rmax, __shfl_xor(rmax, 32));
        const float minter = bj + mp; mt = fmaxf(minter, rmax); inter = __expf(minter - mt);
        den = 0.f;
#pragma unroll
        for (int sb = 0; sb < 8; ++sb) { const f32x4 b4 = *(const LAS f32x4*)(bc + 16 * sb + 4 * g), l4 = *(const LAS f32x4*)(li + 16 * sb + 4 * g);
#pragma unroll
            for (int r = 0; r < 4; ++r) { const int s = 16 * sb + 4 * g + r; const float p = (s <= jj) ? __expf(bj - b4[r] + l4[r] - mt) : 0.f; const float v = S[sb][r] * p; S[sb][r] = v; den += v; } }
        den += __shfl_xor(den, 16); den += __shfl_xor(den, 32);
        den += inter * qn;
#pragma unroll
        for (int t = 0; t < 4; ++t) { u32x4 w; w.x = cvt_pk_bf16(S[2 * t][0], S[2 * t][1]); w.y = cvt_pk_bf16(S[2 * t][2], S[2 * t][3]); w.z = cvt_pk_bf16(S[2 * t + 1][0], S[2 * t + 1][1]); w.w = cvt_pk_bf16(S[2 * t + 1][2], S[2 * t + 1][3]); pf[t] = __builtin_bit_cast(bf16x8, w); }
    }
    f32x4 acc[16];
#pragma unroll
    for (int j = 0; j < 16; ++j) acc[j] = (f32x4){0.f, 0.f, 0.f, 0.f};
#pragma unroll 1
    for (int half = 0; half < 2; ++half) {
        __syncthreads();
        load_plain_commit(Y, pre, tid);
        if (half == 0) load_plain_issue(pre, Cst + (size_t)item * 65536 + 32768, 256, tid);
        else load_plain_issue(pre, proj + SEC(C_MV) + (size_t)t0 * PP + h * 256, PP, tid);
        __syncthreads();
#pragma unroll 1
        for (int t = 0; t < 4; ++t) { const bf16x8 qb = rowfrag_perm(X, PIT, j0, half * 128 + 32 * t, lane);
#pragma unroll
            for (int hb = 0; hb < 2; ++hb) {
                bf16x8 cf[8];
#pragma unroll
                for (int nb = 0; nb < 8; ++nb) cf[nb] = trfrag(Y, PIT, 32 * t, 16 * (8 * hb + nb), lane);
                __builtin_amdgcn_sched_barrier(0);
#pragma unroll
                for (int nb = 0; nb < 8; ++nb) acc[8 * hb + nb] = mfma16(cf[nb], qb, acc[8 * hb + nb]); } }
    }
#pragma unroll
    for (int nb = 0; nb < 16; ++nb) acc[nb] = acc[nb] * inter;
    __syncthreads();
    load_plain_commit(X, pre, tid);
    __syncthreads();
#pragma unroll
    for (int t = 0; t < 4; ++t) if (2 * t <= wid) {
        bf16x8 vf[16];
#pragma unroll
        for (int nb = 0; nb < 16; ++nb) vf[nb] = trfrag(X, PIT, 32 * t, 16 * nb, lane);
        __builtin_amdgcn_sched_barrier(0);
#pragma unroll
        for (int nb = 0; nb < 16; ++nb) acc[nb] = mfma16(vf[nb], pf[t], acc[nb]); }
    const float rdn = 1.0f / fmaxf(fabsf(den), __expf(-mt));
    bf16_t* op = proj + SEC(C_MO) + (size_t)(t0 + jj) * PP + h * 256 + 4 * g;
    u32x2 sgv[16];
#pragma unroll
    for (int nb = 0; nb < 16; ++nb) sgv[nb] = *(const u32x2*)(op + 16 * nb);
#pragma unroll
    for (int nb = 0; nb < 16; ++nb) { const u32x2 sg = sgv[nb];
        u32x2 w; w.x = cvt_pk_bf16(acc[nb][0] * rdn * bflo(sg.x), acc[nb][1] * rdn * bfhi(sg.x)); w.y = cvt_pk_bf16(acc[nb][2] * rdn * bflo(sg.y), acc[nb][3] * rdn * bfhi(sg.y));
        *(u32x2*)(op + 16 * nb) = w; }
    __syncthreads();
}

__device__ __forceinline__ void phase_qkprep(bf16_t* proj, const float* gqk  , const float2* rope) {
    const int tid = my_tid(), lane = tid & 63, wave = tid >> 6;
    const int gw = blockIdx.x * 8 + wave, NGW = gridDim.x * 8;
    const int grp = lane >> 2, u = lane & 3;
    for (int it = gw; it < TG * 2; it += NGW) {
        const int row = it >> 1, which = it & 1, pos = row & (SEQ - 1);
        bf16_t* p = proj + (which ? SEC(C_AK) : SEC(C_AQ)) + (size_t)row * PP + grp * 64 + 8 * u;
        const u32x4 a = *(const u32x4*)p, b = *(const u32x4*)(p + 32);
        float x1[8], x2[8]; unpack8(a, x1); unpack8(b, x2);
        float ss = 0.f;
#pragma unroll
        for (int e = 0; e < 8; ++e) ss += x1[e] * x1[e] + x2[e] * x2[e];
        ss += __shfl_xor(ss, 1); ss += __shfl_xor(ss, 2);
        const float rstd = 1.0f / sqrtf(ss * (1.0f / 64.0f) + 1e-6f) * (which ? 1.0f : 0.125f * 1.4426950408889634f);
        const float* gq = gqk + which * 64 + 8 * u;
        const float2* cs = rope + (size_t)pos * 32 + 8 * u;
        float o1[8], o2[8];
#pragma unroll
        for (int e = 0; e < 8; ++e) { const float y1 = x1[e] * rstd * gq[e], y2 = x2[e] * rstd * gq[32 + e]; const float2 t = cs[e]; o1[e] = y1 * t.x - y2 * t.y; o2[e] = y2 * t.x + y1 * t.y; }
        *(u32x4*)p = pack8(o1); *(u32x4*)(p + 32) = pack8(o2);
    }
}
__device__ __forceinline__ void phase_pool(const bf16_t* proj, bf16_t* pooled) {
    const int tid = my_tid();
    for (int idx = blockIdx.x * NTHR + tid; idx < (TG / 16) * 128; idx += gridDim.x * NTHR) {
        const int cgi = idx & 127, seg = idx >> 7, r0 = seg * 16, pos0 = r0 & (SEQ - 1), w = 2 << (cgi >> 5);
        const bf16_t* src = proj + SEC(C_PU) + (size_t)r0 * PP + cgi * 8;
        float sum[8];
#pragma unroll
        for (int e = 0; e < 8; ++e) sum[e] = 0.f;
        if (pos0 > 0) for (int j = 1; j < w; ++j) { float f[8]; unpack8(*(const u32x4*)(src - (ptrdiff_t)j * PP), f);
#pragma unroll
            for (int e = 0; e < 8; ++e) sum[e] += f[e]; }
        for (int r = 0; r < 16; ++r) {
            float f[8]; unpack8(*(const u32x4*)(src + (ptrdiff_t)r * PP), f);
            const int pos = pos0 + r;
            if (r >= 1 && pos - w >= 0) { float o[8]; unpack8(*(const u32x4*)(src + (ptrdiff_t)(r - w) * PP), o);
#pragma unroll
                for (int e = 0; e < 8; ++e) sum[e] -= o[e]; }
            const float rc = 1.0f / (float)(pos + 1 < w ? pos + 1 : w);
            float out[8];
#pragma unroll
            for (int e = 0; e < 8; ++e) { sum[e] += f[e]; out[e] = sum[e] * rc - f[e]; }
            *(u32x4*)(pooled + (size_t)(r0 + r) * DM + cgi * 8) = pack8(out);
        }
    }
}

constexpr int APIT = 288, ATILE = 64 * APIT, ABUF = 2 * ATILE;
__device__ __forceinline__ void attn_qkexp(const LAS char* Kb, int k0, int q0, int wid, int lane, int g, int qpos, const bf16x8 (&qf)[2][2], const f32x4 negM, bf16x8 (&pf)[2][2]) {
    f32x4 s[2][4];
    {
        bf16x8 kf[2][4][2];
#pragma unroll
        for (int c = 0; c < 2; ++c)
#pragma unroll
            for (int kb = 0; kb < 4; ++kb)
#pragma unroll
                for (int ks = 0; ks < 2; ++ks) kf[c][kb][ks] = rowfrag(Kb, APIT, 16 * kb, c * 64 + 32 * ks, lane);
        __builtin_amdgcn_sched_barrier(0);
#pragma unroll
        for (int c = 0; c < 2; ++c)
#pragma unroll
            for (int kb = 0; kb < 4; ++kb) s[c][kb] = mfma16(kf[c][kb][0], qf[c][0], negM);
#pragma unroll
        for (int c = 0; c < 2; ++c)
#pragma unroll
            for (int kb = 0; kb < 4; ++kb) s[c][kb] = mfma16(kf[c][kb][1], qf[c][1], s[c][kb]);
    }
    if (k0 + 63 > q0 + 16 * wid) {
#pragma unroll
        for (int c = 0; c < 2; ++c)
#pragma unroll
            for (int kb = 0; kb < 4; ++kb)
#pragma unroll
                for (int r = 0; r < 4; ++r) if (k0 + 16 * kb + 4 * g + r > qpos) s[c][kb][r] = -INFINITY;
    }
#pragma unroll
    for (int c = 0; c < 2; ++c) {
#pragma unroll
        for (int kb = 0; kb < 4; ++kb)
#pragma unroll
            for (int r = 0; r < 4; ++r) s[c][kb][r] = __builtin_amdgcn_exp2f(s[c][kb][r]);
#pragma unroll
        for (int tt = 0; tt < 2; ++tt) { u32x4 w; w.x = cvt_pk_bf16(s[c][2 * tt][0], s[c][2 * tt][1]); w.y = cvt_pk_bf16(s[c][2 * tt][2], s[c][2 * tt][3]);
            w.z = cvt_pk_bf16(s[c][2 * tt + 1][0], s[c][2 * tt + 1][1]); w.w = cvt_pk_bf16(s[c][2 * tt + 1][2], s[c][2 * tt + 1][3]); pf[c][tt] = __builtin_bit_cast(bf16x8, w); }
    }
}
__device__ __forceinline__ void attn_pv(const LAS char* Vb, int lane, const bf16x8 (&pf)[2][2], const bf16x8 onesf, f32x4 (&O)[2][8], f32x4 (&Oe)[2]) {
    bf16x8 va[8], vb[8];
#pragma unroll
    for (int nb = 0; nb < 8; ++nb) va[nb] = trfrag(Vb, APIT, 0, 16 * nb, lane);
#pragma unroll
    for (int nb = 0; nb < 8; ++nb) vb[nb] = trfrag(Vb, APIT, 32, 16 * nb, lane);
    __builtin_amdgcn_sched_barrier(0);
    Oe[0] = mfma16(onesf, pf[0][0], Oe[0]); Oe[1] = mfma16(onesf, pf[1][0], Oe[1]);
#pragma unroll
    for (int nb = 0; nb < 8; ++nb) { O[0][nb] = mfma16(va[nb], pf[0][0], O[0][nb]); O[1][nb] = mfma16(va[nb], pf[1][0], O[1][nb]); }
    Oe[0] = mfma16(onesf, pf[0][1], Oe[0]); Oe[1] = mfma16(onesf, pf[1][1], Oe[1]);
#pragma unroll
    for (int nb = 0; nb < 8; ++nb) { O[0][nb] = mfma16(vb[nb], pf[0][1], O[0][nb]); O[1][nb] = mfma16(vb[nb], pf[1][1], O[1][nb]); }
}
__device__ __forceinline__ void attn_step_fast(const LAS char* Kb, const LAS char* Vb, int lane, const bf16x8 (&qf)[2][2], const f32x4 negM, const bf16x8 onesf, f32x4 (&O)[2][8], f32x4 (&Oe)[2]) {
    f32x4 s0[4], s1[4];
    bf16x8 p0[2], p1[2];
    {
        bf16x8 kf[2][4][2];
#pragma unroll
        for (int c = 0; c < 2; ++c)
#pragma unroll
            for (int kb = 0; kb < 4; ++kb)
#pragma unroll
                for (int ks = 0; ks < 2; ++ks) kf[c][kb][ks] = rowfrag(Kb, APIT, 16 * kb, c * 64 + 32 * ks, lane);
        __builtin_amdgcn_sched_barrier(0);
#pragma unroll
        for (int kb = 0; kb < 4; ++kb) s0[kb] = mfma16(kf[0][kb][0], qf[0][0], negM);
#pragma unroll
        for (int kb = 0; kb < 4; ++kb) s0[kb] = mfma16(kf[0][kb][1], qf[0][1], s0[kb]);
        __builtin_amdgcn_sched_barrier(0);
#pragma unroll
        for (int kb = 0; kb < 4; ++kb) s1[kb] = mfma16(kf[1][kb][0], qf[1][0], negM);
#pragma unroll
        for (int kb = 0; kb < 4; ++kb) s1[kb] = mfma16(kf[1][kb][1], qf[1][1], s1[kb]);
    }
#define ATT_EXPPACK(S, P) do { \
        _Pragma("unroll") for (int kb = 0; kb < 4; ++kb) _Pragma("unroll") for (int r = 0; r < 4; ++r) S[kb][r] = __builtin_amdgcn_exp2f(S[kb][r]); \
        _Pragma("unroll") for (int tt = 0; tt < 2; ++tt) { u32x4 w; w.x = cvt_pk_bf16(S[2 * tt][0], S[2 * tt][1]); w.y = cvt_pk_bf16(S[2 * tt][2], S[2 * tt][3]); \
            w.z = cvt_pk_bf16(S[2 * tt + 1][0], S[2 * tt + 1][1]); w.w = cvt_pk_bf16(S[2 * tt + 1][2], S[2 * tt + 1][3]); P[tt] = __builtin_bit_cast(bf16x8, w); } } while (0)
    ATT_EXPPACK(s0, p0);
#pragma unroll
    for (int i = 0; i < 8; ++i) { __builtin_amdgcn_sched_group_barrier(0x008, 1, 0); __builtin_amdgcn_sched_group_barrier(0x002, 3, 0); }
    __builtin_amdgcn_sched_barrier(0);
    bf16x8 va[8], vb[8];
#pragma unroll
    for (int nb = 0; nb < 8; ++nb) va[nb] = trfrag(Vb, APIT, 0, 16 * nb, lane);
#pragma unroll
    for (int nb = 0; nb < 8; ++nb) vb[nb] = trfrag(Vb, APIT, 32, 16 * nb, lane);
    __builtin_amdgcn_sched_barrier(0);
    Oe[0] = mfma16(onesf, p0[0], Oe[0]);
#pragma unroll
    for (int nb = 0; nb < 8; ++nb) O[0][nb] = mfma16(va[nb], p0[0], O[0][nb]);
    Oe[0] = mfma16(onesf, p0[1], Oe[0]);
#pragma unroll
    for (int nb = 0; nb < 8; ++nb) O[0][nb] = mfma16(vb[nb], p0[1], O[0][nb]);
    ATT_EXPPACK(s1, p1);
#pragma unroll
    for (int i = 0; i < 18; ++i) { __builtin_amdgcn_sched_group_barrier(0x008, 1, 0); __builtin_amdgcn_sched_group_barrier(0x002, 2, 0); }
    __builtin_amdgcn_sched_barrier(0);
    Oe[1] = mfma16(onesf, p1[0], Oe[1]);
#pragma unroll
    for (int nb = 0; nb < 8; ++nb) O[1][nb] = mfma16(va[nb], p1[0], O[1][nb]);
    Oe[1] = mfma16(onesf, p1[1], Oe[1]);
#pragma unroll
    for (int nb = 0; nb < 8; ++nb) O[1][nb] = mfma16(vb[nb], p1[1], O[1][nb]);
#undef ATT_EXPPACK
}
__device__ __forceinline__ void attn_item(LAS char* lds, bf16_t* proj, int bl, int h, int qb, float lam, float oscale, const float* gdh, float smax) {
    const int tid = my_tid(), lane = tid & 63, wid = __builtin_amdgcn_readfirstlane(tid >> 6), g = lane >> 4, fr = lane & 15;
    const size_t rowbase = (size_t)bl * SEQ; const int q0 = qb * 128, qpos = q0 + 16 * wid + fr;
    bf16_t* qp = proj + SEC(C_AQ) + (rowbase + qpos) * PP + h * 128;
    bf16x8 qf[2][2];
#pragma unroll
    for (int c = 0; c < 2; ++c)
#pragma unroll
        for (int ks = 0; ks < 2; ++ks) qf[c][ks] = *(const bf16x8*)(qp + c * 64 + 32 * ks + 8 * g);
    f32x4 O[2][8], Oe[2];
#pragma unroll
    for (int c = 0; c < 2; ++c) { Oe[c] = (f32x4){0.f, 0.f, 0.f, 0.f};
#pragma unroll
        for (int nb = 0; nb < 8; ++nb) O[c][nb] = (f32x4){0.f, 0.f, 0.f, 0.f}; }
    const f32x4 negM = (f32x4){-smax, -smax, -smax, -smax};
    const short one16 = (fr == 0) ? (short)0x3F80 : (short)0;
    const bf16x8 onesf = (bf16x8){one16, one16, one16, one16, one16, one16, one16, one16};
    const int NT = 2 * (qb + 1);
    const int sr0 = tid >> 4, sc = tid & 15;
    const bf16_t* kg = proj + SEC(C_AK) + (rowbase + sr0) * PP + h * 128 + sc * 8;
    const bf16_t* vg = proj + SEC(C_AV) + (rowbase + sr0) * PP + h * 128 + sc * 8;
    const int soff = sr0 * APIT + sc * 16;
    u32x4 kr[2], vr[2];
#define ATT_LOAD(tile) do { _Pragma("unroll") for (int i = 0; i < 2; ++i) { kr[i] = *(const u32x4*)(kg + (size_t)(64 * (tile) + 32 * i) * PP); vr[i] = *(const u32x4*)(vg + (size_t)(64 * (tile) + 32 * i) * PP); } } while (0)
#define ATT_STORE(buf) do { LAS char* nb_ = lds + (buf) * ABUF; _Pragma("unroll") for (int i = 0; i < 2; ++i) { *(LAS u32x4*)(nb_ + soff + 32 * i * APIT) = kr[i]; *(LAS u32x4*)(nb_ + ATILE + soff + 32 * i * APIT) = vr[i]; } } while (0)
    ATT_LOAD(0); ATT_STORE(0);
    __syncthreads();
    const int qmaxw = q0 + 16 * wid + 15;
    int t = 0;
    for (; t < NT - 2; ++t) {
        ATT_LOAD(t + 1);
        const LAS char* Kb = lds + (t & 1) * ABUF;
#if ATT_FAST
        attn_step_fast(Kb, Kb + ATILE, lane, qf, negM, onesf, O, Oe);
#else
        { bf16x8 pq[2][2]; attn_qkexp(Kb, 64 * t, q0, wid, lane, g, qpos, qf, negM, pq); attn_pv(Kb + ATILE, lane, pq, onesf, O, Oe); }
#endif
        ATT_STORE((t + 1) & 1);
        BAR_LDS();
    }
    bf16x8 pf[2][2];
    for (; t < NT; ++t) {
        const int k0 = 64 * t;
        if (t + 1 < NT) ATT_LOAD(t + 1);
        if (k0 <= qmaxw) {
            const LAS char* Kb = lds + (t & 1) * ABUF;
            attn_qkexp(Kb, k0, q0, wid, lane, g, qpos, qf, negM, pf);
            attn_pv(Kb + ATILE, lane, pf, onesf, O, Oe);
        }
        if (t + 1 < NT) ATT_STORE((t + 1) & 1);
        BAR_LDS();
    }
#undef ATT_LOAD
#undef ATT_STORE
    const float l0 = __shfl(Oe[0][0], fr), l1 = __shfl(Oe[1][0], fr);
    const float r0 = 1.0f / l0, r1 = lam / l1;
    float ss = 0.f;
#pragma unroll
    for (int nb = 0; nb < 8; ++nb)
#pragma unroll
        for (int r = 0; r < 4; ++r) { const float o = O[0][nb][r] * r0 - O[1][nb][r] * r1; O[0][nb][r] = o; ss += o * o; }
    ss += __shfl_xor(ss, 16); ss += __shfl_xor(ss, 32);
    const float rstd = 1.0f / sqrtf(ss * (1.0f / 128.0f) + 1e-6f) * oscale;
    f32x4 ggv[8];
#pragma unroll
    for (int nb = 0; nb < 8; ++nb) ggv[nb] = *(const f32x4*)(gdh + 16 * nb + 4 * g);
#pragma unroll
    for (int nb = 0; nb < 8; ++nb) { const f32x4 gg = ggv[nb];
        u32x2 w; w.x = cvt_pk_bf16(O[0][nb][0] * rstd * gg.x, O[0][nb][1] * rstd * gg.y); w.y = cvt_pk_bf16(O[0][nb][2] * rstd * gg.z, O[0][nb][3] * rstd * gg.w);
        *(u32x2*)(qp + ((ptrdiff_t)SEC(C_PU) - (ptrdiff_t)SEC(C_AQ)) + 16 * nb + 4 * g) = w; }
}

#ifndef PH_ONLY
#define PH_ONLY -1
#endif
#define PHO(n) (PH_ONLY < 0 || PH_ONLY == (n))
#ifndef PROJ_ALIGN
#define PROJ_ALIGN true
#endif
#ifndef ATT_FAST
#define ATT_FAST 1
#endif
#ifndef DUP_K
#define DUP_K -1
#endif
__global__ void __launch_bounds__(NTHR, 2) fwd_kernel(Args a) {
    extern __shared__ __attribute__((aligned(16))) unsigned char lds_raw[];
    LAS unsigned char* lds = (LAS unsigned char*)lds_raw;
    cg::grid_group grid = cg::this_grid();
    unsigned char* ws = a.ws;
    bf16_t* proj = (bf16_t*)(ws + WS_PROJ);
    bf16_t* hn = (bf16_t*)(ws + WS_HN);
    bf16_t* Cst = (bf16_t*)(ws + WS_CST);
    float* gif = (float*)(ws + WS_GIF);
    float* gch = (float*)(ws + WS_MV); float* mloc = gch + 512; float* mprev = gch + 1024;
    float* nst = (float*)(ws + WS_NST);
    const int G = gridDim.x, bx = blockIdx.x;
    unsigned* barw = (unsigned*)ws;
    volatile LAS unsigned* bst = (volatile LAS unsigned*)(lds + LDS_BYTES - 64);
    if (threadIdx.x < 2) bst[threadIdx.x] = 0u;
    if (bx == 0) for (int i = threadIdx.x; i < XCD_BAR_WORDS; i += NTHR) barw[i] = 0u;
    __syncthreads();
    XcdBarrier xb; xb.bar = barw; xb.x = 0; xb.st = bst;
    bool xb_ready = false;
    for (int ph = a.ph_lo; ph < a.ph_hi; ++ph) {
        const int l = ph / 18, idx = ph % 18;
        const float* xsrc = (l == 0) ? a.in[0] : a.out;
        if (PHO(0) && idx == 0) {
            phase_weights(a, l, lds);
        } else if (idx <= 14) {
            const int grp = (idx - 1) / 7, k = (idx - 1) % 7;
            const size_t rowoff = (size_t)grp * TG;
            if (PHO(1) && k == 0) {
                for (int rep = 0; rep < (DUP_K == 0 ? 2 : 1); ++rep)
                phase_norm<true>(xsrc + rowoff * DM, a.in[1] + l * DM, hn, TG, a.in[2] + (size_t)l * DM * NIN, a.in[3] + l * 8, gif, lds);
            } else if (PHO(2) && k == 1) {
                pg8::Gemm gm{hn, (const bf16_t*)(ws + WS_WIN), TG, NP, DM, DM, 0}; pg8::StaticOrder S; S.init(TG, NP, G, bx);
                pg8::EpiProj E{proj, PP, (size_t)TG * 1024};
                for (int rep = 0; rep < (DUP_K == 1 ? 2 : 1); ++rep)
                pg8::gemm_phase<pg8::EpiProj, pg8::StaticOrder, PROJ_ALIGN, true>(lds, gm, S, E);
            } else if (PHO(3) && k == 2) {
                const float* convw = a.in[4] + (size_t)l * 4 * 2048;
                for (int rep = 0; rep < (DUP_K == 2 ? 2 : 1); ++rep)
                m1_phase((LAS char*)lds, proj, gif, Cst, nst, gch, mloc, convw, bx, G);
                phase_qkprep(proj, a.in[8] + l * 128, (const float2*)(ws + WS_ROPE));
                phase_pool(proj, hn);
            } else if (PHO(4) && k == 3) {
                phase_scan(Cst, nst, gch, mloc, mprev);
                const float* lp = a.in[9] + l * 256;
                float s01 = 0.f, s23 = 0.f;
                for (int i = 0; i < 64; ++i) { s01 += lp[i] * lp[64 + i]; s23 += lp[128 + i] * lp[192 + i]; }
                float mgq = 0.f, mgk = 0.f; { const float* gq = a.in[8] + l * 128; for (int i = 0; i < 64; ++i) { mgq = fmaxf(mgq, fabsf(gq[i])); mgk = fmaxf(mgk, fabsf(gq[64 + i])); } }
                const float smax = 64.0f * mgq * mgk * (0.125f * 1.4426950408889634f) * 1.01f + 0.25f;
                const float lam_init = 0.8f - 0.6f * expf(-0.3f * (float)l);
                const float lam = expf(s01) - expf(s23) + lam_init;
                for (int rep = 0; rep < (DUP_K == 3 ? 2 : 1); ++rep)
                for (int i = bx; i < GB * 8 * 32; i += G) {
                    const int r = i >> 8, j = i & 255, x = j & 7, y = j >> 3, bh = x + 8 * r, qb = (r & 1) ? 31 - y : y;
                    attn_item((LAS char*)lds, proj, bh >> 3, bh & 7, qb, lam, 1.0f - lam_init, a.in[10] + l * 128, smax);
                }
            } else if (PHO(5) && k == 4) {
                const float* convw = a.in[4] + (size_t)l * 4 * 2048;
                for (int it = bx; it < NBH * 32; it += G) m3_item((LAS char*)lds, proj, gif, Cst, nst, mprev, convw, it >> 5, it & 31);
            } else if (PHO(6) && k == 5) {
#pragma unroll 1
                for (int brr = 0; brr < (DUP_K == 5 ? 6 : 3); ++brr) { const int br = brr % 3;
                    pg8::Gemm gm; gm.M = TG; gm.N = DM;
                    if (br == 0) { gm.A = proj + SEC(C_MO); gm.Bt = (const bf16_t*)(ws + WS_WMO); gm.K = DM; gm.lda = PP; gm.a_pn_off = 0; }
                    else if (br == 1) { gm.A = hn; gm.Bt = (const bf16_t*)(ws + WS_WPOOL); gm.K = 256; gm.lda = DM; gm.a_pn_off = 256; }
                    else { gm.A = proj + SEC(C_PU); gm.Bt = (const bf16_t*)(ws + WS_WDIFF); gm.K = DM; gm.lda = PP; gm.a_pn_off = 0; }
                    pg8::StaticOrder S; S.init(TG, DM, G, bx);
                    pg8::EpiMerge E{proj + SEC(C_MQ), proj + SEC(C_GT) + (size_t)br * ((size_t)TG * 1024), PP, br == 0 ? 1 : 0};
                    pg8::gemm_phase<pg8::EpiMerge, pg8::StaticOrder, true, true>(lds, gm, S, E);
                }
            } else if (PHO(7)) {
                pg8::Gemm gm{proj + SEC(C_MQ), (const bf16_t*)(ws + WS_WOUT), TG, DM, DM, PP, 0}; pg8::StaticOrder S; S.init(TG, DM, G, bx);
                pg8::EpiResid E{xsrc + rowoff * DM, a.out + rowoff * DM, DM};
                pg8::gemm_phase<pg8::EpiResid, pg8::StaticOrder, true, true>(lds, gm, S, E);
            }
        } else if (PHO(8) && idx == 15) {
            phase_norm<false>(a.out, a.in[13] + l * DM, hn, TT, nullptr, nullptr, nullptr, lds);
        } else if (PHO(9) && idx == 16) {
            pg8::Gemm gm{hn, (const bf16_t*)(ws + WS_WGU), TT, 2 * FF, DM, DM, 0}; pg8::StaticOrder S; S.init(TT, 2 * FF, G, bx);
            pg8::EpiSwiGLU E{proj, FF};
            for (int rep = 0; rep < (DUP_K == 16 ? 2 : 1); ++rep)
            pg8::gemm_phase<pg8::EpiSwiGLU, pg8::StaticOrder, true, true>(lds, gm, S, E);
        } else if (PHO(10)) {
            pg8::Gemm gm{proj, (const bf16_t*)(ws + WS_WDN), TT, DM, FF, FF, 0}; pg8::StaticOrder S; S.init(TT, DM, G, bx);
            pg8::EpiResid E{a.out, a.out, DM};
            pg8::gemm_phase<pg8::EpiResid, pg8::StaticOrder, true, true>(lds, gm, S, E);
        }
        if (ph + 1 < a.ph_hi) {
            if (!xb_ready) { grid.sync(); xb = xcd_barrier_post(barw, bst); xb_ready = true; }
            else { xcd_barrier(xb); if (DUP_K == 100) { xcd_barrier(xb); xcd_barrier(xb); } }
        }
    }
}

extern "C" void kernel_launch(void* const* d_in, const int* in_sizes, int n_in, void* d_out, int out_size, void* d_ws, size_t ws_size, hipStream_t stream) {
    static int grid = 0;
    if (grid == 0) {
        if (n_in != 16 || out_size != TT * DM || ws_size < WS_END) { fprintf(stderr, "kernel_launch: unexpected shapes / workspace (%d inputs, out %d, ws %zu)\n", n_in, out_size, ws_size); grid = -1; return; }
        int dev = 0, cus = 0, per_cu = 0;
        hipGetDevice(&dev); hipDeviceGetAttribute(&cus, hipDeviceAttributeMultiprocessorCount, dev);
        hipFuncSetAttribute((const void*)fwd_kernel, hipFuncAttributeMaxDynamicSharedMemorySize, LDS_BYTES);
        hipOccupancyMaxActiveBlocksPerMultiprocessor(&per_cu, (const void*)fwd_kernel, NTHR, LDS_BYTES);
        (void)hipGetLastError();
        if (per_cu < 1) per_cu = 1;
        grid = cus * 1;
        if (grid <= 0) grid = 256;
    }
    if (grid < 0) return;
    Args a{};
    for (int i = 0; i < 16; ++i) a.in[i] = (const float*)d_in[i];
    a.out = (float*)d_out; a.ws = (unsigned char*)d_ws; a.ph_lo = 0; a.ph_hi = 36;
    void* args[] = {&a};
    hipError_t e = hipLaunchCooperativeKernel((const void*)fwd_kernel, dim3(grid), dim3(NTHR), args, LDS_BYTES, stream);
    if (e != hipSuccess) fprintf(stderr, "cooperative launch failed: %s (grid %d)\n", hipGetErrorString(e), grid);
}
```

```cpp
#include <hip/hip_runtime.h>
#include <hip/hip_cooperative_groups.h>
#include <cstdio>
#include <cstdint>
namespace cg = cooperative_groups;
namespace pg8 {
#define PG8_LAS __attribute__((address_space(3)))
typedef unsigned short bf16_t;
typedef short bf16x8 __attribute__((ext_vector_type(8)));
typedef float f32x4 __attribute__((ext_vector_type(4)));
typedef unsigned u32x4 __attribute__((ext_vector_type(4)));
constexpr int BM = 256, BK = 64, HALF = 128, HTB = HALF * BK * 2  , STAGE_BYTES = 8 * HTB, NXCD = 8, WGM = 8;

__host__ __device__ __forceinline__ int lds_byte(int r, int c) { const int st = (r >> 4) * 2 + (c >> 5), rr = r & 15, cc = c & 31, ob = rr * 64 + cc * 2; return st * 1024 + (ob ^ (((ob >> 9) & 1) << 5)); }
__host__ __device__ __forceinline__ void stage_rc(int b, int& R, int& C) { const int st = b / 1024, sb = b % 1024, swz = sb ^ (((sb >> 9) & 1) << 5); R = (st >> 1) * 16 + swz / 64; C = (st & 1) * 32 + (swz % 64) / 2; }
__host__ __device__ __forceinline__ int perm32(int rho) { const int n = rho >> 4, i = rho & 15; return 8 * (i >> 2) + 4 * n + (i & 3); }

struct Unit { int pm, pn; };
struct Gemm { const bf16_t* A; const bf16_t* Bt; int M, N, K, lda, a_pn_off; size_t a_kstep = 0; };

struct StaticOrder {
    int nM, nN, nwg, G, c;
    __host__ __device__ void init(int M, int N, int G_, int c_) { nM = M / BM; nN = N / BM; nwg = nM * nN; G = G_; c = c_; }
    __host__ __device__ bool next(int i, Unit& u) const {
        const long L = (long)i * G + c; if (L >= nwg) return false;
        int wgid = (int)L; { const int q = nwg / NXCD, r = nwg % NXCD, xcd = wgid % NXCD, off = wgid / NXCD; wgid = (xcd < r ? xcd * (q + 1) : r * (q + 1) + (xcd - r) * q) + off; }
        const int nig = WGM * nN, gid = wgid / nig, fm = gid * WGM, gsz = (nM - fm) < WGM ? (nM - fm) : WGM;
        u.pm = fm + ((wgid % nig) % gsz); u.pn = (wgid % nig) / gsz; return true;
    }
    __device__ __forceinline__ void a_ready(const Unit&) const {}
    __device__ __forceinline__ void done(const Unit&) const {}
};

typedef float f32x2_t __attribute__((ext_vector_type(2))); typedef __bf16 bf16x2_t __attribute__((ext_vector_type(2)));
__device__ __forceinline__ unsigned cvt_pk_bf16(float lo, float hi) { const f32x2_t v = {lo, hi}; const bf16x2_t b = __builtin_convertvector(v, bf16x2_t); return __builtin_bit_cast(unsigned, b); }
__device__ __forceinline__ float fsigmoid(float x) { return __builtin_amdgcn_rcpf(1.0f + __expf(-x)); }
__device__ __forceinline__ float bflo(unsigned u) { return __uint_as_float(u << 16); }
__device__ __forceinline__ float bfhi(unsigned u) { return __uint_as_float(u & 0xffff0000u); }

struct EpiProj {
    static constexpr bool PERM = true, AFTER_DRAIN = false;
    bf16_t* O; int ldc; size_t sec_stride;
    __device__ __forceinline__ void operator()(const f32x4 (&acc)[2][2][4][2], const Unit& u, int wr, int wc, int fr, int fq) const {
        const bool sg = (u.pn >= 12 && u.pn < 16) || (u.pn >= 32);
        const int row0 = u.pm * BM + wr * 64 + fr, col0 = (u.pn & 3) * BM + wc * 32 + 8 * fq;
        bf16_t* const Os = O + (size_t)(u.pn >> 2) * sec_stride;
#pragma unroll
        for (int ai = 0; ai < 2; ++ai)
#pragma unroll
            for (int m = 0; m < 4; ++m) { bf16_t* rowp = Os + (size_t)(row0 + ai * HALF + m * 16) * ldc + col0;
#pragma unroll
                for (int bj = 0; bj < 2; ++bj) { f32x4 v0 = acc[ai][bj][m][0], v1 = acc[ai][bj][m][1];
                    if (sg) {
#pragma unroll
                        for (int i = 0; i < 4; ++i) { v0[i] = fsigmoid(v0[i]); v1[i] = fsigmoid(v1[i]); } }
                    u32x4 w; w.x = cvt_pk_bf16(v0[0], v0[1]); w.y = cvt_pk_bf16(v0[2], v0[3]); w.z = cvt_pk_bf16(v1[0], v1[1]); w.w = cvt_pk_bf16(v1[2], v1[3]);
                    *(u32x4*)(rowp + bj * HALF) = w; } }
    }
};
struct EpiMerge {
    static constexpr bool PERM = true, AFTER_DRAIN = false;
    bf16_t* O; const bf16_t* Gt; int ld; int first;
    __device__ __forceinline__ void operator()(const f32x4 (&acc)[2][2][4][2], const Unit& u, int wr, int wc, int fr, int fq) const {
        const int row0 = u.pm * BM + wr * 64 + fr, col0 = u.pn * BM + wc * 32 + 8 * fq;
#pragma unroll
        for (int ai = 0; ai < 2; ++ai) {
            u32x4 gv[4][2], pv[4][2];
#pragma unroll
            for (int m = 0; m < 4; ++m)
#pragma unroll
                for (int bj = 0; bj < 2; ++bj) { const size_t ro = (size_t)(row0 + ai * HALF + m * 16) * ld + col0 + bj * HALF;
                    gv[m][bj] = *(const u32x4*)(Gt + ro); pv[m][bj] = first ? (u32x4){0u, 0u, 0u, 0u} : *(const u32x4*)(O + ro); }
#pragma unroll
            for (int m = 0; m < 4; ++m)
#pragma unroll
                for (int bj = 0; bj < 2; ++bj) { const size_t ro = (size_t)(row0 + ai * HALF + m * 16) * ld + col0 + bj * HALF;
                    const f32x4 v0 = acc[ai][bj][m][0], v1 = acc[ai][bj][m][1]; const u32x4 g4 = gv[m][bj], p4 = pv[m][bj];
                    float o[8];
                    o[0] = v0[0] * bflo(g4.x) + bflo(p4.x); o[1] = v0[1] * bfhi(g4.x) + bfhi(p4.x); o[2] = v0[2] * bflo(g4.y) + bflo(p4.y); o[3] = v0[3] * bfhi(g4.y) + bfhi(p4.y);
                    o[4] = v1[0] * bflo(g4.z) + bflo(p4.z); o[5] = v1[1] * bfhi(g4.z) + bfhi(p4.z); o[6] = v1[2] * bflo(g4.w) + bflo(p4.w); o[7] = v1[3] * bfhi(g4.w) + bfhi(p4.w);
                    u32x4 w; w.x = cvt_pk_bf16(o[0], o[1]); w.y = cvt_pk_bf16(o[2], o[3]); w.z = cvt_pk_bf16(o[4], o[5]); w.w = cvt_pk_bf16(o[6], o[7]);
                    *(u32x4*)(O + ro) = w; }
        }
    }
};
struct EpiResid {
    static constexpr bool PERM = false, AFTER_DRAIN = false;
    const float* base; float* out; int ldc;
    __device__ __forceinline__ void operator()(const f32x4 (&acc)[2][2][4][2], const Unit& u, int wr, int wc, int fr, int fq) const {
        const int row0 = u.pm * BM + wr * 64 + fr, col0 = u.pn * BM + wc * 32 + 4 * fq;
#pragma unroll
        for (int ai = 0; ai < 2; ++ai) {
            f32x4 b[4][2][2];
#pragma unroll
            for (int m = 0; m < 4; ++m) { const size_t off = (size_t)(row0 + ai * HALF + m * 16) * ldc + col0;
#pragma unroll
                for (int bj = 0; bj < 2; ++bj)
#pragma unroll
                    for (int n = 0; n < 2; ++n) b[m][bj][n] = *(const f32x4*)(base + off + bj * HALF + n * 16); }
#pragma unroll
            for (int m = 0; m < 4; ++m) { const size_t off = (size_t)(row0 + ai * HALF + m * 16) * ldc + col0;
#pragma unroll
                for (int bj = 0; bj < 2; ++bj)
#pragma unroll
                    for (int n = 0; n < 2; ++n) *(f32x4*)(out + off + bj * HALF + n * 16) = b[m][bj][n] + acc[ai][bj][m][n]; }
        }
    }
};
struct EpiSwiGLU {
    static constexpr bool PERM = true, AFTER_DRAIN = false;
    bf16_t* O; size_t slab;
    __device__ __forceinline__ void operator()(const f32x4 (&acc)[2][2][4][2], const Unit& u, int wr, int wc, int fr, int fq) const {
        const int row0 = u.pm * BM + wr * 64 + fr;
        bf16_t* const Os = O + (size_t)(2 * u.pn + (wc >> 1)) * slab + (wc & 1) * 32 + 8 * fq;
#pragma unroll
        for (int ai = 0; ai < 2; ++ai)
#pragma unroll
            for (int m = 0; m < 4; ++m) { bf16_t* rowp = Os + (size_t)(row0 + ai * HALF + m * 16) * 64;
                float o[8];
#pragma unroll
                for (int n = 0; n < 2; ++n)
#pragma unroll
                    for (int i = 0; i < 4; ++i) { const float gt = acc[ai][0][m][n][i], up = acc[ai][1][m][n][i]; o[n * 4 + i] = gt * fsigmoid(gt) * up; }
                u32x4 w; w.x = cvt_pk_bf16(o[0], o[1]); w.y = cvt_pk_bf16(o[2], o[3]); w.z = cvt_pk_bf16(o[4], o[5]); w.w = cvt_pk_bf16(o[6], o[7]);
                *(u32x4*)rowp = w; }
    }
};
template <class Epi, class Sched, bool ALIGN_EPI = false, bool SP2 = false>
__device__ __forceinline__ void gemm_phase(PG8_LAS unsigned char* lds, const Gemm g, const Sched& S, const Epi& E) {
    int tid_ = threadIdx.x; asm volatile("" : "+v"(tid_)); const int tid = tid_, wid = __builtin_amdgcn_readfirstlane(tid >> 6), lane = tid & 63, wr = wid >> 2, wc = wid & 3, fr = lane & 15, fq = lane >> 4;
    const int K = g.K, nt = K / BK;
    unsigned voffA[2], voffB[2];
#pragma unroll
    for (int i = 0; i < 2; ++i) { int R, C; stage_rc(tid * 16 + i * 8192, R, C); const int Rb = Epi::PERM ? ((R & ~31) + perm32(R & 31)) : R;
        voffA[i] = (unsigned)(R * g.lda + C) * 2u; voffB[i] = (unsigned)(Rb * K + C) * 2u; }
    const size_t kstep = (size_t)(BK * 2), kstepA = g.a_kstep ? (size_t)g.a_kstep : (size_t)(BK * 2);
    const size_t hstepA = (size_t)HALF * g.lda * 2, hstepB = (size_t)HALF * K * 2;
    const size_t tstepA = 2 * hstepA, tstepB = 2 * hstepB, pnoffA = (size_t)g.a_pn_off * 2;
    const unsigned ldsw = (unsigned)wid * 1024u;
    const int aoff = lds_byte(wr * 64 + fr, fq * 8), boff = lds_byte(wc * 32 + fr, fq * 8);
#define PG8_SA(b, h) (((b) * 2 + (h)) * HTB)
#define PG8_SB(b, h) ((4 + (b) * 2 + (h)) * HTB)
#define PG8_STAGE(bufoff, gbase, voff) do { _Pragma("unroll") for (int _i = 0; _i < 2; ++_i) \
        __builtin_amdgcn_global_load_lds((const unsigned*)((const char*)(gbase) + (voff)[_i]), (PG8_LAS unsigned*)(lds + (bufoff) + ldsw + _i * 8192), 16, 0, 0); } while (0)
#define PG8_LDA(dst, b, h) do { _Pragma("unroll") for (int m = 0; m < 4; ++m) _Pragma("unroll") for (int k = 0; k < 2; ++k) dst[m][k] = *(const PG8_LAS bf16x8*)(lds + PG8_SA(b, h) + aoff + m * 2048 + k * 1024); } while (0)
#define PG8_LDB(dst, b, h) do { _Pragma("unroll") for (int n = 0; n < 2; ++n) _Pragma("unroll") for (int k = 0; k < 2; ++k) dst[n][k] = *(const PG8_LAS bf16x8*)(lds + PG8_SB(b, h) + boff + n * 2048 + k * 1024); } while (0)
#define PG8_MMA(ai, bj, At, Bt) do { __builtin_amdgcn_s_setprio(1); _Pragma("unroll") for (int m = 0; m < 4; ++m) _Pragma("unroll") for (int n = 0; n < 2; ++n) _Pragma("unroll") for (int k = 0; k < 2; ++k) \
        acc[ai][bj][m][n] = __builtin_amdgcn_mfma_f32_16x16x32_bf16(Bt[n][k], At[m][k], acc[ai][bj][m][n], 0, 0, 0); __builtin_amdgcn_s_setprio(0); } while (0)
#define PG8_WAIT_V(n) asm volatile("s_waitcnt vmcnt(" #n ")" ::: "memory")
#define PG8_WAIT_L(n) asm volatile("s_waitcnt lgkmcnt(" #n ")" ::: "memory")
#define PG8_BAR __builtin_amdgcn_s_barrier()
#define PG8_SCHED __builtin_amdgcn_sched_barrier(0)
    Unit cur, nxt; int ui = 0;
    if (!S.next(0, cur)) return;
    f32x4 acc[2][2][4][2];
#pragma unroll
    for (int a = 0; a < 2; ++a)
#pragma unroll
        for (int b = 0; b < 2; ++b)
#pragma unroll
            for (int m = 0; m < 4; ++m)
#pragma unroll
                for (int n = 0; n < 2; ++n) acc[a][b][m][n] = (f32x4){0.f, 0.f, 0.f, 0.f};
    bf16x8 At[4][2], B0[2][2], B1[2][2];
    const char* cA = (const char*)g.A + (size_t)cur.pm * tstepA + (size_t)cur.pn * pnoffA; const char* cB = (const char*)g.Bt + (size_t)cur.pn * tstepB;
    S.a_ready(cur);
    if constexpr (SP2) {
        PG8_STAGE(PG8_SB(0, 0), cB, voffB); PG8_STAGE(PG8_SB(0, 1), cB + hstepB, voffB); PG8_STAGE(PG8_SA(0, 0), cA, voffA); PG8_STAGE(PG8_SA(0, 1), cA + hstepA, voffA);
        if (wr == 1) PG8_BAR;
        PG8_WAIT_V(2); PG8_BAR;
        PG8_STAGE(PG8_SB(1, 0), cB + kstep, voffB); PG8_STAGE(PG8_SA(1, 0), cA + kstepA, voffA); PG8_STAGE(PG8_SB(1, 1), cB + hstepB + kstep, voffB);
        PG8_WAIT_V(6); PG8_BAR;
    } else {
        PG8_STAGE(PG8_SB(0, 0), cB, voffB); PG8_STAGE(PG8_SA(0, 0), cA, voffA); PG8_STAGE(PG8_SB(0, 1), cB + hstepB, voffB); PG8_STAGE(PG8_SA(0, 1), cA + hstepA, voffA);
        if (wr == 1) PG8_BAR;
        PG8_WAIT_V(4); PG8_BAR;
        PG8_STAGE(PG8_SB(1, 0), cB + kstep, voffB); PG8_STAGE(PG8_SA(1, 0), cA + kstepA, voffA); PG8_STAGE(PG8_SB(1, 1), cB + hstepB + kstep, voffB);
        PG8_WAIT_V(6); PG8_BAR;
    }
    for (;;) {
        const bool has_next = S.next(ui + 1, nxt);
        const char* nA = has_next ? (const char*)g.A + (size_t)nxt.pm * tstepA + (size_t)nxt.pn * pnoffA : cA; const char* nB = has_next ? (const char*)g.Bt + (size_t)nxt.pn * tstepB : cB;
        for (int t = 0; t < nt; t += 2) {
            const bool last = (t == nt - 2);
            const char* a1 = cA + (size_t)(t + 1) * kstepA;
            const char* a2 = last ? nA : cA + (size_t)(t + 2) * kstepA; const char* b2 = last ? nB : cB + (size_t)(t + 2) * kstep;
            const char* a3 = a2 + kstepA; const char* b3 = b2 + kstep;
            if (last && has_next) S.a_ready(nxt);
            if constexpr (SP2) {
            PG8_LDB(B0, 0, 0); PG8_LDB(B1, 0, 1); PG8_SCHED; PG8_LDA(At, 0, 0); PG8_STAGE(PG8_SA(1, 1), a1 + hstepA, voffA);
            PG8_WAIT_V(8); PG8_WAIT_L(0); PG8_BAR; PG8_MMA(0, 0, At, B0); PG8_MMA(0, 1, At, B1); PG8_BAR; PG8_SCHED;
            PG8_LDA(At, 0, 1); PG8_STAGE(PG8_SB(0, 0), b2, voffB); PG8_STAGE(PG8_SB(0, 1), b2 + hstepB, voffB); PG8_STAGE(PG8_SA(0, 0), a2, voffA);
            PG8_WAIT_V(8); PG8_WAIT_L(0); PG8_BAR; PG8_MMA(1, 0, At, B0); PG8_MMA(1, 1, At, B1); PG8_BAR; PG8_SCHED;
            PG8_LDB(B0, 1, 0); PG8_LDB(B1, 1, 1); PG8_SCHED; PG8_LDA(At, 1, 0); PG8_STAGE(PG8_SA(0, 1), a2 + hstepA, voffA);
            PG8_WAIT_V(8); PG8_WAIT_L(0); PG8_BAR; PG8_MMA(0, 0, At, B0); PG8_MMA(0, 1, At, B1); PG8_BAR; PG8_SCHED;
            PG8_LDA(At, 1, 1); PG8_STAGE(PG8_SB(1, 0), b3, voffB); PG8_STAGE(PG8_SB(1, 1), b3 + hstepB, voffB); PG8_STAGE(PG8_SA(1, 0), a3, voffA);
            PG8_WAIT_V(8); PG8_WAIT_L(0); PG8_BAR; PG8_MMA(1, 0, At, B0); PG8_MMA(1, 1, At, B1); PG8_BAR; PG8_SCHED;
            } else {
            PG8_LDB(B0, 0, 0); PG8_SCHED; PG8_LDA(At, 0, 0); PG8_STAGE(PG8_SA(1, 1), a1 + hstepA, voffA);
            PG8_WAIT_L(8); PG8_BAR; PG8_WAIT_L(0); PG8_MMA(0, 0, At, B0); PG8_BAR; PG8_SCHED;
            PG8_LDB(B1, 0, 1); PG8_STAGE(PG8_SB(0, 0), b2, voffB);
            PG8_BAR; PG8_WAIT_L(0); PG8_MMA(0, 1, At, B1); PG8_BAR;
            PG8_LDA(At, 0, 1); PG8_STAGE(PG8_SA(0, 0), a2, voffA);
            PG8_BAR; PG8_WAIT_L(0); PG8_MMA(1, 0, At, B0); PG8_BAR; PG8_SCHED;
            PG8_STAGE(PG8_SB(0, 1), b2 + hstepB, voffB);
            PG8_WAIT_V(6); PG8_BAR; PG8_MMA(1, 1, At, B1); PG8_BAR;
            PG8_LDB(B0, 1, 0); PG8_SCHED; PG8_LDA(At, 1, 0); PG8_STAGE(PG8_SA(0, 1), a2 + hstepA, voffA);
            PG8_WAIT_L(8); PG8_BAR; PG8_WAIT_L(0); PG8_MMA(0, 0, At, B0); PG8_BAR; PG8_SCHED;
            PG8_LDB(B1, 1, 1); PG8_STAGE(PG8_SB(1, 0), b3, voffB);
            PG8_BAR; PG8_WAIT_L(0); PG8_MMA(0, 1, At, B1); PG8_BAR;
            PG8_LDA(At, 1, 1); PG8_STAGE(PG8_SA(1, 0), a3, voffA);
            PG8_BAR; PG8_WAIT_L(0); PG8_MMA(1, 0, At, B0); PG8_BAR; PG8_SCHED;
            PG8_STAGE(PG8_SB(1, 1), b3 + hstepB, voffB);
            PG8_WAIT_V(6); PG8_BAR; PG8_MMA(1, 1, At, B1); PG8_BAR;
            }
        }
        if constexpr (ALIGN_EPI) { if (wr == 0) PG8_BAR; }
        if constexpr (!Epi::AFTER_DRAIN) { E(acc, cur, wr, wc, fr, fq); S.done(cur); }
        if (!has_next) break;
#pragma unroll
        for (int a = 0; a < 2; ++a)
#pragma unroll
            for (int b = 0; b < 2; ++b)
#pragma unroll
                for (int m = 0; m < 4; ++m)
#pragma unroll
                    for (int n = 0; n < 2; ++n) acc[a][b][m][n] = (f32x4){0.f, 0.f, 0.f, 0.f};
        cur = nxt; cA = nA; cB = nB; ++ui;
        if constexpr (ALIGN_EPI) { if (wr == 1) PG8_BAR; }
    }
    PG8_WAIT_V(0);
    if constexpr (!ALIGN_EPI) { if (wr == 0) PG8_BAR; }
    PG8_BAR;
    if constexpr (Epi::AFTER_DRAIN) { E.fused(acc, cur, wr, wc, fr, fq, lds, wid, lane); S.done(cur); }
#undef PG8_SA
#undef PG8_SB
#undef PG8_STAGE
#undef PG8_LDA
#undef PG8_LDB
#undef PG8_MMA
#undef PG8_WAIT_V
#undef PG8_WAIT_L
#undef PG8_BAR
#undef PG8_SCHED
}
}

#define LAS __attribute__((address_space(3)))
typedef unsigned short bf16_t;
typedef short bf16x8 __attribute__((ext_vector_type(8)));
typedef short s16x4 __attribute__((ext_vector_type(4)));
typedef float f32x4 __attribute__((ext_vector_type(4)));
typedef unsigned u32x4 __attribute__((ext_vector_type(4)));
typedef unsigned u32x2 __attribute__((ext_vector_type(2)));
using pg8::cvt_pk_bf16; using pg8::bflo; using pg8::bfhi; using pg8::fsigmoid;

constexpr int DM = 1024, NBATCH = 8, SEQ = 4096, TT = NBATCH * SEQ, NIN = 11272, NP = 11264, FF = 2816;
constexpr int GB = 4, TG = GB * SEQ, NGRP = NBATCH / GB;
constexpr int NBH = GB * 4;
constexpr int LDS_BYTES = 147456;
constexpr int NTHR = 512;
constexpr int PP = 1024;
#define SEC(C) ((size_t)((C) / 1024) * ((size_t)TG * 1024) + (size_t)((C) % 1024))
constexpr int C_MQ = 0, C_MK = 1024, C_MV = 2048, C_MO = 3072, C_PU = 4096, C_AQ = 5120, C_AK = 6144, C_AV = 7168, C_GT = 8192;
constexpr size_t MiB = 1u << 20;
constexpr size_t WS_ROPE = 1 * MiB;
constexpr size_t WS_WIN = 2 * MiB, WS_WMO = 24 * MiB, WS_WPOOL = 26 * MiB, WS_WDIFF = 27 * MiB, WS_WOUT = 29 * MiB, WS_WGU = 31 * MiB, WS_WDN = 42 * MiB;
constexpr size_t WS_GIF = 48 * MiB;
constexpr size_t WS_MV = 48 * MiB + 512 * 1024;
constexpr size_t WS_NST = 49 * MiB;
constexpr size_t WS_HN = 50 * MiB;
constexpr size_t WS_CST = 82 * MiB;
constexpr size_t WS_PROJ = 146 * MiB;
constexpr size_t WS_END = 498 * MiB;

__device__ __forceinline__ int my_tid() { int t = threadIdx.x; asm volatile("" : "+v"(t)); return t; }
__device__ __forceinline__ float wave_sum(float v) {
#pragma unroll
    for (int o = 1; o < 64; o <<= 1) v += __shfl_xor(v, o);
    return v;
}
__device__ __forceinline__ float wave_max(float v) {
#pragma unroll
    for (int o = 1; o < 64; o <<= 1) v = fmaxf(v, __shfl_xor(v, o));
    return v;
}
typedef short v4i16_t __attribute__((ext_vector_type(4)));
__device__ __forceinline__ s16x4 vtr(const LAS char* p) { return __builtin_bit_cast(s16x4, __builtin_amdgcn_ds_read_tr16_b64_v4i16((LAS v4i16_t*)p)); }
__device__ __forceinline__ bf16x8 trfrag(const LAS char* base, int pitch, int k0, int n0, int lane) {
    const int g = lane >> 4, q = (lane & 15) >> 2, p = lane & 3;
    const LAS char* a = base + (k0 + 4 * g + q) * pitch + (n0 + 4 * p) * 2;
    const s16x4 lo = vtr(a), hi = vtr(a + 16 * pitch);
    return (bf16x8){lo[0], lo[1], lo[2], lo[3], hi[0], hi[1], hi[2], hi[3]};
}
__device__ __forceinline__ bf16x8 rowfrag(const LAS char* base, int pitch, int r0, int c0, int lane) {
    return *(const LAS bf16x8*)(base + (r0 + (lane & 15)) * pitch + (c0 + 8 * (lane >> 4)) * 2);
}
__device__ __forceinline__ bf16x8 rowfrag_perm(const LAS char* base, int pitch, int r0, int c0, int lane) {
    const LAS char* a = base + (r0 + (lane & 15)) * pitch + (c0 + 4 * (lane >> 4)) * 2;
    const s16x4 lo = *(const LAS s16x4*)a, hi = *(const LAS s16x4*)(a + 32);
    return (bf16x8){lo[0], lo[1], lo[2], lo[3], hi[0], hi[1], hi[2], hi[3]};
}
__device__ __forceinline__ f32x4 mfma16(bf16x8 a, bf16x8 b, f32x4 c) { return __builtin_amdgcn_mfma_f32_16x16x32_bf16(a, b, c, 0, 0, 0); }
__device__ __forceinline__ void unpack8(const u32x4 v, float (&f)[8]) {
    f[0] = bflo(v.x); f[1] = bfhi(v.x); f[2] = bflo(v.y); f[3] = bfhi(v.y); f[4] = bflo(v.z); f[5] = bfhi(v.z); f[6] = bflo(v.w); f[7] = bfhi(v.w);
}
__device__ __forceinline__ u32x4 pack8(const float (&f)[8]) {
    u32x4 w; w.x = cvt_pk_bf16(f[0], f[1]); w.y = cvt_pk_bf16(f[2], f[3]); w.z = cvt_pk_bf16(f[4], f[5]); w.w = cvt_pk_bf16(f[6], f[7]); return w;
}
#define LDS_WAIT() asm volatile("s_waitcnt lgkmcnt(0)" ::: "memory")
#define BAR_LDS() do { asm volatile("s_waitcnt lgkmcnt(0)" ::: "memory"); __builtin_amdgcn_s_barrier(); asm volatile("" ::: "memory"); } while (0)

struct Args { const float* in[16]; float* out; unsigned char* ws; int ph_lo, ph_hi; };
#define XB_TMO      128
#define XB_XCNT(j)  (256  + 64 * (j))
#define XB_XSUB(j)  (1280 + 64 * (j))
#define XB_XGEN(j)  (2304 + 64 * (j))
#define XB_TOP      3328
#define XB_TOPGEN   3392
#define XCD_BAR_WORDS 3456
#define XB_SPIN_CAP (1u << 18)

__device__ __forceinline__ unsigned xb_ld(unsigned* p)              { return __hip_atomic_load(p, __ATOMIC_RELAXED, __HIP_MEMORY_SCOPE_AGENT); }
__device__ __forceinline__ unsigned xb_add(unsigned* p, unsigned v) { return __hip_atomic_fetch_add(p, v, __ATOMIC_RELAXED, __HIP_MEMORY_SCOPE_AGENT); }
__device__ __forceinline__ unsigned xb_xcc_id() { return (unsigned)__builtin_amdgcn_s_getreg((3 << 11) | 20) & 0xFu; }
#define XB_SPIN(cond, bar) do { unsigned _sp = 0; while (cond) { __builtin_amdgcn_s_sleep(1); \
    if ((++_sp & 255u) == 0u) { if (xb_ld(&(bar)[XB_TMO])) break; if (_sp > XB_SPIN_CAP) { atomicAdd(&(bar)[XB_TMO], 1u); break; } } } } while (0)

struct XcdBarrier {
    unsigned* bar; unsigned x;
    volatile LAS unsigned* st;
};

__device__ __forceinline__ XcdBarrier xcd_barrier_post(unsigned* bar, volatile LAS unsigned* st) {
    XcdBarrier b; b.bar = bar; b.x = xb_xcc_id(); b.st = st;
    if (threadIdx.x == 0) (void)xb_add(&bar[XB_XCNT(b.x)], 1u);
    return b;
}
__device__ __forceinline__ void xcd_barrier_complete(unsigned* bar, unsigned x, unsigned& nloc, unsigned& nx) {
    const unsigned G = gridDim.x * gridDim.y * gridDim.z;
    unsigned sum, cnt, mine, sp = 0u;
    for (;;) {
        sum = 0u; cnt = 0u; mine = 0u;
#pragma unroll
        for (unsigned j = 0; j < 16; ++j) { const unsigned c = xb_ld(&bar[XB_XCNT(j)]); sum += c; cnt += (c > 0u) ? 1u : 0u; mine = (j == x) ? c : mine; }
        if (sum == G) break;
        __builtin_amdgcn_s_sleep(1);
        if ((++sp & 255u) == 0u) { if (xb_ld(&bar[XB_TMO])) break; if (sp > XB_SPIN_CAP) { atomicAdd(&bar[XB_TMO], 1u); break; } }
    }
    nloc = mine > 0u ? mine : 1u; nx = cnt > 0u ? cnt : 1u;
}

__device__ __forceinline__ void xcd_barrier(const XcdBarrier& b) {
    asm volatile("s_waitcnt vmcnt(0)" ::: "memory");
    __syncthreads();
    if (threadIdx.x == 0) {
        unsigned* bar = b.bar;
        __builtin_amdgcn_s_waitcnt(0);
        unsigned nloc = b.st[0], nx = b.st[1];
        if (nloc == 0u) { xcd_barrier_complete(bar, b.x, nloc, nx); b.st[0] = nloc; b.st[1] = nx; }
        const unsigned old = xb_add(&bar[XB_XSUB(b.x)], 1u);
        const unsigned gen = old / nloc;
        if (old + 1u == (gen + 1u) * nloc) {
            __builtin_amdgcn_fence(__ATOMIC_RELEASE, "agent");
            asm volatile("s_waitcnt vmcnt(0)" ::: "memory");
            const unsigned og = xb_add(&bar[XB_TOP], 1u);
            const unsigned tg = og / nx;
            if (og + 1u == (tg + 1u) * nx) xb_add(&bar[XB_TOPGEN], 1u);
            else XB_SPIN(xb_ld(&bar[XB_TOPGEN]) == tg, bar);
            __builtin_amdgcn_fence(__ATOMIC_ACQUIRE, "agent");
            xb_add(&bar[XB_XGEN(b.x)], 1u);
            asm volatile("s_waitcnt vmcnt(0)" ::: "memory");
        } else {
            XB_SPIN(xb_ld(&bar[XB_XGEN(b.x)]) == gen, bar);
            __builtin_amdgcn_fence(__ATOMIC_ACQUIRE, "agent");
            asm volatile("s_waitcnt vmcnt(0)" ::: "memory");
        }
    }
    __syncthreads();
}


__device__ __forceinline__ void cvt_item(const float* W, int ldw, int k0, int srccol0, bf16_t* WT, int K, int dstrow0, const float* rowscale, LAS float* scr, int lane) {
#pragma unroll 8
    for (int i = 0; i < 32; ++i) { const int kk = 2 * i + (lane >> 5); scr[kk * 33 + (lane & 31)] = W[(size_t)(k0 + kk) * ldw + srccol0 + (lane & 31)]; }
    LDS_WAIT();
    const int c = lane & 7;
#pragma unroll
    for (int j = 0; j < 4; ++j) { const int n = (lane >> 3) + 8 * j; const LAS float* s = scr + (8 * c) * 33 + n;
        const float sc = rowscale ? rowscale[n] : 1.0f;
        u32x4 o; o.x = cvt_pk_bf16(s[0 * 33] * sc, s[1 * 33] * sc); o.y = cvt_pk_bf16(s[2 * 33] * sc, s[3 * 33] * sc); o.z = cvt_pk_bf16(s[4 * 33] * sc, s[5 * 33] * sc); o.w = cvt_pk_bf16(s[6 * 33] * sc, s[7 * 33] * sc);
        *(u32x4*)(WT + (size_t)(dstrow0 + n) * K + k0 + 8 * c) = o; }
    LDS_WAIT();
}
__device__ __forceinline__ void phase_weights(const Args& a, int l, LAS unsigned char* lds) {
    const int tid = my_tid(), lane = tid & 63, wave = tid >> 6;
    LAS float* scr = (LAS float*)(lds + wave * 8704);
    const int gw = blockIdx.x * 8 + wave, NGW = gridDim.x * 8;
    unsigned char* ws = a.ws;
    const float* w_in = a.in[2] + (size_t)l * DM * NIN;
    const float* w_mo = a.in[5] + (size_t)l * DM * DM;
    const float* w_pool = a.in[6] + (size_t)l * 4 * 256 * 256;
    const float* pscale = a.in[7] + (size_t)l * DM;
    const float* w_diff = a.in[11] + (size_t)l * DM * DM;
    const float* w_out = a.in[12] + (size_t)l * DM * DM;
    const float* w_gu = a.in[14] + (size_t)l * DM * 2 * FF;
    const float* w_dn = a.in[15] + (size_t)l * FF * DM;
    constexpr int I0 = 16 * (NP / 32), I1 = 16 * 32, I2 = 4 * 4 * 8, I3 = I1, I4 = I1, I5 = 16 * (2 * FF / 32), I6 = (FF / 64) * 32;
    constexpr int NIT = I0 + I1 + I2 + I3 + I4 + I5 + I6;
    for (int it = gw; it < NIT; it += NGW) {
        int r = it;
        if (r < I0) { const int nb = r % (NP / 32), kb = r / (NP / 32), n0 = nb * 32; cvt_item(w_in, NIN, kb * 64, n0 < 4096 ? n0 : n0 + 8, (bf16_t*)(ws + WS_WIN), DM, n0, nullptr, scr, lane); continue; } r -= I0;
        if (r < I1) { const int nb = r % 32, kb = r / 32; cvt_item(w_mo, DM, kb * 64, nb * 32, (bf16_t*)(ws + WS_WMO), DM, nb * 32, nullptr, scr, lane); continue; } r -= I1;
        if (r < I2) { const int g = r / 32, q = r % 32, nb = q % 8, kb = q / 8; cvt_item(w_pool + g * 65536, 256, kb * 64, nb * 32, (bf16_t*)(ws + WS_WPOOL), 256, g * 256 + nb * 32, pscale + g * 256 + nb * 32, scr, lane); continue; } r -= I2;
        if (r < I3) { const int nb = r % 32, kb = r / 32; cvt_item(w_diff, DM, kb * 64, nb * 32, (bf16_t*)(ws + WS_WDIFF), DM, nb * 32, nullptr, scr, lane); continue; } r -= I3;
        if (r < I4) { const int nb = r % 32, kb = r / 32; cvt_item(w_out, DM, kb * 64, nb * 32, (bf16_t*)(ws + WS_WOUT), DM, nb * 32, nullptr, scr, lane); continue; } r -= I4;
        if (r < I5) { const int nb = r % (2 * FF / 32), kb = r / (2 * FF / 32), n0 = nb * 32, pn = n0 >> 8, wi = n0 & 255;
            const int sc0 = wi < 128 ? 128 * pn + wi : FF + 128 * pn + (wi - 128);
            cvt_item(w_gu, 2 * FF, kb * 64, sc0, (bf16_t*)(ws + WS_WGU), DM, n0, nullptr, scr, lane); continue; } r -= I5;
        { const int nb = r % 32, kb = r / 32; cvt_item(w_dn, DM, kb * 64, nb * 32, (bf16_t*)(ws + WS_WDN), FF, nb * 32, nullptr, scr, lane); }
    }
    if (l == 0) {
        float2* tab = (float2*)(ws + WS_ROPE);
        for (int e = blockIdx.x * NTHR + tid; e < SEQ * 32; e += gridDim.x * NTHR) {
            const int pos = e >> 5, i = e & 31;
            double inv = 1.0; const double rr = 0.74989420933245582730;
            for (int j = 0; j < i; ++j) inv *= rr;
            const double t2 = inv * inv; double cs = 1.0, sn = inv, tc = 1.0, tsn = inv;
#pragma unroll
            for (int n = 1; n <= 12; ++n) { tc *= -t2 / (double)((2 * n - 1) * (2 * n)); cs += tc; tsn *= -t2 / (double)((2 * n) * (2 * n + 1)); sn += tsn; }
            double zr = 1.0, zi = 0.0, br = cs, bi = sn;
            for (int b = 0; b < 12; ++b) { if ((pos >> b) & 1) { const double nr = zr * br - zi * bi, ni = zr * bi + zi * br; zr = nr; zi = ni; } const double sr = br * br - bi * bi, si = 2.0 * br * bi; br = sr; bi = si; }
            tab[e] = make_float2((float)zr, (float)zi);
        }
    }
}

template <bool GATES>
__device__ __forceinline__ void phase_norm(const float* x, const float* gain, bf16_t* hn, int nrows, const float* w_in_l, const float* bif, float* gif, LAS unsigned char* lds) {
    const int tid = my_tid(), lane = tid & 63, wave = tid >> 6;
    LAS float* wif = (LAS float*)lds;
    f32x4 wr[GATES ? 8 : 1][4];
    if (GATES) {
        for (int i = 0; i < 16; ++i) { const int idx = tid + NTHR * i, k = idx >> 3, e = idx & 7; wif[e * 1024 + k] = w_in_l[(size_t)k * NIN + 4096 + e]; }
        __syncthreads();
#pragma unroll
        for (int e = 0; e < 8; ++e)
#pragma unroll
            for (int j = 0; j < 4; ++j) wr[e][j] = *(const LAS f32x4*)(wif + e * 1024 + 4 * lane + 256 * j);
    }
    const int gw = blockIdx.x * 8 + wave, NGW = gridDim.x * 8;
    f32x4 gv[4];
#pragma unroll
    for (int j = 0; j < 4; ++j) gv[j] = *(const f32x4*)(gain + 4 * lane + 256 * j);
    f32x4 v[4], nx[4];
    if (gw < nrows) { const f32x4* xr = (const f32x4*)(x + (size_t)gw * DM) + lane;
#pragma unroll
        for (int j = 0; j < 4; ++j) nx[j] = xr[64 * j]; }
    for (int row = gw; row < nrows; row += NGW) {
        float ss = 0.f;
#pragma unroll
        for (int j = 0; j < 4; ++j) v[j] = nx[j];
        if (row + NGW < nrows) { const f32x4* xr = (const f32x4*)(x + (size_t)(row + NGW) * DM) + lane;
#pragma unroll
            for (int j = 0; j < 4; ++j) nx[j] = xr[64 * j]; }
#pragma unroll
        for (int j = 0; j < 4; ++j) ss += (v[j].x * v[j].x + v[j].y * v[j].y) + (v[j].z * v[j].z + v[j].w * v[j].w);
        const float rstd = 1.0f / sqrtf(wave_sum(ss) * (1.0f / DM) + 1e-6f);
        bf16_t* o8 = hn + (size_t)(lane >> 4) * ((size_t)nrows * 64) + (size_t)row * 64 + 4 * (lane & 15);
#pragma unroll
        for (int j = 0; j < 4; ++j) { v[j] = v[j] * rstd * gv[j]; u32x2 w; w.x = cvt_pk_bf16(v[j].x, v[j].y); w.y = cvt_pk_bf16(v[j].z, v[j].w); *(u32x2*)(o8 + (size_t)(4 * j) * ((size_t)nrows * 64)) = w; }
        if (GATES) {
            float ga[8];
#pragma unroll
            for (int e = 0; e < 8; ++e) { float s = 0.f;
#pragma unroll
                for (int j = 0; j < 4; ++j) { const f32x4 w = wr[e][j]; s += (v[j].x * w.x + v[j].y * w.y) + (v[j].z * w.z + v[j].w * w.w); }
                ga[e] = s; }
            float h4[4], h2[2], h1;
            { const bool up = (lane & 32) != 0;
#pragma unroll
              for (int i = 0; i < 4; ++i) { const float mine = up ? ga[4 + i] : ga[i], other = up ? ga[i] : ga[4 + i]; h4[i] = mine + __shfl_xor(other, 32); } }
            { const bool up = (lane & 16) != 0;
#pragma unroll
              for (int i = 0; i < 2; ++i) { const float mine = up ? h4[2 + i] : h4[i], other = up ? h4[i] : h4[2 + i]; h2[i] = mine + __shfl_xor(other, 16); } }
            { const bool up = (lane & 8) != 0; const float mine = up ? h2[1] : h2[0], other = up ? h2[0] : h2[1]; h1 = mine + __shfl_xor(other, 8); }
            h1 += __shfl_xor(h1, 4); h1 += __shfl_xor(h1, 2); h1 += __shfl_xor(h1, 1);
            if ((lane & 7) == 0) {
                const int e = 4 * (lane >> 5) + 2 * ((lane >> 4) & 1) + ((lane >> 3) & 1);
                const float pre = h1 + bif[e];
                gif[(size_t)row * 8 + e] = (e < 4) ? pre : (fminf(pre, 0.f) - log1pf(__expf(-fabsf(pre))));
            }
        }
    }
    __syncthreads();
}

constexpr int PIT = 544;
constexpr int XOFF = 0, YOFF = 128 * PIT, VECOFF = 2 * 128 * PIT;
__device__ __forceinline__ void load_plain(LAS char* dst, const bf16_t* src, size_t gpitch, int tid) {
#pragma unroll
    for (int i = 0; i < 8; ++i) { const int id = tid + NTHR * i, row = id >> 5, cc = id & 31;
        const u32x4 v = *(const u32x4*)(src + (size_t)row * gpitch + cc * 8);
        *(LAS u32x4*)(dst + row * PIT + cc * 16) = v; }
}
__device__ __forceinline__ void load_plain_issue(u32x4 (&pre)[8], const bf16_t* src, size_t gpitch, int tid) {
#pragma unroll
    for (int i = 0; i < 8; ++i) { const int id = tid + NTHR * i, row = id >> 5, cc = id & 31; pre[i] = *(const u32x4*)(src + (size_t)row * gpitch + cc * 8); }
}
__device__ __forceinline__ void load_plain_commit(LAS char* dst, const u32x4 (&pre)[8], int tid) {
#pragma unroll
    for (int i = 0; i < 8; ++i) { const int id = tid + NTHR * i, row = id >> 5, cc = id & 31; *(LAS u32x4*)(dst + row * PIT + cc * 16) = pre[i]; }
}
__device__ __forceinline__ void load_conv(LAS char* dst, const bf16_t* src, int pos0, const float* cw  , const LAS float* rowscale, float cscale, int tid) {
    const int cg = tid & 31, rs = tid >> 5, r0 = rs * 8;
    u32x4 rw[11];
#pragma unroll
    for (int j = 0; j < 11; ++j) { const int rr = r0 - 3 + j;
        if (j >= 3 || pos0 + rr >= 0) rw[j] = *(const u32x4*)(src + (ptrdiff_t)rr * PP + cg * 8); else rw[j] = (u32x4){0u, 0u, 0u, 0u}; }
    float w[4][8];
#pragma unroll
    for (int j = 0; j < 4; ++j) { const f32x4 a = *(const f32x4*)(cw + j * 2048 + cg * 8), b = *(const f32x4*)(cw + j * 2048 + cg * 8 + 4);
        w[j][0] = a.x; w[j][1] = a.y; w[j][2] = a.z; w[j][3] = a.w; w[j][4] = b.x; w[j][5] = b.y; w[j][6] = b.z; w[j][7] = b.w; }
    float sc8[8];
#pragma unroll
    for (int r = 0; r < 8; ++r) sc8[r] = rowscale ? rowscale[r0 + r] : cscale;
    float u[3][8];
#pragma unroll
    for (int j = 0; j < 3; ++j) unpack8(rw[j], u[j]);
#pragma unroll
    for (int r = 0; r < 8; ++r) {
        float x[8]; unpack8(rw[3 + r], x);
        const float sc = sc8[r];
        float o[8];
#pragma unroll
        for (int e = 0; e < 8; ++e) { const float cv = (w[0][e] * u[0][e] + w[1][e] * u[1][e]) + (w[2][e] * u[2][e] + w[3][e] * x[e]); o[e] = cv * fsigmoid(cv) * sc;
            u[0][e] = u[1][e]; u[1][e] = u[2][e]; u[2][e] = x[e]; }
        *(LAS u32x4*)(dst + (r0 + r) * PIT + cg * 16) = pack8(o);
    }
}
__device__ __forceinline__ void load_conv_issue(u32x4 (&rw)[11], const bf16_t* src, int pos0, int tid) {
    const int cg = tid & 31, r0 = (tid >> 5) * 8;
#pragma unroll
    for (int j = 0; j < 11; ++j) { const int rr = r0 - 3 + j;
        if (j >= 3 || pos0 + rr >= 0) rw[j] = *(const u32x4*)(src + (ptrdiff_t)rr * PP + cg * 8); else rw[j] = (u32x4){0u, 0u, 0u, 0u}; }
}
__device__ __forceinline__ void load_conv_finish(LAS char* dst, const u32x4 (&rw)[11], const float* cw, const LAS float* rowscale, float cscale, int tid) {
    const int cg = tid & 31, r0 = (tid >> 5) * 8;
    float w[4][8];
#pragma unroll
    for (int j = 0; j < 4; ++j) { const f32x4 a = *(const f32x4*)(cw + j * 2048 + cg * 8), b = *(const f32x4*)(cw + j * 2048 + cg * 8 + 4);
        w[j][0] = a.x; w[j][1] = a.y; w[j][2] = a.z; w[j][3] = a.w; w[j][4] = b.x; w[j][5] = b.y; w[j][6] = b.z; w[j][7] = b.w; }
    float sc8[8];
#pragma unroll
    for (int r = 0; r < 8; ++r) sc8[r] = rowscale ? rowscale[r0 + r] : cscale;
    float u[3][8];
#pragma unroll
    for (int j = 0; j < 3; ++j) unpack8(rw[j], u[j]);
#pragma unroll
    for (int r = 0; r < 8; ++r) {
        float x[8]; unpack8(rw[3 + r], x);
        const float sc = sc8[r];
        float o[8];
#pragma unroll
        for (int e = 0; e < 8; ++e) { const float cv = (w[0][e] * u[0][e] + w[1][e] * u[1][e]) + (w[2][e] * u[2][e] + w[3][e] * x[e]); o[e] = cv * fsigmoid(cv) * sc;
            u[0][e] = u[1][e]; u[1][e] = u[2][e]; u[2][e] = x[e]; }
        *(LAS u32x4*)(dst + (r0 + r) * PIT + cg * 16) = pack8(o);
    }
}
__device__ __forceinline__ void load_gates(LAS float* vec, const float* gif, int t0, int h, int tid) {
    LAS float* li = vec; LAS float* bc = vec + 128; LAS float* tot = vec + 256;
    const int lane = tid & 63;
    float v = 0.f;
    if (tid < 128) { li[tid] = gif[(size_t)(t0 + tid) * 8 + h]; v = gif[(size_t)(t0 + tid) * 8 + 4 + h];
#pragma unroll
        for (int o = 1; o < 64; o <<= 1) { const float uu = __shfl_up(v, o); if (lane >= o) v += uu; }
        if (tid == 63) tot[0] = v; }
    __syncthreads();
    if (tid < 128) { if (tid >= 64) v += tot[0]; bc[tid] = v; }
}

__device__ __forceinline__ void m1_phase(LAS char* lds, const bf16_t* proj, const float* gif, bf16_t* Cst, float* nst, float* gch, float* mloc, const float* convw, int bx, int G) {
    const int tid = my_tid(), lane = tid & 63, wid = __builtin_amdgcn_readfirstlane(tid >> 6), g = lane >> 4, fr = lane & 15;
    LAS char* X = lds + XOFF; LAS char* Y = lds + YOFF; LAS float* vec = (LAS float*)(lds + VECOFF);
    LAS float* li = vec; LAS float* bc = vec + 128; LAS float* tot = vec + 256; LAS float* es = vec + 272;
    u32x4 rk[11]; float liv = 0.f, lfv = 0.f;
#define M1_ISSUE(it_) do { const int bhl_ = (it_) >> 5, c_ = (it_) & 31, h_ = bhl_ & 3, t0_ = (bhl_ >> 2) * SEQ + c_ * 128; \
        load_conv_issue(rk, proj + SEC(C_MK) + (size_t)t0_ * PP + h_ * 256, c_ * 128, tid); \
        if (tid < 128) { liv = gif[(size_t)(t0_ + tid) * 8 + h_]; lfv = gif[(size_t)(t0_ + tid) * 8 + 4 + h_]; } } while (0)
    if (bx >= NBH * 32) return;
    M1_ISSUE(bx);
    for (int it = bx; it < NBH * 32; it += G) {
        const int bhl = it >> 5, h = bhl & 3, item = it;
        u32x4 pv[8]; load_plain_issue(pv, proj + SEC(C_MV) + (size_t)((bhl >> 2) * SEQ + (it & 31) * 128) * PP + h * 256, PP, tid);
        float v = lfv;
        if (tid < 128) { li[tid] = liv;
#pragma unroll
            for (int o = 1; o < 64; o <<= 1) { const float uu = __shfl_up(v, o); if (lane >= o) v += uu; }
            if (tid == 63) tot[0] = v; }
        BAR_LDS();
        if (tid < 128) { if (tid >= 64) v += tot[0]; bc[tid] = v; }
        BAR_LDS();
        const float gtot = bc[127];
        const float w0 = gtot - bc[lane] + li[lane], w1 = gtot - bc[lane + 64] + li[lane + 64];
        const float ml = wave_max(fmaxf(w0, w1));
        if (tid < 128) es[tid] = __expf(gtot - bc[tid] + li[tid] - ml);
        if (tid == 0) { gch[item] = gtot; mloc[item] = ml; }
        BAR_LDS();
        load_conv_finish(X, rk, convw + 1024 + h * 256, es, 1.0f, tid);
        load_plain_commit(Y, pv, tid);
        BAR_LDS();
        if (it + G < NBH * 32) M1_ISSUE(it + G);
        { float sn = 0.f; const LAS char* xc = X + ((tid >> 8) * 64) * PIT + (tid & 255) * 2;
#pragma unroll 16
            for (int r = 0; r < 64; ++r) sn += __uint_as_float((unsigned)(*(const LAS unsigned short*)(xc + r * PIT)) << 16);
            vec[400 + tid] = sn; }
        bf16_t* Co = Cst + (size_t)item * 65536;
#pragma unroll 1
        for (int hk = 0; hk < 2; ++hk) {
            f32x4 acc[2][8];
#pragma unroll
            for (int i = 0; i < 2; ++i)
#pragma unroll
                for (int j = 0; j < 8; ++j) acc[i][j] = (f32x4){0.f, 0.f, 0.f, 0.f};
            const LAS char* Xh = X + hk * 256;
#pragma unroll 1
            for (int t = 0; t < 4; ++t) {
                const bf16x8 v0 = trfrag(Y, PIT, 32 * t, 16 * (2 * wid), lane), v1 = trfrag(Y, PIT, 32 * t, 16 * (2 * wid + 1), lane);
#pragma unroll
                for (int kh = 0; kh < 2; ++kh) {
                    bf16x8 kf[4];
#pragma unroll
                    for (int kb = 0; kb < 4; ++kb) kf[kb] = trfrag(Xh, PIT, 32 * t, 16 * (4 * kh + kb), lane);
                    __builtin_amdgcn_sched_barrier(0);
#pragma unroll
                    for (int kb = 0; kb < 4; ++kb) { acc[0][4 * kh + kb] = mfma16(v0, kf[kb], acc[0][4 * kh + kb]); acc[1][4 * kh + kb] = mfma16(v1, kf[kb], acc[1][4 * kh + kb]); } }
            }
#pragma unroll
            for (int i = 0; i < 2; ++i)
#pragma unroll
                for (int kb = 0; kb < 8; ++kb) { u32x2 w; w.x = cvt_pk_bf16(acc[i][kb][0], acc[i][kb][1]); w.y = cvt_pk_bf16(acc[i][kb][2], acc[i][kb][3]);
                    *(u32x2*)(Co + (size_t)(128 * hk + 16 * kb + fr) * 256 + 16 * (2 * wid + i) + 4 * g) = w; }
        }
        BAR_LDS();
        if (tid < 256) nst[(size_t)item * 256 + tid] = vec[400 + tid] + vec[656 + tid];
        BAR_LDS();
    }
#undef M1_ISSUE
}

__device__ __forceinline__ void phase_scan(bf16_t* Cst, float* nst, const float* gch, const float* mloc, float* mprev) {
    const int tid = my_tid();
    for (int i = blockIdx.x * NTHR + tid; i < NBH * 8192 + NBH * 256; i += gridDim.x * NTHR) {
        if (i < NBH * 8192) {
            const int bh = i >> 13, e8 = i & 8191;
            float st[8];
#pragma unroll
            for (int e = 0; e < 8; ++e) st[e] = 0.f;
            float m = -1e30f;
            for (int c0 = 0; c0 < 32; c0 += 8) {
                u32x4 ld[8];
#pragma unroll
                for (int j = 0; j < 8; ++j) ld[j] = *(const u32x4*)(Cst + ((size_t)(bh * 32 + c0 + j) * 65536 + e8 * 8));
#pragma unroll
                for (int j = 0; j < 8; ++j) { const int c = c0 + j; const float gc = gch[bh * 32 + c], mc = mloc[bh * 32 + c];
                    const float mn = fmaxf(gc + m, mc), aa = __expf(gc + m - mn), bb = __expf(mc - mn);
                    float lc[8]; unpack8(ld[j], lc);
                    *(u32x4*)(Cst + ((size_t)(bh * 32 + c) * 65536 + e8 * 8)) = pack8(st);
#pragma unroll
                    for (int e = 0; e < 8; ++e) st[e] = aa * st[e] + bb * lc[e];
                    if (e8 == 0) mprev[bh * 32 + c] = m;
                    m = mn; }
            }
        } else {
            const int j = i - NBH * 8192, bh = j >> 8, k = j & 255;
            float st = 0.f, m = -1e30f;
            for (int c = 0; c < 32; ++c) { const float gc = gch[bh * 32 + c], mc = mloc[bh * 32 + c];
                const float mn = fmaxf(gc + m, mc), aa = __expf(gc + m - mn), bb = __expf(mc - mn);
                const size_t o = (size_t)(bh * 32 + c) * 256 + k; const float lc = nst[o]; nst[o] = st; st = aa * st + bb * lc; m = mn; }
        }
    }
}

__device__ __forceinline__ void m3_item(LAS char* lds, bf16_t* proj, const float* gif, const bf16_t* Cst, const float* nst, const float* mprev, const float* convw, int bhl, int c) {
    const int tid = my_tid(), lane = tid & 63, wid = __builtin_amdgcn_readfirstlane(tid >> 6), g = lane >> 4, fr = lane & 15;
    const int bl = bhl >> 2, h = bhl & 3, item = bhl * 32 + c, t0 = bl * SEQ + c * 128;
    LAS char* X = lds + XOFF; LAS char* Y = lds + YOFF; LAS float* vec = (LAS float*)(lds + VECOFF);
    LAS float* li = vec; LAS float* bc = vec + 128; LAS float* npv = vec + 272;
    load_gates(vec, gif, t0, h, tid);
    if (tid < 256) npv[tid] = nst[(size_t)item * 256 + tid];
    load_conv(X, proj + SEC(C_MQ) + (size_t)t0 * PP + h * 256, c * 128, convw + h * 256, nullptr, 0.0625f, tid);
    load_conv(Y, proj + SEC(C_MK) + (size_t)t0 * PP + h * 256, c * 128, convw + 1024 + h * 256, nullptr, 1.0f, tid);
    __syncthreads();
    const int j0 = 16 * wid, jj = j0 + fr;
    bf16x8 pf[4]; float den, inter, mt;
    u32x4 pre[8];
    load_plain_issue(pre, Cst + (size_t)item * 65536, 256, tid);
    {
        f32x4 S[8];
#pragma unroll
        for (int sb = 0; sb < 8; ++sb) S[sb] = (f32x4){0.f, 0.f, 0.f, 0.f};
#pragma unroll 1
        for (int t = 0; t < 8; ++t) { const bf16x8 qb = rowfrag(X, PIT, j0, 32 * t, lane);
            bf16x8 kf[8];
#pragma unroll
            for (int sb = 0; sb < 8; ++sb) kf[sb] = rowfrag(Y, PIT, 16 * sb, 32 * t, lane);
            __builtin_amdgcn_sched_barrier(0);
#pragma unroll
            for (int sb = 0; sb < 8; ++sb) S[sb] = mfma16(kf[sb], qb, S[sb]); }
        float qn = 0.f;
        { const LAS char* qr = X + jj * PIT + (64 * g) * 2;
#pragma unroll 2
            for (int i = 0; i < 8; ++i) { const u32x4 v = *(const LAS u32x4*)(qr + 16 * i); float f[8]; unpack8(v, f);
                const f32x4 n0 = *(const LAS f32x4*)(npv + 64 * g + 8 * i), n1 = *(const LAS f32x4*)(npv + 64 * g + 8 * i + 4);
                qn += (f[0] * n0.x + f[1] * n0.y) + (f[2] * n0.z + f[3] * n0.w) + (f[4] * n1.x + f[5] * n1.y) + (f[6] * n1.z + f[7] * n1.w); } }
        qn += __shfl_xor(qn, 16); qn += __shfl_xor(qn, 32);
        const float bj = bc[jj], mp = mprev[item];
        float rmax = -INFINITY;
#pragma unroll
        for (int sb = 0; sb < 8; ++sb) { const f32x4 b4 = *(const LAS f32x4*)(bc + 16 * sb + 4 * g), l4 = *(const LAS f32x4*)(li + 16 * sb + 4 * g);
#pragma unroll
            for (int r = 0; r < 4; ++r) { const int s = 16 * sb + 4 * g + r; const float dm = (s <= jj) ? (bj - b4[r] + l4[r]) : -INFINITY; rmax = fmaxf(rmax, dm); } }
        rmax = fmaxf(rmax, __shfl_xor(rmax, 16)); rmax = fmaxf(rmax, __shfl_xor(rmax, 32));
        const float minter = bj + mp; mt = fmaxf(minter, rmax); inter = __expf(minter - mt);
        den = 0.f;
#pragma unroll
        for (int sb = 0; sb < 8; ++sb) { const f32x4 b4 = *(const LAS f32x4*)(bc + 16 * sb + 4 * g), l4 = *(const LAS f32x4*)(li + 16 * sb + 4 * g);
#pragma unroll
            for (int r = 0; r < 4; ++r) { const int s = 16 * sb + 4 * g + r; const float p = (s <= jj) ? __expf(bj - b4[r] + l4[r] - mt) : 0.f; const float v = S[sb][r] * p; S[sb][r] = v; den += v; } }
        den += __shfl_xor(den, 16); den += __shfl_xor(den, 32);
        den += inter * qn;
#pragma unroll
        for (int t = 0; t < 4; ++t) { u32x4 w; w.x = cvt_pk_bf16(S[2 * t][0], S[2 * t][1]); w.y = cvt_pk_bf16(S[2 * t][2], S[2 * t][3]); w.z = cvt_pk_bf16(S[2 * t + 1][0], S[2 * t + 1][1]); w.w = cvt_pk_bf16(S[2 * t + 1][2], S[2 * t + 1][3]); pf[t] = __builtin_bit_cast(bf16x8, w); }
    }
    f32x4 acc[16];
#pragma unroll
    for (int j = 0; j < 16; ++j) acc[j] = (f32x4){0.f, 0.f, 0.f, 0.f};
#pragma unroll 1
    for (int half = 0; half < 2; ++half) {
        __syncthreads();
        load_plain_commit(Y, pre, tid);
        if (half == 0) load_plain_issue(pre, Cst + (size_t)item * 65536 + 32768, 256, tid);
        else load_plain_issue(pre, proj + SEC(C_MV) + (size_t)t0 * PP + h * 256, PP, tid);
        __syncthreads();
#pragma unroll 1
        for (int t = 0; t < 4; ++t) { const bf16x8 qb = rowfrag_perm(X, PIT, j0, half * 128 + 32 * t, lane);
#pragma unroll
            for (int hb = 0; hb < 2; ++hb) {
                bf16x8 cf[8];
#pragma unroll
                for (int nb = 0; nb < 8; ++nb) cf[nb] = trfrag(Y, PIT, 32 * t, 16 * (8 * hb + nb), lane);
                __builtin_amdgcn_sched_barrier(0);
#pragma unroll
                for (int nb = 0; nb < 8; ++nb) acc[8 * hb + nb] = mfma16(cf[nb], qb, acc[8 * hb + nb]); } }
    }
#pragma unroll
    for (int nb = 0; nb < 16; ++nb) acc[nb] = acc[nb] * inter;
    __syncthreads();
    load_plain_commit(X, pre, tid);
    __syncthreads();
#pragma unroll
    for (int t = 0; t < 4; ++t) if (2 * t <= wid) {
        bf16x8 vf[16];
#pragma unroll
        for (int nb = 0; nb < 16; ++nb) vf[nb] = trfrag(X, PIT, 32 * t, 16 * nb, lane);
        __builtin_amdgcn_sched_barrier(0);
#pragma unroll
        for (int nb = 0; nb < 16; ++nb) acc[nb] = mfma16(vf[nb], pf[t], acc[nb]); }
    const float rdn = 1.0f / fmaxf(fabsf(den), __expf(-mt));
    bf16_t* op = proj + SEC(C_MO) + (size_t)(t0 + jj) * PP + h * 256 + 4 * g;
    u32x2 sgv[16];
#pragma unroll
    for (int nb = 0; nb < 16; ++nb) sgv[nb] = *(const u32x2*)(op + 16 * nb);
#pragma unroll
    for (int nb = 0; nb < 16; ++nb) { const u32x2 sg = sgv[nb];
        u32x2 w; w.x = cvt_pk_bf16(acc[nb][0] * rdn * bflo(sg.x), acc[nb][1] * rdn * bfhi(sg.x)); w.y = cvt_pk_bf16(acc[nb][2] * rdn * bflo(sg.y), acc[nb][3] * rdn * bfhi(sg.y));
        *(u32x2*)(op + 16 * nb) = w; }
    __syncthreads();
}

__device__ __forceinline__ void phase_qkprep(bf16_t* proj, const float* gqk  , const float2* rope) {
    const int tid = my_tid(), lane = tid & 63, wave = tid >> 6;
    const int gw = blockIdx.x * 8 + wave, NGW = gridDim.x * 8;
    const int grp = lane >> 2, u = lane & 3;
    for (int it = gw; it < TG * 2; it += NGW) {
        const int row = it >> 1, which = it & 1, pos = row & (SEQ - 1);
        bf16_t* p = proj + (which ? SEC(C_AK) : SEC(C_AQ)) + (size_t)row * PP + grp * 64 + 8 * u;
        const u32x4 a = *(const u32x4*)p, b = *(const u32x4*)(p + 32);
        float x1[8], x2[8]; unpack8(a, x1); unpack8(b, x2);
        float ss = 0.f;
#pragma unroll
        for (int e = 0; e < 8; ++e) ss += x1[e] * x1[e] + x2[e] * x2[e];
        ss += __shfl_xor(ss, 1); ss += __shfl_xor(ss, 2);
        const float rstd = 1.0f / sqrtf(ss * (1.0f / 64.0f) + 1e-6f) * (which ? 1.0f : 0.125f * 1.4426950408889634f);
        const float* gq = gqk + which * 64 + 8 * u;
        const float2* cs = rope + (size_t)pos * 32 + 8 * u;
        float o1[8], o2[8];
#pragma unroll
        for (int e = 0; e < 8; ++e) { const float y1 = x1[e] * rstd * gq[e], y2 = x2[e] * rstd * gq[32 + e]; const float2 t = cs[e]; o1[e] = y1 * t.x - y2 * t.y; o2[e] = y2 * t.x + y1 * t.y; }
        *(u32x4*)p = pack8(o1); *(u32x4*)(p + 32) = pack8(o2);
    }
}
__device__ __forceinline__ void phase_pool(const bf16_t* proj, bf16_t* pooled) {
    const int tid = my_tid();
    for (int idx = blockIdx.x * NTHR + tid; idx < (TG / 16) * 128; idx += gridDim.x * NTHR) {
        const int cgi = idx & 127, seg = idx >> 7, r0 = seg * 16, pos0 = r0 & (SEQ - 1), w = 2 << (cgi >> 5);
        const bf16_t* src = proj + SEC(C_PU) + (size_t)r0 * PP + cgi * 8;
        float sum[8];
#pragma unroll
        for (int e = 0; e < 8; ++e) sum[e] = 0.f;
        if (pos0 > 0) for (int j = 1; j < w; ++j) { float f[8]; unpack8(*(const u32x4*)(src - (ptrdiff_t)j * PP), f);
#pragma unroll
            for (int e = 0; e < 8; ++e) sum[e] += f[e]; }
        for (int r = 0; r < 16; ++r) {
            float f[8]; unpack8(*(const u32x4*)(src + (ptrdiff_t)r * PP), f);
            const int pos = pos0 + r;
            if (r >= 1 && pos - w >= 0) { float o[8]; unpack8(*(const u32x4*)(src + (ptrdiff_t)(r - w) * PP), o);
#pragma unroll
                for (int e = 0; e < 8; ++e) sum[e] -= o[e]; }
            const float rc = 1.0f / (float)(pos + 1 < w ? pos + 1 : w);
            float out[8];
#pragma unroll
            for (int e = 0; e < 8; ++e) { sum[e] += f[e]; out[e] = sum[e] * rc - f[e]; }
            *(u32x4*)(pooled + (size_t)(r0 + r) * DM + cgi * 8) = pack8(out);
        }
    }
}

constexpr int APIT = 288, ATILE = 64 * APIT, ABUF = 2 * ATILE;
__device__ __forceinline__ void attn_qkexp(const LAS char* Kb, int k0, int q0, int wid, int lane, int g, int qpos, const bf16x8 (&qf)[2][2], const f32x4 negM, bf16x8 (&pf)[2][2]) {
    f32x4 s[2][4];
    {
        bf16x8 kf[2][4][2];
#pragma unroll
        for (int c = 0; c < 2; ++c)
#pragma unroll
            for (int kb = 0; kb < 4; ++kb)
#pragma unroll
                for (int ks = 0; ks < 2; ++ks) kf[c][kb][ks] = rowfrag(Kb, APIT, 16 * kb, c * 64 + 32 * ks, lane);
        __builtin_amdgcn_sched_barrier(0);
#pragma unroll
        for (int c = 0; c < 2; ++c)
#pragma unroll
            for (int kb = 0; kb < 4; ++kb) s[c][kb] = mfma16(kf[c][kb][0], qf[c][0], negM);
#pragma unroll
        for (int c = 0; c < 2; ++c)
#pragma unroll
            for (int kb = 0; kb < 4; ++kb) s[c][kb] = mfma16(kf[c][kb][1], qf[c][1], s[c][kb]);
    }
    if (k0 + 63 > q0 + 16 * wid) {
#pragma unroll
        for (int c = 0; c < 2; ++c)
#pragma unroll
            for (int kb = 0; kb < 4; ++kb)
#pragma unroll
                for (int r = 0; r < 4; ++r) if (k0 + 16 * kb + 4 * g + r > qpos) s[c][kb][r] = -INFINITY;
    }
#pragma unroll
    for (int c = 0; c < 2; ++c) {
#pragma unroll
        for (int kb = 0; kb < 4; ++kb)
#pragma unroll
            for (int r = 0; r < 4; ++r) s[c][kb][r] = __builtin_amdgcn_exp2f(s[c][kb][r]);
#pragma unroll
        for (int tt = 0; tt < 2; ++tt) { u32x4 w; w.x = cvt_pk_bf16(s[c][2 * tt][0], s[c][2 * tt][1]); w.y = cvt_pk_bf16(s[c][2 * tt][2], s[c][2 * tt][3]);
            w.z = cvt_pk_bf16(s[c][2 * tt + 1][0], s[c][2 * tt + 1][1]); w.w = cvt_pk_bf16(s[c][2 * tt + 1][2], s[c][2 * tt + 1][3]); pf[c][tt] = __builtin_bit_cast(bf16x8, w); }
    }
}
__device__ __forceinline__ void attn_pv(const LAS char* Vb, int lane, const bf16x8 (&pf)[2][2], const bf16x8 onesf, f32x4 (&O)[2][8], f32x4 (&Oe)[2]) {
    bf16x8 va[8], vb[8];
#pragma unroll
    for (int nb = 0; nb < 8; ++nb) va[nb] = trfrag(Vb, APIT, 0, 16 * nb, lane);
#pragma unroll
    for (int nb = 0; nb < 8; ++nb) vb[nb] = trfrag(Vb, APIT, 32, 16 * nb, lane);
    __builtin_amdgcn_sched_barrier(0);
    Oe[0] = mfma16(onesf, pf[0][0], Oe[0]); Oe[1] = mfma16(onesf, pf[1][0], Oe[1]);
#pragma unroll
    for (int nb = 0; nb < 8; ++nb) { O[0][nb] = mfma16(va[nb], pf[0][0], O[0][nb]); O[1][nb] = mfma16(va[nb], pf[1][0], O[1][nb]); }
    Oe[0] = mfma16(onesf, pf[0][1], Oe[0]); Oe[1] = mfma16(onesf, pf[1][1], Oe[1]);
#pragma unroll
    for (int nb = 0; nb < 8; ++nb) { O[0][nb] = mfma16(vb[nb], pf[0][1], O[0][nb]); O[1][nb] = mfma16(vb[nb], pf[1][1], O[1][nb]); }
}
__device__ __forceinline__ void attn_step_fast(const LAS char* Kb, const LAS char* Vb, int lane, const bf16x8 (&qf)[2][2], const f32x4 negM, const bf16x8 onesf, f32x4 (&O)[2][8], f32x4 (&Oe)[2]) {
    f32x4 s0[4], s1[4];
    bf16x8 p0[2], p1[2];
    {
        bf16x8 kf[2][4][2];
#pragma unroll
        for (int c = 0; c < 2; ++c)
#pragma unroll
            for (int kb = 0; kb < 4; ++kb)
#pragma unroll
                for (int ks = 0; ks < 2; ++ks) kf[c][kb][ks] = rowfrag(Kb, APIT, 16 * kb, c * 64 + 32 * ks, lane);
        __builtin_amdgcn_sched_barrier(0);
#pragma unroll
        for (int kb = 0; kb < 4; ++kb) s0[kb] = mfma16(kf[0][kb][0], qf[0][0], negM);
#pragma unroll
        for (int kb = 0; kb < 4; ++kb) s0[kb] = mfma16(kf[0][kb][1], qf[0][1], s0[kb]);
        __builtin_amdgcn_sched_barrier(0);
#pragma unroll
        for (int kb = 0; kb < 4; ++kb) s1[kb] = mfma16(kf[1][kb][0], qf[1][0], negM);
#pragma unroll
        for (int kb = 0; kb < 4; ++kb) s1[kb] = mfma16(kf[1][kb][1], qf[1][1], s1[kb]);
    }
#define ATT_EXPPACK(S, P) do { \
        _Pragma("unroll") for (int kb = 0; kb < 4; ++kb) _Pragma("unroll") for (int r = 0; r < 4; ++r) S[kb][r] = __builtin_amdgcn_exp2f(S[kb][r]); \
        _Pragma("unroll") for (int tt = 0; tt < 2; ++tt) { u32x4 w; w.x = cvt_pk_bf16(S[2 * tt][0], S[2 * tt][1]); w.y = cvt_pk_bf16(S[2 * tt][2], S[2 * tt][3]); \
            w.z = cvt_pk_bf16(S[2 * tt + 1][0], S[2 * tt + 1][1]); w.w = cvt_pk_bf16(S[2 * tt + 1][2], S[2 * tt + 1][3]); P[tt] = __builtin_bit_cast(bf16x8, w); } } while (0)
    ATT_EXPPACK(s0, p0);
#pragma unroll
    for (int i = 0; i < 8; ++i) { __builtin_amdgcn_sched_group_barrier(0x008, 1, 0); __builtin_amdgcn_sched_group_barrier(0x002, 3, 0); }
    __builtin_amdgcn_sched_barrier(0);
    bf16x8 va[8], vb[8];
#pragma unroll
    for (int nb = 0; nb < 8; ++nb) va[nb] = trfrag(Vb, APIT, 0, 16 * nb, lane);
#pragma unroll
    for (int nb = 0; nb < 8; ++nb) vb[nb] = trfrag(Vb, APIT, 32, 16 * nb, lane);
    __builtin_amdgcn_sched_barrier(0);
    Oe[0] = mfma16(onesf, p0[0], Oe[0]);
#pragma unroll
    for (int nb = 0; nb < 8; ++nb) O[0][nb] = mfma16(va[nb], p0[0], O[0][nb]);
    Oe[0] = mfma16(onesf, p0[1], Oe[0]);
#pragma unroll
    for (int nb = 0; nb < 8; ++nb) O[0][nb] = mfma16(vb[nb], p0[1], O[0][nb]);
    ATT_EXPPACK(s1, p1);
#pragma unroll
    for (int i = 0; i < 18; ++i) { __builtin_amdgcn_sched_group_barrier(0x008, 1, 0); __builtin_amdgcn_sched_group_barrier(0x002, 2, 0); }
    __builtin_amdgcn_sched_barrier(0);
    Oe[1] = mfma16(onesf, p1[0], Oe[1]);
#pragma unroll
    for (int nb = 0; nb < 8; ++nb) O[1][nb] = mfma16(va[nb], p1[0], O[1][nb]);
    Oe[1] = mfma16(onesf, p1[1], Oe[1]);
#pragma unroll
    for (int nb = 0; nb < 8; ++nb) O[1][nb] = mfma16(vb[nb], p1[1], O[1][nb]);
#undef ATT_EXPPACK
}
__device__ __forceinline__ void attn_item(LAS char* lds, bf16_t* proj, int bl, int h, int qb, float lam, float oscale, const float* gdh, float smax) {
    const int tid = my_tid(), lane = tid & 63, wid = __builtin_amdgcn_readfirstlane(tid >> 6), g = lane >> 4, fr = lane & 15;
    const size_t rowbase = (size_t)bl * SEQ; const int q0 = qb * 128, qpos = q0 + 16 * wid + fr;
    bf16_t* qp = proj + SEC(C_AQ) + (rowbase + qpos) * PP + h * 128;
    bf16x8 qf[2][2];
#pragma unroll
    for (int c = 0; c < 2; ++c)
#pragma unroll
        for (int ks = 0; ks < 2; ++ks) qf[c][ks] = *(const bf16x8*)(qp + c * 64 + 32 * ks + 8 * g);
    f32x4 O[2][8], Oe[2];
#pragma unroll
    for (int c = 0; c < 2; ++c) { Oe[c] = (f32x4){0.f, 0.f, 0.f, 0.f};
#pragma unroll
        for (int nb = 0; nb < 8; ++nb) O[c][nb] = (f32x4){0.f, 0.f, 0.f, 0.f}; }
    const f32x4 negM = (f32x4){-smax, -smax, -smax, -smax};
    const short one16 = (fr == 0) ? (short)0x3F80 : (short)0;
    const bf16x8 onesf = (bf16x8){one16, one16, one16, one16, one16, one16, one16, one16};
    const int NT = 2 * (qb + 1);
    const int sr0 = tid >> 4, sc = tid & 15;
    const bf16_t* kg = proj + SEC(C_AK) + (rowbase + sr0) * PP + h * 128 + sc * 8;
    const bf16_t* vg = proj + SEC(C_AV) + (rowbase + sr0) * PP + h * 128 + sc * 8;
    const int soff = sr0 * APIT + sc * 16;
    u32x4 kr[2], vr[2];
#define ATT_LOAD(tile) do { _Pragma("unroll") for (int i = 0; i < 2; ++i) { kr[i] = *(const u32x4*)(kg + (size_t)(64 * (tile) + 32 * i) * PP); vr[i] = *(const u32x4*)(vg + (size_t)(64 * (tile) + 32 * i) * PP); } } while (0)
#define ATT_STORE(buf) do { LAS char* nb_ = lds + (buf) * ABUF; _Pragma("unroll") for (int i = 0; i < 2; ++i) { *(LAS u32x4*)(nb_ + soff + 32 * i * APIT) = kr[i]; *(LAS u32x4*)(nb_ + ATILE + soff + 32 * i * APIT) = vr[i]; } } while (0)
    ATT_LOAD(0); ATT_STORE(0);
    __syncthreads();
    const int qmaxw = q0 + 16 * wid + 15;
    int t = 0;
    for (; t < NT - 2; ++t) {
        ATT_LOAD(t + 1);
        const LAS char* Kb = lds + (t & 1) * ABUF;
#if ATT_FAST
        attn_step_fast(Kb, Kb + ATILE, lane, qf, negM, onesf, O, Oe);
#else
        { bf16x8 pq[2][2]; attn_qkexp(Kb, 64 * t, q0, wid, lane, g, qpos, qf, negM, pq); attn_pv(Kb + ATILE, lane, pq, onesf, O, Oe); }
#endif
        ATT_STORE((t + 1) & 1);
        BAR_LDS();
    }
    bf16x8 pf[2][2];
    for (; t < NT; ++t) {
        const int k0 = 64 * t;
        if (t + 1 < NT) ATT_LOAD(t + 1);
        if (k0 <= qmaxw) {
            const LAS char* Kb = lds + (t & 1) * ABUF;
            attn_qkexp(Kb, k0, q0, wid, lane, g, qpos, qf, negM, pf);
            attn_pv(Kb + ATILE, lane, pf, onesf, O, Oe);
        }
        if (t + 1 < NT) ATT_STORE((t + 1) & 1);
        BAR_LDS();
    }
#undef ATT_LOAD
#undef ATT_STORE
    const float l0 = __shfl(Oe[0][0], fr), l1 = __shfl(Oe[1][0], fr);
    const float r0 = 1.0f / l0, r1 = lam / l1;
    float ss = 0.f;
#pragma unroll
    for (int nb = 0; nb < 8; ++nb)
#pragma unroll
        for (int r = 0; r < 4; ++r) { const float o = O[0][nb][r] * r0 - O[1][nb][r] * r1; O[0][nb][r] = o; ss += o * o; }
    ss += __shfl_xor(ss, 16); ss += __shfl_xor(ss, 32);
    const float rstd = 1.0f / sqrtf(ss * (1.0f / 128.0f) + 1e-6f) * oscale;
    f32x4 ggv[8];
#pragma unroll
    for (int nb = 0; nb < 8; ++nb) ggv[nb] = *(const f32x4*)(gdh + 16 * nb + 4 * g);
#pragma unroll
    for (int nb = 0; nb < 8; ++nb) { const f32x4 gg = ggv[nb];
        u32x2 w; w.x = cvt_pk_bf16(O[0][nb][0] * rstd * gg.x, O[0][nb][1] * rstd * gg.y); w.y = cvt_pk_bf16(O[0][nb][2] * rstd * gg.z, O[0][nb][3] * rstd * gg.w);
        *(u32x2*)(qp + ((ptrdiff_t)SEC(C_PU) - (ptrdiff_t)SEC(C_AQ)) + 16 * nb + 4 * g) = w; }
}

#ifndef PH_ONLY
#define PH_ONLY -1
#endif
#define PHO(n) (PH_ONLY < 0 || PH_ONLY == (n))
#ifndef PROJ_ALIGN
#define PROJ_ALIGN true
#endif
#ifndef ATT_FAST
#define ATT_FAST 1
#endif
#ifndef DUP_K
#define DUP_K -1
#endif
__global__ void __launch_bounds__(NTHR, 2) fwd_kernel(Args a) {
    extern __shared__ __attribute__((aligned(16))) unsigned char lds_raw[];
    LAS unsigned char* lds = (LAS unsigned char*)lds_raw;
    cg::grid_group grid = cg::this_grid();
    unsigned char* ws = a.ws;
    bf16_t* proj = (bf16_t*)(ws + WS_PROJ);
    bf16_t* hn = (bf16_t*)(ws + WS_HN);
    bf16_t* Cst = (bf16_t*)(ws + WS_CST);
    float* gif = (float*)(ws + WS_GIF);
    float* gch = (float*)(ws + WS_MV); float* mloc = gch + 512; float* mprev = gch + 1024;
    float* nst = (float*)(ws + WS_NST);
    const int G = gridDim.x, bx = blockIdx.x;
    unsigned* barw = (unsigned*)ws;
    volatile LAS unsigned* bst = (volatile LAS unsigned*)(lds + LDS_BYTES - 64);
    if (threadIdx.x < 2) bst[threadIdx.x] = 0u;
    if (bx == 0) for (int i = threadIdx.x; i < XCD_BAR_WORDS; i += NTHR) barw[i] = 0u;
    __syncthreads();
    XcdBarrier xb; xb.bar = barw; xb.x = 0; xb.st = bst;
    bool xb_ready = false;
    for (int ph = a.ph_lo; ph < a.ph_hi; ++ph) {
        const int l = ph / 18, idx = ph % 18;
        const float* xsrc = (l == 0) ? a.in[0] : a.out;
        if (PHO(0) && idx == 0) {
            phase_weights(a, l, lds);
        } else if (idx <= 14) {
            const int grp = (idx - 1) / 7, k = (idx - 1) % 7;
            const size_t rowoff = (size_t)grp * TG;
            if (PHO(1) && k == 0) {
                for (int rep = 0; rep < (DUP_K == 0 ? 2 : 1); ++rep)
                phase_norm<true>(xsrc + rowoff * DM, a.in[1] + l * DM, hn, TG, a.in[2] + (size_t)l * DM * NIN, a.in[3] + l * 8, gif, lds);
            } else if (PHO(2) && k == 1) {
                pg8::Gemm gm{hn, (const bf16_t*)(ws + WS_WIN), TG, NP, DM, 64, 0, (size_t)TG * 64 * 2}; pg8::StaticOrder S; S.init(TG, NP, G, bx);
                pg8::EpiProj E{proj, PP, (size_t)TG * 1024};
                for (int rep = 0; rep < (DUP_K == 1 ? 2 : 1); ++rep)
                pg8::gemm_phase<pg8::EpiProj, pg8::StaticOrder, PROJ_ALIGN, true>(lds, gm, S, E);
            } else if (PHO(3) && k == 2) {
                const float* convw = a.in[4] + (size_t)l * 4 * 2048;
                for (int rep = 0; rep < (DUP_K == 2 ? 2 : 1); ++rep)
                m1_phase((LAS char*)lds, proj, gif, Cst, nst, gch, mloc, convw, bx, G);
                phase_qkprep(proj, a.in[8] + l * 128, (const float2*)(ws + WS_ROPE));
                phase_pool(proj, hn);
            } else if (PHO(4) && k == 3) {
                phase_scan(Cst, nst, gch, mloc, mprev);
                const float* lp = a.in[9] + l * 256;
                float s01 = 0.f, s23 = 0.f;
                for (int i = 0; i < 64; ++i) { s01 += lp[i] * lp[64 + i]; s23 += lp[128 + i] * lp[192 + i]; }
                float mgq = 0.f, mgk = 0.f; { const float* gq = a.in[8] + l * 128; for (int i = 0; i < 64; ++i) { mgq = fmaxf(mgq, fabsf(gq[i])); mgk = fmaxf(mgk, fabsf(gq[64 + i])); } }
                const float smax = 64.0f * mgq * mgk * (0.125f * 1.4426950408889634f) * 1.01f + 0.25f;
                const float lam_init = 0.8f - 0.6f * expf(-0.3f * (float)l);
                const float lam = expf(s01) - expf(s23) + lam_init;
                for (int rep = 0; rep < (DUP_K == 3 ? 2 : 1); ++rep)
                for (int i = bx; i < GB * 8 * 32; i += G) {
                    const int r = i >> 8, j = i & 255, x = j & 7, y = j >> 3, bh = x + 8 * r, qb = (r & 1) ? 31 - y : y;
                    attn_item((LAS char*)lds, proj, bh >> 3, bh & 7, qb, lam, 1.0f - lam_init, a.in[10] + l * 128, smax);
                }
            } else if (PHO(5) && k == 4) {
                const float* convw = a.in[4] + (size_t)l * 4 * 2048;
                for (int it = bx; it < NBH * 32; it += G) m3_item((LAS char*)lds, proj, gif, Cst, nst, mprev, convw, it >> 5, it & 31);
            } else if (PHO(6) && k == 5) {
#pragma unroll 1
                for (int brr = 0; brr < (DUP_K == 5 ? 6 : 3); ++brr) { const int br = brr % 3;
                    pg8::Gemm gm; gm.M = TG; gm.N = DM;
                    if (br == 0) { gm.A = proj + SEC(C_MO); gm.Bt = (const bf16_t*)(ws + WS_WMO); gm.K = DM; gm.lda = PP; gm.a_pn_off = 0; }
                    else if (br == 1) { gm.A = hn; gm.Bt = (const bf16_t*)(ws + WS_WPOOL); gm.K = 256; gm.lda = DM; gm.a_pn_off = 256; }
                    else { gm.A = proj + SEC(C_PU); gm.Bt = (const bf16_t*)(ws + WS_WDIFF); gm.K = DM; gm.lda = PP; gm.a_pn_off = 0; }
                    pg8::StaticOrder S; S.init(TG, DM, G, bx);
                    pg8::EpiMerge E{proj + SEC(C_MQ), proj + SEC(C_GT) + (size_t)br * ((size_t)TG * 1024), PP, br == 0 ? 1 : 0};
                    pg8::gemm_phase<pg8::EpiMerge, pg8::StaticOrder, true, true>(lds, gm, S, E);
                }
            } else if (PHO(7)) {
                pg8::Gemm gm{proj + SEC(C_MQ), (const bf16_t*)(ws + WS_WOUT), TG, DM, DM, PP, 0}; pg8::StaticOrder S; S.init(TG, DM, G, bx);
                pg8::EpiResid E{xsrc + rowoff * DM, a.out + rowoff * DM, DM};
                pg8::gemm_phase<pg8::EpiResid, pg8::StaticOrder, true, true>(lds, gm, S, E);
            }
        } else if (PHO(8) && idx == 15) {
            phase_norm<false>(a.out, a.in[13] + l * DM, hn, TT, nullptr, nullptr, nullptr, lds);
        } else if (PHO(9) && idx == 16) {
            pg8::Gemm gm{hn, (const bf16_t*)(ws + WS_WGU), TT, 2 * FF, DM, 64, 0, (size_t)TT * 64 * 2}; pg8::StaticOrder S; S.init(TT, 2 * FF, G, bx);
            pg8::EpiSwiGLU E{proj, (size_t)TT * 64};
            for (int rep = 0; rep < (DUP_K == 16 ? 2 : 1); ++rep)
            pg8::gemm_phase<pg8::EpiSwiGLU, pg8::StaticOrder, true, true>(lds, gm, S, E);
        } else if (PHO(10)) {
            pg8::Gemm gm{proj, (const bf16_t*)(ws + WS_WDN), TT, DM, FF, 64, 0, (size_t)TT * 64 * 2};   pg8::StaticOrder S; S.init(TT, DM, G, bx);
            pg8::EpiResid E{a.out, a.out, DM};
            pg8::gemm_phase<pg8::EpiResid, pg8::StaticOrder, true, true>(lds, gm, S, E);
        }
        if (ph + 1 < a.ph_hi) {
            if (!xb_ready) { grid.sync(); xb = xcd_barrier_post(barw, bst); xb_ready = true; }
            else { xcd_barrier(xb); if (DUP_K == 100) { xcd_barrier(xb); xcd_barrier(xb); } }
        }
    }
}

extern "C" void kernel_launch(void* const* d_in, const int* in_sizes, int n_in, void* d_out, int out_size, void* d_ws, size_t ws_size, hipStream_t stream) {
    static int grid = 0;
    if (grid == 0) {
        if (n_in != 16 || out_size != TT * DM || ws_size < WS_END) { fprintf(stderr, "kernel_launch: unexpected shapes / workspace (%d inputs, out %d, ws %zu)\n", n_in, out_size, ws_size); grid = -1; return; }
        int dev = 0, cus = 0, per_cu = 0;
        hipGetDevice(&dev); hipDeviceGetAttribute(&cus, hipDeviceAttributeMultiprocessorCount, dev);
        hipFuncSetAttribute((const void*)fwd_kernel, hipFuncAttributeMaxDynamicSharedMemorySize, LDS_BYTES);
        hipOccupancyMaxActiveBlocksPerMultiprocessor(&per_cu, (const void*)fwd_kernel, NTHR, LDS_BYTES);
        (void)hipGetLastError();
        if (per_cu < 1) per_cu = 1;
        grid = cus * 1;
        if (grid <= 0) grid = 256;
    }
    if (grid < 0) return;
    Args a{};
    for (int i = 0; i < 16; ++i) a.in[i] = (const float*)d_in[i];
    a.out = (float*)d_out; a.ws = (unsigned char*)d_ws; a.ph_lo = 0; a.ph_hi = 36;
    void* args[] = {&a};
    hipError_t e = hipLaunchCooperativeKernel((const void*)fwd_kernel, dim3(grid), dim3(NTHR), args, LDS_BYTES, stream);
    if (e != hipSuccess) fprintf(stderr, "cooperative launch failed: %s (grid %d)\n", hipGetErrorString(e), grid);
}
```

```cpp
#include <hip/hip_runtime.h>
#include <hip/hip_cooperative_groups.h>
#include <cstdio>
#include <cstdint>
namespace cg = cooperative_groups;
namespace pg8 {
#define PG8_LAS __attribute__((address_space(3)))
typedef unsigned short bf16_t;
typedef short bf16x8 __attribute__((ext_vector_type(8)));
typedef float f32x4 __attribute__((ext_vector_type(4)));
typedef unsigned u32x4 __attribute__((ext_vector_type(4)));
constexpr int BM = 256, BK = 64, HALF = 128, HTB = HALF * BK * 2  , STAGE_BYTES = 8 * HTB, NXCD = 8, WGM = 8;

__host__ __device__ __forceinline__ int lds_byte(int r, int c) { const int st = (r >> 4) * 2 + (c >> 5), rr = r & 15, cc = c & 31, ob = rr * 64 + cc * 2; return st * 1024 + (ob ^ (((ob >> 9) & 1) << 5)); }
__host__ __device__ __forceinline__ void stage_rc(int b, int& R, int& C) { const int st = b / 1024, sb = b % 1024, swz = sb ^ (((sb >> 9) & 1) << 5); R = (st >> 1) * 16 + swz / 64; C = (st & 1) * 32 + (swz % 64) / 2; }
__host__ __device__ __forceinline__ int perm32(int rho) { const int n = rho >> 4, i = rho & 15; return 8 * (i >> 2) + 4 * n + (i & 3); }

struct Unit { int pm, pn; };
struct Gemm { const bf16_t* A; const bf16_t* Bt; int M, N, K, lda, a_pn_off; size_t a_kstep = 0; };

struct StaticOrder {
    int nM, nN, nwg, G, c;
    __host__ __device__ void init(int M, int N, int G_, int c_) { nM = M / BM; nN = N / BM; nwg = nM * nN; G = G_; c = c_; }
    __host__ __device__ bool next(int i, Unit& u) const {
        const long L = (long)i * G + c; if (L >= nwg) return false;
        int wgid = (int)L; { const int q = nwg / NXCD, r = nwg % NXCD, xcd = wgid % NXCD, off = wgid / NXCD; wgid = (xcd < r ? xcd * (q + 1) : r * (q + 1) + (xcd - r) * q) + off; }
        const int nig = WGM * nN, gid = wgid / nig, fm = gid * WGM, gsz = (nM - fm) < WGM ? (nM - fm) : WGM;
        u.pm = fm + ((wgid % nig) % gsz); u.pn = (wgid % nig) / gsz; return true;
    }
    __device__ __forceinline__ void a_ready(const Unit&) const {}
    __device__ __forceinline__ void done(const Unit&) const {}
};

typedef float f32x2_t __attribute__((ext_vector_type(2))); typedef __bf16 bf16x2_t __attribute__((ext_vector_type(2)));
__device__ __forceinline__ unsigned cvt_pk_bf16(float lo, float hi) { const f32x2_t v = {lo, hi}; const bf16x2_t b = __builtin_convertvector(v, bf16x2_t); return __builtin_bit_cast(unsigned, b); }
__device__ __forceinline__ float fsigmoid(float x) { return __builtin_amdgcn_rcpf(1.0f + __expf(-x)); }
__device__ __forceinline__ float bflo(unsigned u) { return __uint_as_float(u << 16); }
__device__ __forceinline__ float bfhi(unsigned u) { return __uint_as_float(u & 0xffff0000u); }

struct EpiProj {
    static constexpr bool PERM = true, AFTER_DRAIN = false;
    bf16_t* O; int ldc; size_t sec_stride;
    __device__ __forceinline__ void operator()(const f32x4 (&acc)[2][2][4][2], const Unit& u, int wr, int wc, int fr, int fq) const {
        const bool sg = (u.pn >= 12 && u.pn < 16) || (u.pn >= 32);
        const int row0 = u.pm * BM + wr * 64 + fr, col0 = (u.pn & 3) * BM + wc * 32 + 8 * fq;
        bf16_t* const Os = O + (size_t)(u.pn >> 2) * sec_stride;
#pragma unroll
        for (int ai = 0; ai < 2; ++ai)
#pragma unroll
            for (int m = 0; m < 4; ++m) { bf16_t* rowp = Os + (size_t)(row0 + ai * HALF + m * 16) * ldc + col0;
#pragma unroll
                for (int bj = 0; bj < 2; ++bj) { f32x4 v0 = acc[ai][bj][m][0], v1 = acc[ai][bj][m][1];
                    if (sg) {
#pragma unroll
                        for (int i = 0; i < 4; ++i) { v0[i] = fsigmoid(v0[i]); v1[i] = fsigmoid(v1[i]); } }
                    u32x4 w; w.x = cvt_pk_bf16(v0[0], v0[1]); w.y = cvt_pk_bf16(v0[2], v0[3]); w.z = cvt_pk_bf16(v1[0], v1[1]); w.w = cvt_pk_bf16(v1[2], v1[3]);
                    *(u32x4*)(rowp + bj * HALF) = w; } }
    }
};
struct EpiMerge {
    static constexpr bool PERM = true, AFTER_DRAIN = false;
    bf16_t* O; const bf16_t* Gt; int ld; int first;
    __device__ __forceinline__ void operator()(const f32x4 (&acc)[2][2][4][2], const Unit& u, int wr, int wc, int fr, int fq) const {
        const int row0 = u.pm * BM + wr * 64 + fr, col0 = u.pn * BM + wc * 32 + 8 * fq;
#pragma unroll
        for (int ai = 0; ai < 2; ++ai) {
            u32x4 gv[4][2], pv[4][2];
#pragma unroll
            for (int m = 0; m < 4; ++m)
#pragma unroll
                for (int bj = 0; bj < 2; ++bj) { const size_t ro = (size_t)(row0 + ai * HALF + m * 16) * ld + col0 + bj * HALF;
                    gv[m][bj] = *(const u32x4*)(Gt + ro); pv[m][bj] = first ? (u32x4){0u, 0u, 0u, 0u} : *(const u32x4*)(O + ro); }
#pragma unroll
            for (int m = 0; m < 4; ++m)
#pragma unroll
                for (int bj = 0; bj < 2; ++bj) { const size_t ro = (size_t)(row0 + ai * HALF + m * 16) * ld + col0 + bj * HALF;
                    const f32x4 v0 = acc[ai][bj][m][0], v1 = acc[ai][bj][m][1]; const u32x4 g4 = gv[m][bj], p4 = pv[m][bj];
                    float o[8];
                    o[0] = v0[0] * bflo(g4.x) + bflo(p4.x); o[1] = v0[1] * bfhi(g4.x) + bfhi(p4.x); o[2] = v0[2] * bflo(g4.y) + bflo(p4.y); o[3] = v0[3] * bfhi(g4.y) + bfhi(p4.y);
                    o[4] = v1[0] * bflo(g4.z) + bflo(p4.z); o[5] = v1[1] * bfhi(g4.z) + bfhi(p4.z); o[6] = v1[2] * bflo(g4.w) + bflo(p4.w); o[7] = v1[3] * bfhi(g4.w) + bfhi(p4.w);
                    u32x4 w; w.x = cvt_pk_bf16(o[0], o[1]); w.y = cvt_pk_bf16(o[2], o[3]); w.z = cvt_pk_bf16(o[4], o[5]); w.w = cvt_pk_bf16(o[6], o[7]);
                    *(u32x4*)(O + ro) = w; }
        }
    }
};
struct EpiResid {
    static constexpr bool PERM = false, AFTER_DRAIN = false;
    const float* base; float* out; int ldc;
    __device__ __forceinline__ void operator()(const f32x4 (&acc)[2][2][4][2], const Unit& u, int wr, int wc, int fr, int fq) const {
        const int row0 = u.pm * BM + wr * 64 + fr, col0 = u.pn * BM + wc * 32 + 4 * fq;
#pragma unroll
        for (int ai = 0; ai < 2; ++ai) {
            f32x4 b[4][2][2];
#pragma unroll
            for (int m = 0; m < 4; ++m) { const size_t off = (size_t)(row0 + ai * HALF + m * 16) * ldc + col0;
#pragma unroll
                for (int bj = 0; bj < 2; ++bj)
#pragma unroll
                    for (int n = 0; n < 2; ++n) b[m][bj][n] = *(const f32x4*)(base + off + bj * HALF + n * 16); }
#pragma unroll
            for (int m = 0; m < 4; ++m) { const size_t off = (size_t)(row0 + ai * HALF + m * 16) * ldc + col0;
#pragma unroll
                for (int bj = 0; bj < 2; ++bj)
#pragma unroll
                    for (int n = 0; n < 2; ++n) *(f32x4*)(out + off + bj * HALF + n * 16) = b[m][bj][n] + acc[ai][bj][m][n]; }
        }
    }
};
struct EpiSwiGLU {
    static constexpr bool PERM = true, AFTER_DRAIN = false;
    bf16_t* O; size_t slab;
    __device__ __forceinline__ void operator()(const f32x4 (&acc)[2][2][4][2], const Unit& u, int wr, int wc, int fr, int fq) const {
        const int row0 = u.pm * BM + wr * 64 + fr;
        bf16_t* const Os = O + (size_t)(2 * u.pn + (wc >> 1)) * slab + (wc & 1) * 32 + 8 * fq;
#pragma unroll
        for (int ai = 0; ai < 2; ++ai)
#pragma unroll
            for (int m = 0; m < 4; ++m) { bf16_t* rowp = Os + (size_t)(row0 + ai * HALF + m * 16) * 64;
                float o[8];
#pragma unroll
                for (int n = 0; n < 2; ++n)
#pragma unroll
                    for (int i = 0; i < 4; ++i) { const float gt = acc[ai][0][m][n][i], up = acc[ai][1][m][n][i]; o[n * 4 + i] = gt * fsigmoid(gt) * up; }
                u32x4 w; w.x = cvt_pk_bf16(o[0], o[1]); w.y = cvt_pk_bf16(o[2], o[3]); w.z = cvt_pk_bf16(o[4], o[5]); w.w = cvt_pk_bf16(o[6], o[7]);
                *(u32x4*)rowp = w; }
    }
};
template <class Epi, class Sched, bool ALIGN_EPI = false, bool SP2 = false>
__device__ __forceinline__ void gemm_phase(PG8_LAS unsigned char* lds, const Gemm g, const Sched& S, const Epi& E) {
    int tid_ = threadIdx.x; asm volatile("" : "+v"(tid_)); const int tid = tid_, wid = __builtin_amdgcn_readfirstlane(tid >> 6), lane = tid & 63, wr = wid >> 2, wc = wid & 3, fr = lane & 15, fq = lane >> 4;
    const int K = g.K, nt = K / BK;
    unsigned voffA[2], voffB[2];
#pragma unroll
    for (int i = 0; i < 2; ++i) { int R, C; stage_rc(tid * 16 + i * 8192, R, C); const int Rb = Epi::PERM ? ((R & ~31) + perm32(R & 31)) : R;
        voffA[i] = (unsigned)(R * g.lda + C) * 2u; voffB[i] = (unsigned)(Rb * K + C) * 2u; }
    const size_t kstep = (size_t)(BK * 2), kstepA = g.a_kstep ? (size_t)g.a_kstep : (size_t)(BK * 2);
    const size_t hstepA = (size_t)HALF * g.lda * 2, hstepB = (size_t)HALF * K * 2;
    const size_t tstepA = 2 * hstepA, tstepB = 2 * hstepB, pnoffA = (size_t)g.a_pn_off * 2;
    const unsigned ldsw = (unsigned)wid * 1024u;
    const int aoff = lds_byte(wr * 64 + fr, fq * 8), boff = lds_byte(wc * 32 + fr, fq * 8);
#define PG8_SA(b, h) (((b) * 2 + (h)) * HTB)
#define PG8_SB(b, h) ((4 + (b) * 2 + (h)) * HTB)
#define PG8_STAGE(bufoff, gbase, voff) do { _Pragma("unroll") for (int _i = 0; _i < 2; ++_i) \
        __builtin_amdgcn_global_load_lds((const unsigned*)((const char*)(gbase) + (voff)[_i]), (PG8_LAS unsigned*)(lds + (bufoff) + ldsw + _i * 8192), 16, 0, 0); } while (0)
#define PG8_LDA(dst, b, h) do { _Pragma("unroll") for (int m = 0; m < 4; ++m) _Pragma("unroll") for (int k = 0; k < 2; ++k) dst[m][k] = *(const PG8_LAS bf16x8*)(lds + PG8_SA(b, h) + aoff + m * 2048 + k * 1024); } while (0)
#define PG8_LDB(dst, b, h) do { _Pragma("unroll") for (int n = 0; n < 2; ++n) _Pragma("unroll") for (int k = 0; k < 2; ++k) dst[n][k] = *(const PG8_LAS bf16x8*)(lds + PG8_SB(b, h) + boff + n * 2048 + k * 1024); } while (0)
#define PG8_MMA(ai, bj, At, Bt) do { __builtin_amdgcn_s_setprio(1); _Pragma("unroll") for (int m = 0; m < 4; ++m) _Pragma("unroll") for (int n = 0; n < 2; ++n) _Pragma("unroll") for (int k = 0; k < 2; ++k) \
        acc[ai][bj][m][n] = __builtin_amdgcn_mfma_f32_16x16x32_bf16(Bt[n][k], At[m][k], acc[ai][bj][m][n], 0, 0, 0); __builtin_amdgcn_s_setprio(0); } while (0)
#define PG8_WAIT_V(n) asm volatile("s_waitcnt vmcnt(" #n ")" ::: "memory")
#define PG8_WAIT_L(n) asm volatile("s_waitcnt lgkmcnt(" #n ")" ::: "memory")
#define PG8_BAR __builtin_amdgcn_s_barrier()
#define PG8_SCHED __builtin_amdgcn_sched_barrier(0)
    Unit cur, nxt; int ui = 0;
    if (!S.next(0, cur)) return;
    f32x4 acc[2][2][4][2];
#pragma unroll
    for (int a = 0; a < 2; ++a)
#pragma unroll
        for (int b = 0; b < 2; ++b)
#pragma unroll
            for (int m = 0; m < 4; ++m)
#pragma unroll
                for (int n = 0; n < 2; ++n) acc[a][b][m][n] = (f32x4){0.f, 0.f, 0.f, 0.f};
    bf16x8 At[4][2], B0[2][2], B1[2][2];
    const char* cA = (const char*)g.A + (size_t)cur.pm * tstepA + (size_t)cur.pn * pnoffA; const char* cB = (const char*)g.Bt + (size_t)cur.pn * tstepB;
    S.a_ready(cur);
    if constexpr (SP2) {
        PG8_STAGE(PG8_SB(0, 0), cB, voffB); PG8_STAGE(PG8_SB(0, 1), cB + hstepB, voffB); PG8_STAGE(PG8_SA(0, 0), cA, voffA); PG8_STAGE(PG8_SA(0, 1), cA + hstepA, voffA);
        if (wr == 1) PG8_BAR;
        PG8_WAIT_V(2); PG8_BAR;
        PG8_STAGE(PG8_SB(1, 0), cB + kstep, voffB); PG8_STAGE(PG8_SA(1, 0), cA + kstepA, voffA); PG8_STAGE(PG8_SB(1, 1), cB + hstepB + kstep, voffB);
        PG8_WAIT_V(6); PG8_BAR;
    } else {
        PG8_STAGE(PG8_SB(0, 0), cB, voffB); PG8_STAGE(PG8_SA(0, 0), cA, voffA); PG8_STAGE(PG8_SB(0, 1), cB + hstepB, voffB); PG8_STAGE(PG8_SA(0, 1), cA + hstepA, voffA);
        if (wr == 1) PG8_BAR;
        PG8_WAIT_V(4); PG8_BAR;
        PG8_STAGE(PG8_SB(1, 0), cB + kstep, voffB); PG8_STAGE(PG8_SA(1, 0), cA + kstepA, voffA); PG8_STAGE(PG8_SB(1, 1), cB + hstepB + kstep, voffB);
        PG8_WAIT_V(6); PG8_BAR;
    }
    for (;;) {
        const bool has_next = S.next(ui + 1, nxt);
        const char* nA = has_next ? (const char*)g.A + (size_t)nxt.pm * tstepA + (size_t)nxt.pn * pnoffA : cA; const char* nB = has_next ? (const char*)g.Bt + (size_t)nxt.pn * tstepB : cB;
        for (int t = 0; t < nt; t += 2) {
            const bool last = (t == nt - 2);
            const char* a1 = cA + (size_t)(t + 1) * kstepA;
            const char* a2 = last ? nA : cA + (size_t)(t + 2) * kstepA; const char* b2 = last ? nB : cB + (size_t)(t + 2) * kstep;
            const char* a3 = a2 + kstepA; const char* b3 = b2 + kstep;
            if (last && has_next) S.a_ready(nxt);
            if constexpr (SP2) {
            PG8_LDB(B0, 0, 0); PG8_LDB(B1, 0, 1); PG8_SCHED; PG8_LDA(At, 0, 0); PG8_STAGE(PG8_SA(1, 1), a1 + hstepA, voffA);
            PG8_WAIT_V(8); PG8_WAIT_L(0); PG8_BAR; PG8_MMA(0, 0, At, B0); PG8_MMA(0, 1, At, B1); PG8_BAR; PG8_SCHED;
            PG8_LDA(At, 0, 1); PG8_STAGE(PG8_SB(0, 0), b2, voffB); PG8_STAGE(PG8_SB(0, 1), b2 + hstepB, voffB); PG8_STAGE(PG8_SA(0, 0), a2, voffA);
            PG8_WAIT_V(8); PG8_WAIT_L(0); PG8_BAR; PG8_MMA(1, 0, At, B0); PG8_MMA(1, 1, At, B1); PG8_BAR; PG8_SCHED;
            PG8_LDB(B0, 1, 0); PG8_LDB(B1, 1, 1); PG8_SCHED; PG8_LDA(At, 1, 0); PG8_STAGE(PG8_SA(0, 1), a2 + hstepA, voffA);
            PG8_WAIT_V(8); PG8_WAIT_L(0); PG8_BAR; PG8_MMA(0, 0, At, B0); PG8_MMA(0, 1, At, B1); PG8_BAR; PG8_SCHED;
            PG8_LDA(At, 1, 1); PG8_STAGE(PG8_SB(1, 0), b3, voffB); PG8_STAGE(PG8_SB(1, 1), b3 + hstepB, voffB); PG8_STAGE(PG8_SA(1, 0), a3, voffA);
            PG8_WAIT_V(8); PG8_WAIT_L(0); PG8_BAR; PG8_MMA(1, 0, At, B0); PG8_MMA(1, 1, At, B1); PG8_BAR; PG8_SCHED;
            } else {
            PG8_LDB(B0, 0, 0); PG8_SCHED; PG8_LDA(At, 0, 0); PG8_STAGE(PG8_SA(1, 1), a1 + hstepA, voffA);
            PG8_WAIT_L(8); PG8_BAR; PG8_WAIT_L(0); PG8_MMA(0, 0, At, B0); PG8_BAR; PG8_SCHED;
            PG8_LDB(B1, 0, 1); PG8_STAGE(PG8_SB(0, 0), b2, voffB);
            PG8_BAR; PG8_WAIT_L(0); PG8_MMA(0, 1, At, B1); PG8_BAR;
            PG8_LDA(At, 0, 1); PG8_STAGE(PG8_SA(0, 0), a2, voffA);
            PG8_BAR; PG8_WAIT_L(0); PG8_MMA(1, 0, At, B0); PG8_BAR; PG8_SCHED;
            PG8_STAGE(PG8_SB(0, 1), b2 + hstepB, voffB);
            PG8_WAIT_V(6); PG8_BAR; PG8_MMA(1, 1, At, B1); PG8_BAR;
            PG8_LDB(B0, 1, 0); PG8_SCHED; PG8_LDA(At, 1, 0); PG8_STAGE(PG8_SA(0, 1), a2 + hstepA, voffA);
            PG8_WAIT_L(8); PG8_BAR; PG8_WAIT_L(0); PG8_MMA(0, 0, At, B0); PG8_BAR; PG8_SCHED;
            PG8_LDB(B1, 1, 1); PG8_STAGE(PG8_SB(1, 0), b3, voffB);
            PG8_BAR; PG8_WAIT_L(0); PG8_MMA(0, 1, At, B1); PG8_BAR;
            PG8_LDA(At, 1, 1); PG8_STAGE(PG8_SA(1, 0), a3, voffA);
            PG8_BAR; PG8_WAIT_L(0); PG8_MMA(1, 0, At, B0); PG8_BAR; PG8_SCHED;
            PG8_STAGE(PG8_SB(1, 1), b3 + hstepB, voffB);
            PG8_WAIT_V(6); PG8_BAR; PG8_MMA(1, 1, At, B1); PG8_BAR;
            }
        }
        if constexpr (ALIGN_EPI) { if (wr == 0) PG8_BAR; }
        if constexpr (!Epi::AFTER_DRAIN) { E(acc, cur, wr, wc, fr, fq); S.done(cur); }
        if (!has_next) break;
#pragma unroll
        for (int a = 0; a < 2; ++a)
#pragma unroll
            for (int b = 0; b < 2; ++b)
#pragma unroll
                for (int m = 0; m < 4; ++m)
#pragma unroll
                    for (int n = 0; n < 2; ++n) acc[a][b][m][n] = (f32x4){0.f, 0.f, 0.f, 0.f};
        cur = nxt; cA = nA; cB = nB; ++ui;
        if constexpr (ALIGN_EPI) { if (wr == 1) PG8_BAR; }
    }
    PG8_WAIT_V(0);
    if constexpr (!ALIGN_EPI) { if (wr == 0) PG8_BAR; }
    PG8_BAR;
    if constexpr (Epi::AFTER_DRAIN) { E.fused(acc, cur, wr, wc, fr, fq, lds, wid, lane); S.done(cur); }
#undef PG8_SA
#undef PG8_SB
#undef PG8_STAGE
#undef PG8_LDA
#undef PG8_LDB
#undef PG8_MMA
#undef PG8_WAIT_V
#undef PG8_WAIT_L
#undef PG8_BAR
#undef PG8_SCHED
}
}

#define LAS __attribute__((address_space(3)))
typedef unsigned short bf16_t;
typedef short bf16x8 __attribute__((ext_vector_type(8)));
typedef short s16x4 __attribute__((ext_vector_type(4)));
typedef float f32x4 __attribute__((ext_vector_type(4)));
typedef unsigned u32x4 __attribute__((ext_vector_type(4)));
typedef unsigned u32x2 __attribute__((ext_vector_type(2)));
using pg8::cvt_pk_bf16; using pg8::bflo; using pg8::bfhi; using pg8::fsigmoid;

constexpr int DM = 1024, NBATCH = 8, SEQ = 4096, TT = NBATCH * SEQ, NIN = 11272, NP = 11264, FF = 2816;
constexpr int GB = 4, TG = GB * SEQ, NGRP = NBATCH / GB;
constexpr int NBH = GB * 4;
constexpr int LDS_BYTES = 147456;
constexpr int NTHR = 512;
constexpr int PP = 1024;
#define SEC(C) ((size_t)((C) / 1024) * ((size_t)TG * 1024) + (size_t)((C) % 1024))
constexpr int C_MQ = 0, C_MK = 1024, C_MV = 2048, C_MO = 3072, C_PU = 4096, C_AQ = 5120, C_AK = 6144, C_AV = 7168, C_GT = 8192;
constexpr size_t MiB = 1u << 20;
constexpr size_t WS_ROPE = 1 * MiB;
constexpr size_t WS_WIN = 2 * MiB, WS_WMO = 24 * MiB, WS_WPOOL = 26 * MiB, WS_WDIFF = 27 * MiB, WS_WOUT = 29 * MiB, WS_WGU = 31 * MiB, WS_WDN = 42 * MiB;
constexpr size_t WS_GIF = 48 * MiB;
constexpr size_t WS_MV = 48 * MiB + 512 * 1024;
constexpr size_t WS_NST = 49 * MiB;
constexpr size_t WS_HN = 50 * MiB;
constexpr size_t WS_CST = 82 * MiB;
constexpr size_t WS_PROJ = 146 * MiB;
constexpr size_t WS_END = 498 * MiB;

__device__ __forceinline__ int my_tid() { int t = threadIdx.x; asm volatile("" : "+v"(t)); return t; }
__device__ __forceinline__ float wave_sum(float v) {
#pragma unroll
    for (int o = 1; o < 64; o <<= 1) v += __shfl_xor(v, o);
    return v;
}
__device__ __forceinline__ float wave_max(float v) {
#pragma unroll
    for (int o = 1; o < 64; o <<= 1) v = fmaxf(v, __shfl_xor(v, o));
    return v;
}
typedef short v4i16_t __attribute__((ext_vector_type(4)));
__device__ __forceinline__ s16x4 vtr(const LAS char* p) { return __builtin_bit_cast(s16x4, __builtin_amdgcn_ds_read_tr16_b64_v4i16((LAS v4i16_t*)p)); }
__device__ __forceinline__ bf16x8 trfrag(const LAS char* base, int pitch, int k0, int n0, int lane) {
    const int g = lane >> 4, q = (lane & 15) >> 2, p = lane & 3;
    const LAS char* a = base + (k0 + 4 * g + q) * pitch + (n0 + 4 * p) * 2;
    const s16x4 lo = vtr(a), hi = vtr(a + 16 * pitch);
    return (bf16x8){lo[0], lo[1], lo[2], lo[3], hi[0], hi[1], hi[2], hi[3]};
}
__device__ __forceinline__ bf16x8 rowfrag(const LAS char* base, int pitch, int r0, int c0, int lane) {
    return *(const LAS bf16x8*)(base + (r0 + (lane & 15)) * pitch + (c0 + 8 * (lane >> 4)) * 2);
}
__device__ __forceinline__ bf16x8 rowfrag_perm(const LAS char* base, int pitch, int r0, int c0, int lane) {
    const LAS char* a = base + (r0 + (lane & 15)) * pitch + (c0 + 4 * (lane >> 4)) * 2;
    const s16x4 lo = *(const LAS s16x4*)a, hi = *(const LAS s16x4*)(a + 32);
    return (bf16x8){lo[0], lo[1], lo[2], lo[3], hi[0], hi[1], hi[2], hi[3]};
}
__device__ __forceinline__ f32x4 mfma16(bf16x8 a, bf16x8 b, f32x4 c) { return __builtin_amdgcn_mfma_f32_16x16x32_bf16(a, b, c, 0, 0, 0); }
__device__ __forceinline__ void unpack8(const u32x4 v, float (&f)[8]) {
    f[0] = bflo(v.x); f[1] = bfhi(v.x); f[2] = bflo(v.y); f[3] = bfhi(v.y); f[4] = bflo(v.z); f[5] = bfhi(v.z); f[6] = bflo(v.w); f[7] = bfhi(v.w);
}
__device__ __forceinline__ u32x4 pack8(const float (&f)[8]) {
    u32x4 w; w.x = cvt_pk_bf16(f[0], f[1]); w.y = cvt_pk_bf16(f[2], f[3]); w.z = cvt_pk_bf16(f[4], f[5]); w.w = cvt_pk_bf16(f[6], f[7]); return w;
}
#define LDS_WAIT() asm volatile("s_waitcnt lgkmcnt(0)" ::: "memory")
#define BAR_LDS() do { asm volatile("s_waitcnt lgkmcnt(0)" ::: "memory"); __builtin_amdgcn_s_barrier(); asm volatile("" ::: "memory"); } while (0)

struct Args { const float* in[16]; float* out; unsigned char* ws; int ph_lo, ph_hi; };
#define XB_TMO      128
#define XB_XCNT(j)  (256  + 64 * (j))
#define XB_XSUB(j)  (1280 + 64 * (j))
#define XB_XGEN(j)  (2304 + 64 * (j))
#define XB_TOP      3328
#define XB_TOPGEN   3392
#define XCD_BAR_WORDS 3456
#define XB_SPIN_CAP (1u << 18)

__device__ __forceinline__ unsigned xb_ld(unsigned* p)              { return __hip_atomic_load(p, __ATOMIC_RELAXED, __HIP_MEMORY_SCOPE_AGENT); }
__device__ __forceinline__ unsigned xb_add(unsigned* p, unsigned v) { return __hip_atomic_fetch_add(p, v, __ATOMIC_RELAXED, __HIP_MEMORY_SCOPE_AGENT); }
__device__ __forceinline__ unsigned xb_xcc_id() { return (unsigned)__builtin_amdgcn_s_getreg((3 << 11) | 20) & 0xFu; }
#define XB_SPIN(cond, bar) do { unsigned _sp = 0; while (cond) { __builtin_amdgcn_s_sleep(1); \
    if ((++_sp & 255u) == 0u) { if (xb_ld(&(bar)[XB_TMO])) break; if (_sp > XB_SPIN_CAP) { atomicAdd(&(bar)[XB_TMO], 1u); break; } } } } while (0)

struct XcdBarrier {
    unsigned* bar; unsigned x;
    volatile LAS unsigned* st;
};

__device__ __forceinline__ XcdBarrier xcd_barrier_post(unsigned* bar, volatile LAS unsigned* st) {
    XcdBarrier b; b.bar = bar; b.x = xb_xcc_id(); b.st = st;
    if (threadIdx.x == 0) (void)xb_add(&bar[XB_XCNT(b.x)], 1u);
    return b;
}
__device__ __forceinline__ void xcd_barrier_complete(unsigned* bar, unsigned x, unsigned& nloc, unsigned& nx) {
    const unsigned G = gridDim.x * gridDim.y * gridDim.z;
    unsigned sum, cnt, mine, sp = 0u;
    for (;;) {
        sum = 0u; cnt = 0u; mine = 0u;
#pragma unroll
        for (unsigned j = 0; j < 16; ++j) { const unsigned c = xb_ld(&bar[XB_XCNT(j)]); sum += c; cnt += (c > 0u) ? 1u : 0u; mine = (j == x) ? c : mine; }
        if (sum == G) break;
        __builtin_amdgcn_s_sleep(1);
        if ((++sp & 255u) == 0u) { if (xb_ld(&bar[XB_TMO])) break; if (sp > XB_SPIN_CAP) { atomicAdd(&bar[XB_TMO], 1u); break; } }
    }
    nloc = mine > 0u ? mine : 1u; nx = cnt > 0u ? cnt : 1u;
}

__device__ __forceinline__ void xcd_barrier(const XcdBarrier& b) {
    asm volatile("s_waitcnt vmcnt(0)" ::: "memory");
    __syncthreads();
    if (threadIdx.x == 0) {
        unsigned* bar = b.bar;
        __builtin_amdgcn_s_waitcnt(0);
        unsigned nloc = b.st[0], nx = b.st[1];
        if (nloc == 0u) { xcd_barrier_complete(bar, b.x, nloc, nx); b.st[0] = nloc; b.st[1] = nx; }
        const unsigned old = xb_add(&bar[XB_XSUB(b.x)], 1u);
        const unsigned gen = old / nloc;
        if (old + 1u == (gen + 1u) * nloc) {
            __builtin_amdgcn_fence(__ATOMIC_RELEASE, "agent");
            asm volatile("s_waitcnt vmcnt(0)" ::: "memory");
            const unsigned og = xb_add(&bar[XB_TOP], 1u);
            const unsigned tg = og / nx;
            if (og + 1u == (tg + 1u) * nx) xb_add(&bar[XB_TOPGEN], 1u);
            else XB_SPIN(xb_ld(&bar[XB_TOPGEN]) == tg, bar);
            __builtin_amdgcn_fence(__ATOMIC_ACQUIRE, "agent");
            xb_add(&bar[XB_XGEN(b.x)], 1u);
            asm volatile("s_waitcnt vmcnt(0)" ::: "memory");
        } else {
            XB_SPIN(xb_ld(&bar[XB_XGEN(b.x)]) == gen, bar);
            __builtin_amdgcn_fence(__ATOMIC_ACQUIRE, "agent");
            asm volatile("s_waitcnt vmcnt(0)" ::: "memory");
        }
    }
    __syncthreads();
}


__device__ __forceinline__ void cvt_item(const float* W, int ldw, int k0, int srccol0, bf16_t* WT, int K, int dstrow0, const float* rowscale, LAS float* scr, int lane) {
#pragma unroll 8
    for (int i = 0; i < 32; ++i) { const int kk = 2 * i + (lane >> 5); scr[kk * 33 + (lane & 31)] = W[(size_t)(k0 + kk) * ldw + srccol0 + (lane & 31)]; }
    LDS_WAIT();
    const int c = lane & 7;
#pragma unroll
    for (int j = 0; j < 4; ++j) { const int n = (lane >> 3) + 8 * j; const LAS float* s = scr + (8 * c) * 33 + n;
        const float sc = rowscale ? rowscale[n] : 1.0f;
        u32x4 o; o.x = cvt_pk_bf16(s[0 * 33] * sc, s[1 * 33] * sc); o.y = cvt_pk_bf16(s[2 * 33] * sc, s[3 * 33] * sc); o.z = cvt_pk_bf16(s[4 * 33] * sc, s[5 * 33] * sc); o.w = cvt_pk_bf16(s[6 * 33] * sc, s[7 * 33] * sc);
        *(u32x4*)(WT + (size_t)(dstrow0 + n) * K + k0 + 8 * c) = o; }
    LDS_WAIT();
}
__device__ __forceinline__ void phase_weights(const Args& a, int l, LAS unsigned char* lds) {
    const int tid = my_tid(), lane = tid & 63, wave = tid >> 6;
    LAS float* scr = (LAS float*)(lds + wave * 8704);
    const int gw = blockIdx.x * 8 + wave, NGW = gridDim.x * 8;
    unsigned char* ws = a.ws;
    const float* w_in = a.in[2] + (size_t)l * DM * NIN;
    const float* w_mo = a.in[5] + (size_t)l * DM * DM;
    const float* w_pool = a.in[6] + (size_t)l * 4 * 256 * 256;
    const float* pscale = a.in[7] + (size_t)l * DM;
    const float* w_diff = a.in[11] + (size_t)l * DM * DM;
    const float* w_out = a.in[12] + (size_t)l * DM * DM;
    const float* w_gu = a.in[14] + (size_t)l * DM * 2 * FF;
    const float* w_dn = a.in[15] + (size_t)l * FF * DM;
    constexpr int I0 = 16 * (NP / 32), I1 = 16 * 32, I2 = 4 * 4 * 8, I3 = I1, I4 = I1, I5 = 16 * (2 * FF / 32), I6 = (FF / 64) * 32;
    constexpr int NIT = I0 + I1 + I2 + I3 + I4 + I5 + I6;
    for (int it = gw; it < NIT; it += NGW) {
        int r = it;
        if (r < I0) { const int nb = r % (NP / 32), kb = r / (NP / 32), n0 = nb * 32; cvt_item(w_in, NIN, kb * 64, n0 < 4096 ? n0 : n0 + 8, (bf16_t*)(ws + WS_WIN), DM, n0, nullptr, scr, lane); continue; } r -= I0;
        if (r < I1) { const int nb = r % 32, kb = r / 32; cvt_item(w_mo, DM, kb * 64, nb * 32, (bf16_t*)(ws + WS_WMO), DM, nb * 32, nullptr, scr, lane); continue; } r -= I1;
        if (r < I2) { const int g = r / 32, q = r % 32, nb = q % 8, kb = q / 8; cvt_item(w_pool + g * 65536, 256, kb * 64, nb * 32, (bf16_t*)(ws + WS_WPOOL), 256, g * 256 + nb * 32, pscale + g * 256 + nb * 32, scr, lane); continue; } r -= I2;
        if (r < I3) { const int nb = r % 32, kb = r / 32; cvt_item(w_diff, DM, kb * 64, nb * 32, (bf16_t*)(ws + WS_WDIFF), DM, nb * 32, nullptr, scr, lane); continue; } r -= I3;
        if (r < I4) { const int nb = r % 32, kb = r / 32; cvt_item(w_out, DM, kb * 64, nb * 32, (bf16_t*)(ws + WS_WOUT), DM, nb * 32, nullptr, scr, lane); continue; } r -= I4;
        if (r < I5) { const int nb = r % (2 * FF / 32), kb = r / (2 * FF / 32), n0 = nb * 32, pn = n0 >> 8, wi = n0 & 255;
            const int sc0 = wi < 128 ? 128 * pn + wi : FF + 128 * pn + (wi - 128);
            cvt_item(w_gu, 2 * FF, kb * 64, sc0, (bf16_t*)(ws + WS_WGU), DM, n0, nullptr, scr, lane); continue; } r -= I5;
        { const int nb = r % 32, kb = r / 32; cvt_item(w_dn, DM, kb * 64, nb * 32, (bf16_t*)(ws + WS_WDN), FF, nb * 32, nullptr, scr, lane); }
    }
    if (l == 0) {
        float2* tab = (float2*)(ws + WS_ROPE);
        for (int e = blockIdx.x * NTHR + tid; e < SEQ * 32; e += gridDim.x * NTHR) {
            const int pos = e >> 5, i = e & 31;
            double inv = 1.0; const double rr = 0.74989420933245582730;
            for (int j = 0; j < i; ++j) inv *= rr;
            const double t2 = inv * inv; double cs = 1.0, sn = inv, tc = 1.0, tsn = inv;
#pragma unroll
            for (int n = 1; n <= 12; ++n) { tc *= -t2 / (double)((2 * n - 1) * (2 * n)); cs += tc; tsn *= -t2 / (double)((2 * n) * (2 * n + 1)); sn += tsn; }
            double zr = 1.0, zi = 0.0, br = cs, bi = sn;
            for (int b = 0; b < 12; ++b) { if ((pos >> b) & 1) { const double nr = zr * br - zi * bi, ni = zr * bi + zi * br; zr = nr; zi = ni; } const double sr = br * br - bi * bi, si = 2.0 * br * bi; br = sr; bi = si; }
            tab[e] = make_float2((float)zr, (float)zi);
        }
    }
}

template <bool GATES>
__device__ __forceinline__ void phase_norm(const float* x, const float* gain, bf16_t* hn, int nrows, const float* w_in_l, const float* bif, float* gif, LAS unsigned char* lds) {
    const int tid = my_tid(), lane = tid & 63, wave = tid >> 6;
    LAS float* wif = (LAS float*)lds;
    f32x4 wr[GATES ? 8 : 1][4];
    if (GATES) {
        for (int i = 0; i < 16; ++i) { const int idx = tid + NTHR * i, k = idx >> 3, e = idx & 7; wif[e * 1024 + k] = w_in_l[(size_t)k * NIN + 4096 + e]; }
        __syncthreads();
#pragma unroll
        for (int e = 0; e < 8; ++e)
#pragma unroll
            for (int j = 0; j < 4; ++j) wr[e][j] = *(const LAS f32x4*)(wif + e * 1024 + 4 * lane + 256 * j);
    }
    const int gw = blockIdx.x * 8 + wave, NGW = gridDim.x * 8;
    f32x4 gv[4];
#pragma unroll
    for (int j = 0; j < 4; ++j) gv[j] = *(const f32x4*)(gain + 4 * lane + 256 * j);
    f32x4 v[4], nx[4];
    if (gw < nrows) { const f32x4* xr = (const f32x4*)(x + (size_t)gw * DM) + lane;
#pragma unroll
        for (int j = 0; j < 4; ++j) nx[j] = xr[64 * j]; }
    for (int row = gw; row < nrows; row += NGW) {
        float ss = 0.f;
#pragma unroll
        for (int j = 0; j < 4; ++j) v[j] = nx[j];
        if (row + NGW < nrows) { const f32x4* xr = (const f32x4*)(x + (size_t)(row + NGW) * DM) + lane;
#pragma unroll
            for (int j = 0; j < 4; ++j) nx[j] = xr[64 * j]; }
#pragma unroll
        for (int j = 0; j < 4; ++j) ss += (v[j].x * v[j].x + v[j].y * v[j].y) + (v[j].z * v[j].z + v[j].w * v[j].w);
        const float rstd = 1.0f / sqrtf(wave_sum(ss) * (1.0f / DM) + 1e-6f);
        bf16_t* o8 = hn + (size_t)(lane >> 4) * ((size_t)nrows * 64) + (size_t)row * 64 + 4 * (lane & 15);
#pragma unroll
        for (int j = 0; j < 4; ++j) { v[j] = v[j] * rstd * gv[j]; u32x2 w; w.x = cvt_pk_bf16(v[j].x, v[j].y); w.y = cvt_pk_bf16(v[j].z, v[j].w); *(u32x2*)(o8 + (size_t)(4 * j) * ((size_t)nrows * 64)) = w; }
        if (GATES) {
            float ga[8];
#pragma unroll
            for (int e = 0; e < 8; ++e) { float s = 0.f;
#pragma unroll
                for (int j = 0; j < 4; ++j) { const f32x4 w = wr[e][j]; s += (v[j].x * w.x + v[j].y * w.y) + (v[j].z * w.z + v[j].w * w.w); }
                ga[e] = s; }
            float h4[4], h2[2], h1;
            { const bool up = (lane & 32) != 0;
#pragma unroll
              for (int i = 0; i < 4; ++i) { const float mine = up ? ga[4 + i] : ga[i], other = up ? ga[i] : ga[4 + i]; h4[i] = mine + __shfl_xor(other, 32); } }
            { const bool up = (lane & 16) != 0;
#pragma unroll
              for (int i = 0; i < 2; ++i) { const float mine = up ? h4[2 + i] : h4[i], other = up ? h4[i] : h4[2 + i]; h2[i] = mine + __shfl_xor(other, 16); } }
            { const bool up = (lane & 8) != 0; const float mine = up ? h2[1] : h2[0], other = up ? h2[0] : h2[1]; h1 = mine + __shfl_xor(other, 8); }
            h1 += __shfl_xor(h1, 4); h1 += __shfl_xor(h1, 2); h1 += __shfl_xor(h1, 1);
            if ((lane & 7) == 0) {
                const int e = 4 * (lane >> 5) + 2 * ((lane >> 4) & 1) + ((lane >> 3) & 1);
                const float pre = h1 + bif[e];
                gif[(size_t)row * 8 + e] = (e < 4) ? pre : (fminf(pre, 0.f) - log1pf(__expf(-fabsf(pre))));
            }
        }
    }
    __syncthreads();
}

constexpr int PIT = 544;
constexpr int XOFF = 0, YOFF = 128 * PIT, VECOFF = 2 * 128 * PIT;
__device__ __forceinline__ void load_plain(LAS char* dst, const bf16_t* src, size_t gpitch, int tid) {
#pragma unroll
    for (int i = 0; i < 8; ++i) { const int id = tid + NTHR * i, row = id >> 5, cc = id & 31;
        const u32x4 v = *(const u32x4*)(src + (size_t)row * gpitch + cc * 8);
        *(LAS u32x4*)(dst + row * PIT + cc * 16) = v; }
}
__device__ __forceinline__ void load_plain_issue(u32x4 (&pre)[8], const bf16_t* src, size_t gpitch, int tid) {
#pragma unroll
    for (int i = 0; i < 8; ++i) { const int id = tid + NTHR * i, row = id >> 5, cc = id & 31; pre[i] = *(const u32x4*)(src + (size_t)row * gpitch + cc * 8); }
}
__device__ __forceinline__ void load_plain_commit(LAS char* dst, const u32x4 (&pre)[8], int tid) {
#pragma unroll
    for (int i = 0; i < 8; ++i) { const int id = tid + NTHR * i, row = id >> 5, cc = id & 31; *(LAS u32x4*)(dst + row * PIT + cc * 16) = pre[i]; }
}
__device__ __forceinline__ void load_conv(LAS char* dst, const bf16_t* src, int pos0, const float* cw  , const LAS float* rowscale, float cscale, int tid) {
    const int cg = tid & 31, rs = tid >> 5, r0 = rs * 8;
    u32x4 rw[11];
#pragma unroll
    for (int j = 0; j < 11; ++j) { const int rr = r0 - 3 + j;
        if (j >= 3 || pos0 + rr >= 0) rw[j] = *(const u32x4*)(src + (ptrdiff_t)rr * PP + cg * 8); else rw[j] = (u32x4){0u, 0u, 0u, 0u}; }
    float w[4][8];
#pragma unroll
    for (int j = 0; j < 4; ++j) { const f32x4 a = *(const f32x4*)(cw + j * 2048 + cg * 8), b = *(const f32x4*)(cw + j * 2048 + cg * 8 + 4);
        w[j][0] = a.x; w[j][1] = a.y; w[j][2] = a.z; w[j][3] = a.w; w[j][4] = b.x; w[j][5] = b.y; w[j][6] = b.z; w[j][7] = b.w; }
    float sc8[8];
#pragma unroll
    for (int r = 0; r < 8; ++r) sc8[r] = rowscale ? rowscale[r0 + r] : cscale;
    float u[3][8];
#pragma unroll
    for (int j = 0; j < 3; ++j) unpack8(rw[j], u[j]);
#pragma unroll
    for (int r = 0; r < 8; ++r) {
        float x[8]; unpack8(rw[3 + r], x);
        const float sc = sc8[r];
        float o[8];
#pragma unroll
        for (int e = 0; e < 8; ++e) { const float cv = (w[0][e] * u[0][e] + w[1][e] * u[1][e]) + (w[2][e] * u[2][e] + w[3][e] * x[e]); o[e] = cv * fsigmoid(cv) * sc;
            u[0][e] = u[1][e]; u[1][e] = u[2][e]; u[2][e] = x[e]; }
        *(LAS u32x4*)(dst + (r0 + r) * PIT + cg * 16) = pack8(o);
    }
}
__device__ __forceinline__ void load_conv_issue(u32x4 (&rw)[11], const bf16_t* src, int pos0, int tid) {
    const int cg = tid & 31, r0 = (tid >> 5) * 8;
#pragma unroll
    for (int j = 0; j < 11; ++j) { const int rr = r0 - 3 + j;
        if (j >= 3 || pos0 + rr >= 0) rw[j] = *(const u32x4*)(src + (ptrdiff_t)rr * PP + cg * 8); else rw[j] = (u32x4){0u, 0u, 0u, 0u}; }
}
__device__ __forceinline__ void load_conv_finish(LAS char* dst, const u32x4 (&rw)[11], const float* cw, const LAS float* rowscale, float cscale, int tid) {
    const int cg = tid & 31, r0 = (tid >> 5) * 8;
    float w[4][8];
#pragma unroll
    for (int j = 0; j < 4; ++j) { const f32x4 a = *(const f32x4*)(cw + j * 2048 + cg * 8), b = *(const f32x4*)(cw + j * 2048 + cg * 8 + 4);
        w[j][0] = a.x; w[j][1] = a.y; w[j][2] = a.z; w[j][3] = a.w; w[j][4] = b.x; w[j][5] = b.y; w[j][6] = b.z; w[j][7] = b.w; }
    float sc8[8];
#pragma unroll
    for (int r = 0; r < 8; ++r) sc8[r] = rowscale ? rowscale[r0 + r] : cscale;
    float u[3][8];
#pragma unroll
    for (int j = 0; j < 3; ++j) unpack8(rw[j], u[j]);
#pragma unroll
    for (int r = 0; r < 8; ++r) {
        float x[8]; unpack8(rw[3 + r], x);
        const float sc = sc8[r];
        float o[8];
#pragma unroll
        for (int e = 0; e < 8; ++e) { const float cv = (w[0][e] * u[0][e] + w[1][e] * u[1][e]) + (w[2][e] * u[2][e] + w[3][e] * x[e]); o[e] = cv * fsigmoid(cv) * sc;
            u[0][e] = u[1][e]; u[1][e] = u[2][e]; u[2][e] = x[e]; }
        *(LAS u32x4*)(dst + (r0 + r) * PIT + cg * 16) = pack8(o);
    }
}
__device__ __forceinline__ void load_gates(LAS float* vec, const float* gif, int t0, int h, int tid) {
    LAS float* li = vec; LAS float* bc = vec + 128; LAS float* tot = vec + 256;
    const int lane = tid & 63;
    float v = 0.f;
    if (tid < 128) { li[tid] = gif[(size_t)(t0 + tid) * 8 + h]; v = gif[(size_t)(t0 + tid) * 8 + 4 + h];
#pragma unroll
        for (int o = 1; o < 64; o <<= 1) { const float uu = __shfl_up(v, o); if (lane >= o) v += uu; }
        if (tid == 63) tot[0] = v; }
    __syncthreads();
    if (tid < 128) { if (tid >= 64) v += tot[0]; bc[tid] = v; }
}

__device__ __forceinline__ void m1_phase(LAS char* lds, const bf16_t* proj, const float* gif, bf16_t* Cst, float* nst, float* gch, float* mloc, const float* convw, int bx, int G) {
    const int tid = my_tid(), lane = tid & 63, wid = __builtin_amdgcn_readfirstlane(tid >> 6), g = lane >> 4, fr = lane & 15;
    LAS char* X = lds + XOFF; LAS char* Y = lds + YOFF; LAS float* vec = (LAS float*)(lds + VECOFF);
    LAS float* li = vec; LAS float* bc = vec + 128; LAS float* tot = vec + 256; LAS float* es = vec + 272;
    u32x4 rk[11]; float liv = 0.f, lfv = 0.f;
#define M1_ISSUE(it_) do { const int bhl_ = (it_) >> 5, c_ = (it_) & 31, h_ = bhl_ & 3, t0_ = (bhl_ >> 2) * SEQ + c_ * 128; \
        load_conv_issue(rk, proj + SEC(C_MK) + (size_t)t0_ * PP + h_ * 256, c_ * 128, tid); \
        if (tid < 128) { liv = gif[(size_t)(t0_ + tid) * 8 + h_]; lfv = gif[(size_t)(t0_ + tid) * 8 + 4 + h_]; } } while (0)
    if (bx >= NBH * 32) return;
    M1_ISSUE(bx);
    for (int it = bx; it < NBH * 32; it += G) {
        const int bhl = it >> 5, h = bhl & 3, item = it;
        u32x4 pv[8]; load_plain_issue(pv, proj + SEC(C_MV) + (size_t)((bhl >> 2) * SEQ + (it & 31) * 128) * PP + h * 256, PP, tid);
        float v = lfv;
        if (tid < 128) { li[tid] = liv;
#pragma unroll
            for (int o = 1; o < 64; o <<= 1) { const float uu = __shfl_up(v, o); if (lane >= o) v += uu; }
            if (tid == 63) tot[0] = v; }
        BAR_LDS();
        if (tid < 128) { if (tid >= 64) v += tot[0]; bc[tid] = v; }
        BAR_LDS();
        const float gtot = bc[127];
        const float w0 = gtot - bc[lane] + li[lane], w1 = gtot - bc[lane + 64] + li[lane + 64];
        const float ml = wave_max(fmaxf(w0, w1));
        if (tid < 128) es[tid] = __expf(gtot - bc[tid] + li[tid] - ml);
        if (tid == 0) { gch[item] = gtot; mloc[item] = ml; }
        BAR_LDS();
        load_conv_finish(X, rk, convw + 1024 + h * 256, es, 1.0f, tid);
        load_plain_commit(Y, pv, tid);
        BAR_LDS();
        if (it + G < NBH * 32) M1_ISSUE(it + G);
        if (tid < 256) { float sn = 0.f; const LAS char* xc = X + tid * 2;
#pragma unroll 16
            for (int r = 0; r < 128; ++r) sn += __uint_as_float((unsigned)(*(const LAS unsigned short*)(xc + r * PIT)) << 16);
            nst[(size_t)item * 256 + tid] = sn; }
        bf16_t* Co = Cst + (size_t)item * 65536;
#pragma unroll 1
        for (int hk = 0; hk < 2; ++hk) {
            f32x4 acc[2][8];
#pragma unroll
            for (int i = 0; i < 2; ++i)
#pragma unroll
                for (int j = 0; j < 8; ++j) acc[i][j] = (f32x4){0.f, 0.f, 0.f, 0.f};
            const LAS char* Xh = X + hk * 256;
#pragma unroll 1
            for (int t = 0; t < 4; ++t) {
                const bf16x8 v0 = trfrag(Y, PIT, 32 * t, 16 * (2 * wid), lane), v1 = trfrag(Y, PIT, 32 * t, 16 * (2 * wid + 1), lane);
#pragma unroll
                for (int kh = 0; kh < 2; ++kh) {
                    bf16x8 kf[4];
#pragma unroll
                    for (int kb = 0; kb < 4; ++kb) kf[kb] = trfrag(Xh, PIT, 32 * t, 16 * (4 * kh + kb), lane);
                    __builtin_amdgcn_sched_barrier(0);
#pragma unroll
                    for (int kb = 0; kb < 4; ++kb) { acc[0][4 * kh + kb] = mfma16(v0, kf[kb], acc[0][4 * kh + kb]); acc[1][4 * kh + kb] = mfma16(v1, kf[kb], acc[1][4 * kh + kb]); } }
            }
#pragma unroll
            for (int i = 0; i < 2; ++i)
#pragma unroll
                for (int kb = 0; kb < 8; ++kb) { u32x2 w; w.x = cvt_pk_bf16(acc[i][kb][0], acc[i][kb][1]); w.y = cvt_pk_bf16(acc[i][kb][2], acc[i][kb][3]);
                    *(u32x2*)(Co + (size_t)(128 * hk + 16 * kb + fr) * 256 + 16 * (2 * wid + i) + 4 * g) = w; }
        }
        BAR_LDS();
    }
#undef M1_ISSUE
}

__device__ __forceinline__ void phase_scan(bf16_t* Cst, float* nst, const float* gch, const float* mloc, float* mprev) {
    const int tid = my_tid();
    for (int i = blockIdx.x * NTHR + tid; i < NBH * 8192 + NBH * 256; i += gridDim.x * NTHR) {
        if (i < NBH * 8192) {
            const int bh = i >> 13, e8 = i & 8191;
            float st[8];
#pragma unroll
            for (int e = 0; e < 8; ++e) st[e] = 0.f;
            float m = -1e30f;
            for (int c0 = 0; c0 < 32; c0 += 8) {
                u32x4 ld[8];
#pragma unroll
                for (int j = 0; j < 8; ++j) ld[j] = *(const u32x4*)(Cst + ((size_t)(bh * 32 + c0 + j) * 65536 + e8 * 8));
#pragma unroll
                for (int j = 0; j < 8; ++j) { const int c = c0 + j; const float gc = gch[bh * 32 + c], mc = mloc[bh * 32 + c];
                    const float mn = fmaxf(gc + m, mc), aa = __expf(gc + m - mn), bb = __expf(mc - mn);
                    float lc[8]; unpack8(ld[j], lc);
                    *(u32x4*)(Cst + ((size_t)(bh * 32 + c) * 65536 + e8 * 8)) = pack8(st);
#pragma unroll
                    for (int e = 0; e < 8; ++e) st[e] = aa * st[e] + bb * lc[e];
                    if (e8 == 0) mprev[bh * 32 + c] = m;
                    m = mn; }
            }
        } else {
            const int j = i - NBH * 8192, bh = j >> 8, k = j & 255;
            float st = 0.f, m = -1e30f;
            for (int c = 0; c < 32; ++c) { const float gc = gch[bh * 32 + c], mc = mloc[bh * 32 + c];
                const float mn = fmaxf(gc + m, mc), aa = __expf(gc + m - mn), bb = __expf(mc - mn);
                const size_t o = (size_t)(bh * 32 + c) * 256 + k; const float lc = nst[o]; nst[o] = st; st = aa * st + bb * lc; m = mn; }
        }
    }
}

__device__ __forceinline__ void m3_item(LAS char* lds, bf16_t* proj, const float* gif, const bf16_t* Cst, const float* nst, const float* mprev, const float* convw, int bhl, int c) {
    const int tid = my_tid(), lane = tid & 63, wid = __builtin_amdgcn_readfirstlane(tid >> 6), g = lane >> 4, fr = lane & 15;
    const int bl = bhl >> 2, h = bhl & 3, item = bhl * 32 + c, t0 = bl * SEQ + c * 128;
    LAS char* X = lds + XOFF; LAS char* Y = lds + YOFF; LAS float* vec = (LAS float*)(lds + VECOFF);
    LAS float* li = vec; LAS float* bc = vec + 128; LAS float* npv = vec + 272;
    load_gates(vec, gif, t0, h, tid);
    if (tid < 256) npv[tid] = nst[(size_t)item * 256 + tid];
    load_conv(X, proj + SEC(C_MQ) + (size_t)t0 * PP + h * 256, c * 128, convw + h * 256, nullptr, 0.0625f, tid);
    load_conv(Y, proj + SEC(C_MK) + (size_t)t0 * PP + h * 256, c * 128, convw + 1024 + h * 256, nullptr, 1.0f, tid);
    __syncthreads();
    const int j0 = 16 * wid, jj = j0 + fr;
    bf16x8 pf[4]; float den, inter, mt;
    u32x4 pre[8];
    load_plain_issue(pre, Cst + (size_t)item * 65536, 256, tid);
    {
        f32x4 S[8];
#pragma unroll
        for (int sb = 0; sb < 8; ++sb) S[sb] = (f32x4){0.f, 0.f, 0.f, 0.f};
#pragma unroll 1
        for (int t = 0; t < 8; ++t) { const bf16x8 qb = rowfrag(X, PIT, j0, 32 * t, lane);
            bf16x8 kf[8];
#pragma unroll
            for (int sb = 0; sb < 8; ++sb) kf[sb] = rowfrag(Y, PIT, 16 * sb, 32 * t, lane);
            __builtin_amdgcn_sched_barrier(0);
#pragma unroll
            for (int sb = 0; sb < 8; ++sb) S[sb] = mfma16(kf[sb], qb, S[sb]); }
        float qn = 0.f;
        { const LAS char* qr = X + jj * PIT + (64 * g) * 2;
#pragma unroll 2
            for (int i = 0; i < 8; ++i) { const u32x4 v = *(const LAS u32x4*)(qr + 16 * i); float f[8]; unpack8(v, f);
                const f32x4 n0 = *(const LAS f32x4*)(npv + 64 * g + 8 * i), n1 = *(const LAS f32x4*)(npv + 64 * g + 8 * i + 4);
                qn += (f[0] * n0.x + f[1] * n0.y) + (f[2] * n0.z + f[3] * n0.w) + (f[4] * n1.x + f[5] * n1.y) + (f[6] * n1.z + f[7] * n1.w); } }
        qn += __shfl_xor(qn, 16); qn += __shfl_xor(qn, 32);
        const float bj = bc[jj], mp = mprev[item];
        float rmax = -INFINITY;
#pragma unroll
        for (int sb = 0; sb < 8; ++sb) { const f32x4 b4 = *(const LAS f32x4*)(bc + 16 * sb + 4 * g), l4 = *(const LAS f32x4*)(li + 16 * sb + 4 * g);
#pragma unroll
            for (int r = 0; r < 4; ++r) { const int s = 16 * sb + 4 * g + r; const float dm = (s <= jj) ? (bj - b4[r] + l4[r]) : -INFINITY; rmax = fmaxf(rmax, dm); } }
        rmax = fmaxf(rmax, __shfl_xor(rmax, 16)); rmax = fmaxf(rmax, __shfl_xor(rmax, 32));
        const float minter = bj + mp; mt = fmaxf(minter, rmax); inter = __expf(minter - mt);
        den = 0.f;
#pragma unroll
        for (int sb = 0; sb < 8; ++sb) { const f32x4 b4 = *(const LAS f32x4*)(bc + 16 * sb + 4 * g), l4 = *(const LAS f32x4*)(li + 16 * sb + 4 * g);
#pragma unroll
            for (int r = 0; r < 4; ++r) { const int s = 16 * sb + 4 * g + r; const float p = (s <= jj) ? __expf(bj - b4[r] + l4[r] - mt) : 0.f; const float v = S[sb][r] * p; S[sb][r] = v; den += v; } }
        den += __shfl_xor(den, 16); den += __shfl_xor(den, 32);
        den += inter * qn;
#pragma unroll
        for (int t = 0; t < 4; ++t) { u32x4 w; w.x = cvt_pk_bf16(S[2 * t][0], S[2 * t][1]); w.y = cvt_pk_bf16(S[2 * t][2], S[2 * t][3]); w.z = cvt_pk_bf16(S[2 * t + 1][0], S[2 * t + 1][1]); w.w = cvt_pk_bf16(S[2 * t + 1][2], S[2 * t + 1][3]); pf[t] = __builtin_bit_cast(bf16x8, w); }
    }
    f32x4 acc[16];
#pragma unroll
    for (int j = 0; j < 16; ++j) acc[j] = (f32x4){0.f, 0.f, 0.f, 0.f};
#pragma unroll 1
    for (int half = 0; half < 2; ++half) {
        __syncthreads();
        load_plain_commit(Y, pre, tid);
        if (half == 0) load_plain_issue(pre, Cst + (size_t)item * 65536 + 32768, 256, tid);
        else load_plain_issue(pre, proj + SEC(C_MV) + (size_t)t0 * PP + h * 256, PP, tid);
        __syncthreads();
#pragma unroll 1
        for (int t = 0; t < 4; ++t) { const bf16x8 qb = rowfrag_perm(X, PIT, j0, half * 128 + 32 * t, lane);
#pragma unroll
            for (int hb = 0; hb < 2; ++hb) {
                bf16x8 cf[8];
#pragma unroll
                for (int nb = 0; nb < 8; ++nb) cf[nb] = trfrag(Y, PIT, 32 * t, 16 * (8 * hb + nb), lane);
                __builtin_amdgcn_sched_barrier(0);
#pragma unroll
                for (int nb = 0; nb < 8; ++nb) acc[8 * hb + nb] = mfma16(cf[nb], qb, acc[8 * hb + nb]); } }
    }
#pragma unroll
    for (int nb = 0; nb < 16; ++nb) acc[nb] = acc[nb] * inter;
    __syncthreads();
    load_plain_commit(X, pre, tid);
    __syncthreads();
#pragma unroll
    for (int t = 0; t < 4; ++t) if (2 * t <= wid) {
        bf16x8 vf[16];
#pragma unroll
        for (int nb = 0; nb < 16; ++nb) vf[nb] = trfrag(X, PIT, 32 * t, 16 * nb, lane);
        __builtin_amdgcn_sched_barrier(0);
#pragma unroll
        for (int nb = 0; nb < 16; ++nb) acc[nb] = mfma16(vf[nb], pf[t], acc[nb]); }
    const float rdn = 1.0f / fmaxf(fabsf(den), __expf(-mt));
    bf16_t* op = proj + SEC(C_MO) + (size_t)(t0 + jj) * PP + h * 256 + 4 * g;
    u32x2 sgv[16];
#pragma unroll
    for (int nb = 0; nb < 16; ++nb) sgv[nb] = *(const u32x2*)(op + 16 * nb);
#pragma unroll
    for (int nb = 0; nb < 16; ++nb) { const u32x2 sg = sgv[nb];
        u32x2 w; w.x = cvt_pk_bf16(acc[nb][0] * rdn * bflo(sg.x), acc[nb][1] * rdn * bfhi(sg.x)); w.y = cvt_pk_bf16(acc[nb][2] * rdn * bflo(sg.y), acc[nb][3] * rdn * bfhi(sg.y));
        *(u32x2*)(op + 16 * nb) = w; }
    __syncthreads();
}

__device__ __forceinline__ void phase_qkprep(bf16_t* proj, const float* gqk  , const float2* rope) {
    const int tid = my_tid(), lane = tid & 63, wave = tid >> 6;
    const int gw = blockIdx.x * 8 + wave, NGW = gridDim.x * 8;
    const int grp = lane >> 2, u = lane & 3;
    for (int it = gw; it < TG * 2; it += NGW) {
        const int row = it >> 1, which = it & 1, pos = row & (SEQ - 1);
        bf16_t* p = proj + (which ? SEC(C_AK) : SEC(C_AQ)) + (size_t)row * PP + grp * 64 + 8 * u;
        const u32x4 a = *(const u32x4*)p, b = *(const u32x4*)(p + 32);
        float x1[8], x2[8]; unpack8(a, x1); unpack8(b, x2);
        float ss = 0.f;
#pragma unroll
        for (int e = 0; e < 8; ++e) ss += x1[e] * x1[e] + x2[e] * x2[e];
        ss += __shfl_xor(ss, 1); ss += __shfl_xor(ss, 2);
        const float rstd = 1.0f / sqrtf(ss * (1.0f / 64.0f) + 1e-6f) * (which ? 1.0f : 0.125f * 1.4426950408889634f);
        const float* gq = gqk + which * 64 + 8 * u;
        const float2* cs = rope + (size_t)pos * 32 + 8 * u;
        float o1[8], o2[8];
#pragma unroll
        for (int e = 0; e < 8; ++e) { const float y1 = x1[e] * rstd * gq[e], y2 = x2[e] * rstd * gq[32 + e]; const float2 t = cs[e]; o1[e] = y1 * t.x - y2 * t.y; o2[e] = y2 * t.x + y1 * t.y; }
        *(u32x4*)p = pack8(o1); *(u32x4*)(p + 32) = pack8(o2);
    }
}
__device__ __forceinline__ void phase_pool(const bf16_t* proj, bf16_t* pooled) {
    const int tid = my_tid();
    for (int idx = blockIdx.x * NTHR + tid; idx < (TG / 16) * 128; idx += gridDim.x * NTHR) {
        const int cgi = idx & 127, seg = idx >> 7, r0 = seg * 16, pos0 = r0 & (SEQ - 1), w = 2 << (cgi >> 5);
        const bf16_t* src = proj + SEC(C_PU) + (size_t)r0 * PP + cgi * 8;
        float sum[8];
#pragma unroll
        for (int e = 0; e < 8; ++e) sum[e] = 0.f;
        if (pos0 > 0) for (int j = 1; j < w; ++j) { float f[8]; unpack8(*(const u32x4*)(src - (ptrdiff_t)j * PP), f);
#pragma unroll
            for (int e = 0; e < 8; ++e) sum[e] += f[e]; }
        for (int r = 0; r < 16; ++r) {
            float f[8]; unpack8(*(const u32x4*)(src + (ptrdiff_t)r * PP), f);
            const int pos = pos0 + r;
            if (r >= 1 && pos - w >= 0) { float o[8]; unpack8(*(const u32x4*)(src + (ptrdiff_t)(r - w) * PP), o);
#pragma unroll
                for (int e = 0; e < 8; ++e) sum[e] -= o[e]; }
            const float rc = 1.0f / (float)(pos + 1 < w ? pos + 1 : w);
            float out[8];
#pragma unroll
            for (int e = 0; e < 8; ++e) { sum[e] += f[e]; out[e] = sum[e] * rc - f[e]; }
            *(u32x4*)(pooled + (size_t)(r0 + r) * DM + cgi * 8) = pack8(out);
        }
    }
}

constexpr int APIT = 288, ATILE = 64 * APIT, ABUF = 2 * ATILE;
__device__ __forceinline__ void attn_qkexp(const LAS char* Kb, int k0, int q0, int wid, int lane, int g, int qpos, const bf16x8 (&qf)[2][2], const f32x4 negM, bf16x8 (&pf)[2][2]) {
    f32x4 s[2][4];
    {
        bf16x8 kf[2][4][2];
#pragma unroll
        for (int c = 0; c < 2; ++c)
#pragma unroll
            for (int kb = 0; kb < 4; ++kb)
#pragma unroll
                for (int ks = 0; ks < 2; ++ks) kf[c][kb][ks] = rowfrag(Kb, APIT, 16 * kb, c * 64 + 32 * ks, lane);
        __builtin_amdgcn_sched_barrier(0);
#pragma unroll
        for (int c = 0; c < 2; ++c)
#pragma unroll
            for (int kb = 0; kb < 4; ++kb) s[c][kb] = mfma16(kf[c][kb][0], qf[c][0], negM);
#pragma unroll
        for (int c = 0; c < 2; ++c)
#pragma unroll
            for (int kb = 0; kb < 4; ++kb) s[c][kb] = mfma16(kf[c][kb][1], qf[c][1], s[c][kb]);
    }
    if (k0 + 63 > q0 + 16 * wid) {
#pragma unroll
        for (int c = 0; c < 2; ++c)
#pragma unroll
            for (int kb = 0; kb < 4; ++kb)
#pragma unroll
                for (int r = 0; r < 4; ++r) if (k0 + 16 * kb + 4 * g + r > qpos) s[c][kb][r] = -INFINITY;
    }
#pragma unroll
    for (int c = 0; c < 2; ++c) {
#pragma unroll
        for (int kb = 0; kb < 4; ++kb)
#pragma unroll
            for (int r = 0; r < 4; ++r) s[c][kb][r] = __builtin_amdgcn_exp2f(s[c][kb][r]);
#pragma unroll
        for (int tt = 0; tt < 2; ++tt) { u32x4 w; w.x = cvt_pk_bf16(s[c][2 * tt][0], s[c][2 * tt][1]); w.y = cvt_pk_bf16(s[c][2 * tt][2], s[c][2 * tt][3]);
            w.z = cvt_pk_bf16(s[c][2 * tt + 1][0], s[c][2 * tt + 1][1]); w.w = cvt_pk_bf16(s[c][2 * tt + 1][2], s[c][2 * tt + 1][3]); pf[c][tt] = __builtin_bit_cast(bf16x8, w); }
    }
}
__device__ __forceinline__ void attn_pv(const LAS char* Vb, int lane, const bf16x8 (&pf)[2][2], const bf16x8 onesf, f32x4 (&O)[2][8], f32x4 (&Oe)[2]) {
    bf16x8 va[8], vb[8];
#pragma unroll
    for (int nb = 0; nb < 8; ++nb) va[nb] = trfrag(Vb, APIT, 0, 16 * nb, lane);
#pragma unroll
    for (int nb = 0; nb < 8; ++nb) vb[nb] = trfrag(Vb, APIT, 32, 16 * nb, lane);
    __builtin_amdgcn_sched_barrier(0);
    Oe[0] = mfma16(onesf, pf[0][0], Oe[0]); Oe[1] = mfma16(onesf, pf[1][0], Oe[1]);
#pragma unroll
    for (int nb = 0; nb < 8; ++nb) { O[0][nb] = mfma16(va[nb], pf[0][0], O[0][nb]); O[1][nb] = mfma16(va[nb], pf[1][0], O[1][nb]); }
    Oe[0] = mfma16(onesf, pf[0][1], Oe[0]); Oe[1] = mfma16(onesf, pf[1][1], Oe[1]);
#pragma unroll
    for (int nb = 0; nb < 8; ++nb) { O[0][nb] = mfma16(vb[nb], pf[0][1], O[0][nb]); O[1][nb] = mfma16(vb[nb], pf[1][1], O[1][nb]); }
}
__device__ __forceinline__ void attn_step_fast(const LAS char* Kb, const LAS char* Vb, int lane, const bf16x8 (&qf)[2][2], const f32x4 negM, const bf16x8 onesf, f32x4 (&O)[2][8], f32x4 (&Oe)[2]) {
    f32x4 s0[4], s1[4];
    bf16x8 p0[2], p1[2];
    {
        bf16x8 kf[2][4][2];
#pragma unroll
        for (int c = 0; c < 2; ++c)
#pragma unroll
            for (int kb = 0; kb < 4; ++kb)
#pragma unroll
                for (int ks = 0; ks < 2; ++ks) kf[c][kb][ks] = rowfrag(Kb, APIT, 16 * kb, c * 64 + 32 * ks, lane);
        __builtin_amdgcn_sched_barrier(0);
#pragma unroll
        for (int kb = 0; kb < 4; ++kb) s0[kb] = mfma16(kf[0][kb][0], qf[0][0], negM);
#pragma unroll
        for (int kb = 0; kb < 4; ++kb) s0[kb] = mfma16(kf[0][kb][1], qf[0][1], s0[kb]);
        __builtin_amdgcn_sched_barrier(0);
#pragma unroll
        for (int kb = 0; kb < 4; ++kb) s1[kb] = mfma16(kf[1][kb][0], qf[1][0], negM);
#pragma unroll
        for (int kb = 0; kb < 4; ++kb) s1[kb] = mfma16(kf[1][kb][1], qf[1][1], s1[kb]);
    }
#define ATT_EXPPACK(S, P) do { \
        _Pragma("unroll") for (int kb = 0; kb < 4; ++kb) _Pragma("unroll") for (int r = 0; r < 4; ++r) S[kb][r] = __builtin_amdgcn_exp2f(S[kb][r]); \
        _Pragma("unroll") for (int tt = 0; tt < 2; ++tt) { u32x4 w; w.x = cvt_pk_bf16(S[2 * tt][0], S[2 * tt][1]); w.y = cvt_pk_bf16(S[2 * tt][2], S[2 * tt][3]); \
            w.z = cvt_pk_bf16(S[2 * tt + 1][0], S[2 * tt + 1][1]); w.w = cvt_pk_bf16(S[2 * tt + 1][2], S[2 * tt + 1][3]); P[tt] = __builtin_bit_cast(bf16x8, w); } } while (0)
    ATT_EXPPACK(s0, p0);
#pragma unroll
    for (int i = 0; i < 8; ++i) { __builtin_amdgcn_sched_group_barrier(0x008, 1, 0); __builtin_amdgcn_sched_group_barrier(0x002, 3, 0); }
    __builtin_amdgcn_sched_barrier(0);
    bf16x8 va[8], vb[8];
#pragma unroll
    for (int nb = 0; nb < 8; ++nb) va[nb] = trfrag(Vb, APIT, 0, 16 * nb, lane);
#pragma unroll
    for (int nb = 0; nb < 8; ++nb) vb[nb] = trfrag(Vb, APIT, 32, 16 * nb, lane);
    __builtin_amdgcn_sched_barrier(0);
    Oe[0] = mfma16(onesf, p0[0], Oe[0]);
#pragma unroll
    for (int nb = 0; nb < 8; ++nb) O[0][nb] = mfma16(va[nb], p0[0], O[0][nb]);
    Oe[0] = mfma16(onesf, p0[1], Oe[0]);
#pragma unroll
    for (int nb = 0; nb < 8; ++nb) O[0][nb] = mfma16(vb[nb], p0[1], O[0][nb]);
    ATT_EXPPACK(s1, p1);
#pragma unroll
    for (int i = 0; i < 18; ++i) { __builtin_amdgcn_sched_group_barrier(0x008, 1, 0); __builtin_amdgcn_sched_group_barrier(0x002, 2, 0); }
    __builtin_amdgcn_sched_barrier(0);
    Oe[1] = mfma16(onesf, p1[0], Oe[1]);
#pragma unroll
    for (int nb = 0; nb < 8; ++nb) O[1][nb] = mfma16(va[nb], p1[0], O[1][nb]);
    Oe[1] = mfma16(onesf, p1[1], Oe[1]);
#pragma unroll
    for (int nb = 0; nb < 8; ++nb) O[1][nb] = mfma16(vb[nb], p1[1], O[1][nb]);
#undef ATT_EXPPACK
}
__device__ __forceinline__ void attn_item(LAS char* lds, bf16_t* proj, int bl, int h, int qb, float lam, float oscale, const float* gdh, float smax) {
    const int tid = my_tid(), lane = tid & 63, wid = __builtin_amdgcn_readfirstlane(tid >> 6), g = lane >> 4, fr = lane & 15;
    const size_t rowbase = (size_t)bl * SEQ; const int q0 = qb * 128, qpos = q0 + 16 * wid + fr;
    bf16_t* qp = proj + SEC(C_AQ) + (rowbase + qpos) * PP + h * 128;
    bf16x8 qf[2][2];
#pragma unroll
    for (int c = 0; c < 2; ++c)
#pragma unroll
        for (int ks = 0; ks < 2; ++ks) qf[c][ks] = *(const bf16x8*)(qp + c * 64 + 32 * ks + 8 * g);
    f32x4 O[2][8], Oe[2];
#pragma unroll
    for (int c = 0; c < 2; ++c) { Oe[c] = (f32x4){0.f, 0.f, 0.f, 0.f};
#pragma unroll
        for (int nb = 0; nb < 8; ++nb) O[c][nb] = (f32x4){0.f, 0.f, 0.f, 0.f}; }
    const f32x4 negM = (f32x4){-smax, -smax, -smax, -smax};
    const short one16 = (fr == 0) ? (short)0x3F80 : (short)0;
    const bf16x8 onesf = (bf16x8){one16, one16, one16, one16, one16, one16, one16, one16};
    const int NT = 2 * (qb + 1);
    const int sr0 = tid >> 4, sc = tid & 15;
    const bf16_t* kg = proj + SEC(C_AK) + (rowbase + sr0) * PP + h * 128 + sc * 8;
    const bf16_t* vg = proj + SEC(C_AV) + (rowbase + sr0) * PP + h * 128 + sc * 8;
    const int soff = sr0 * APIT + sc * 16;
    u32x4 kr[2], vr[2];
#define ATT_LOAD(tile) do { _Pragma("unroll") for (int i = 0; i < 2; ++i) { kr[i] = *(const u32x4*)(kg + (size_t)(64 * (tile) + 32 * i) * PP); vr[i] = *(const u32x4*)(vg + (size_t)(64 * (tile) + 32 * i) * PP); } } while (0)
#define ATT_STORE(buf) do { LAS char* nb_ = lds + (buf) * ABUF; _Pragma("unroll") for (int i = 0; i < 2; ++i) { *(LAS u32x4*)(nb_ + soff + 32 * i * APIT) = kr[i]; *(LAS u32x4*)(nb_ + ATILE + soff + 32 * i * APIT) = vr[i]; } } while (0)
    ATT_LOAD(0); ATT_STORE(0);
    __syncthreads();
    const int qmaxw = q0 + 16 * wid + 15;
    int t = 0;
    for (; t < NT - 2; ++t) {
        ATT_LOAD(t + 1);
        const LAS char* Kb = lds + (t & 1) * ABUF;
#if ATT_FAST
        attn_step_fast(Kb, Kb + ATILE, lane, qf, negM, onesf, O, Oe);
#else
        { bf16x8 pq[2][2]; attn_qkexp(Kb, 64 * t, q0, wid, lane, g, qpos, qf, negM, pq); attn_pv(Kb + ATILE, lane, pq, onesf, O, Oe); }
#endif
        ATT_STORE((t + 1) & 1);
        BAR_LDS();
    }
    bf16x8 pf[2][2];
    for (; t < NT; ++t) {
        const int k0 = 64 * t;
        if (t + 1 < NT) ATT_LOAD(t + 1);
        if (k0 <= qmaxw) {
            const LAS char* Kb = lds + (t & 1) * ABUF;
            attn_qkexp(Kb, k0, q0, wid, lane, g, qpos, qf, negM, pf);
            attn_pv(Kb + ATILE, lane, pf, onesf, O, Oe);
        }
        if (t + 1 < NT) ATT_STORE((t + 1) & 1);
        BAR_LDS();
    }
#undef ATT_LOAD
#undef ATT_STORE
    const float l0 = __shfl(Oe[0][0], fr), l1 = __shfl(Oe[1][0], fr);
    const float r0 = 1.0f / l0, r1 = lam / l1;
    float ss = 0.f;
#pragma unroll
    for (int nb = 0; nb < 8; ++nb)
#pragma unroll
        for (int r = 0; r < 4; ++r) { const float o = O[0][nb][r] * r0 - O[1][nb][r] * r1; O[0][nb][r] = o; ss += o * o; }
    ss += __shfl_xor(ss, 16); ss += __shfl_xor(ss, 32);
    const float rstd = 1.0f / sqrtf(ss * (1.0f / 128.0f) + 1e-6f) * oscale;
    f32x4 ggv[8];
#pragma unroll
    for (int nb = 0; nb < 8; ++nb) ggv[nb] = *(const f32x4*)(gdh + 16 * nb + 4 * g);
#pragma unroll
    for (int nb = 0; nb < 8; ++nb) { const f32x4 gg = ggv[nb];
        u32x2 w; w.x = cvt_pk_bf16(O[0][nb][0] * rstd * gg.x, O[0][nb][1] * rstd * gg.y); w.y = cvt_pk_bf16(O[0][nb][2] * rstd * gg.z, O[0][nb][3] * rstd * gg.w);
        *(u32x2*)(qp + ((ptrdiff_t)SEC(C_PU) - (ptrdiff_t)SEC(C_AQ)) + 16 * nb + 4 * g) = w; }
}

#ifndef PH_ONLY
#define PH_ONLY -1
#endif
#define PHO(n) (PH_ONLY < 0 || PH_ONLY == (n))
#ifndef PROJ_ALIGN
#define PROJ_ALIGN true
#endif
#ifndef ATT_FAST
#define ATT_FAST 1
#endif
#ifndef DUP_K
#define DUP_K -1
#endif
__global__ void __launch_bounds__(NTHR, 2) fwd_kernel(Args a) {
    extern __shared__ __attribute__((aligned(16))) unsigned char lds_raw[];
    LAS unsigned char* lds = (LAS unsigned char*)lds_raw;
    cg::grid_group grid = cg::this_grid();
    unsigned char* ws = a.ws;
    bf16_t* proj = (bf16_t*)(ws + WS_PROJ);
    bf16_t* hn = (bf16_t*)(ws + WS_HN);
    bf16_t* Cst = (bf16_t*)(ws + WS_CST);
    float* gif = (float*)(ws + WS_GIF);
    float* gch = (float*)(ws + WS_MV); float* mloc = gch + 512; float* mprev = gch + 1024;
    float* nst = (float*)(ws + WS_NST);
    const int G = gridDim.x, bx = blockIdx.x;
    unsigned* barw = (unsigned*)ws;
    volatile LAS unsigned* bst = (volatile LAS unsigned*)(lds + LDS_BYTES - 64);
    if (threadIdx.x < 2) bst[threadIdx.x] = 0u;
    if (bx == 0) for (int i = threadIdx.x; i < XCD_BAR_WORDS; i += NTHR) barw[i] = 0u;
    __syncthreads();
    XcdBarrier xb; xb.bar = barw; xb.x = 0; xb.st = bst;
    bool xb_ready = false;
    for (int ph = a.ph_lo; ph < a.ph_hi; ++ph) {
        const int l = ph / 18, idx = ph % 18;
        const float* xsrc = (l == 0) ? a.in[0] : a.out;
        if (PHO(0) && idx == 0) {
            phase_weights(a, l, lds);
        } else if (idx <= 14) {
            const int grp = (idx - 1) / 7, k = (idx - 1) % 7;
            const size_t rowoff = (size_t)grp * TG;
            if (PHO(1) && k == 0) {
                for (int rep = 0; rep < (DUP_K == 0 ? 2 : 1); ++rep)
                phase_norm<true>(xsrc + rowoff * DM, a.in[1] + l * DM, hn, TG, a.in[2] + (size_t)l * DM * NIN, a.in[3] + l * 8, gif, lds);
            } else if (PHO(2) && k == 1) {
                pg8::Gemm gm{hn, (const bf16_t*)(ws + WS_WIN), TG, NP, DM, 64, 0, (size_t)TG * 64 * 2}; pg8::StaticOrder S; S.init(TG, NP, G, bx);
                pg8::EpiProj E{proj, PP, (size_t)TG * 1024};
                for (int rep = 0; rep < (DUP_K == 1 ? 2 : 1); ++rep)
                pg8::gemm_phase<pg8::EpiProj, pg8::StaticOrder, PROJ_ALIGN, true>(lds, gm, S, E);
            } else if (PHO(3) && k == 2) {
                const float* convw = a.in[4] + (size_t)l * 4 * 2048;
                for (int rep = 0; rep < (DUP_K == 2 ? 2 : 1); ++rep)
                m1_phase((LAS char*)lds, proj, gif, Cst, nst, gch, mloc, convw, bx, G);
                phase_qkprep(proj, a.in[8] + l * 128, (const float2*)(ws + WS_ROPE));
                phase_pool(proj, hn);
            } else if (PHO(4) && k == 3) {
                phase_scan(Cst, nst, gch, mloc, mprev);
                const float* lp = a.in[9] + l * 256;
                float s01 = 0.f, s23 = 0.f;
                for (int i = 0; i < 64; ++i) { s01 += lp[i] * lp[64 + i]; s23 += lp[128 + i] * lp[192 + i]; }
                float mgq = 0.f, mgk = 0.f; { const float* gq = a.in[8] + l * 128; for (int i = 0; i < 64; ++i) { mgq = fmaxf(mgq, fabsf(gq[i])); mgk = fmaxf(mgk, fabsf(gq[64 + i])); } }
                const float smax = 64.0f * mgq * mgk * (0.125f * 1.4426950408889634f) * 1.01f + 0.25f;
                const float lam_init = 0.8f - 0.6f * expf(-0.3f * (float)l);
                const float lam = expf(s01) - expf(s23) + lam_init;
                for (int rep = 0; rep < (DUP_K == 3 ? 2 : 1); ++rep)
                for (int i = bx; i < GB * 8 * 32; i += G) {
                    const int r = i >> 8, j = i & 255, x = j & 7, y = j >> 3, bh = x + 8 * r, qb = (r & 1) ? 31 - y : y;
                    attn_item((LAS char*)lds, proj, bh >> 3, bh & 7, qb, lam, 1.0f - lam_init, a.in[10] + l * 128, smax);
                }
            } else if (PHO(5) && k == 4) {
                const float* convw = a.in[4] + (size_t)l * 4 * 2048;
                for (int it = bx; it < NBH * 32; it += G) m3_item((LAS char*)lds, proj, gif, Cst, nst, mprev, convw, it >> 5, it & 31);
            } else if (PHO(6) && k == 5) {
#pragma unroll 1
                for (int brr = 0; brr < (DUP_K == 5 ? 6 : 3); ++brr) { const int br = brr % 3;
                    pg8::Gemm gm; gm.M = TG; gm.N = DM;
                    if (br == 0) { gm.A = proj + SEC(C_MO); gm.Bt = (const bf16_t*)(ws + WS_WMO); gm.K = DM; gm.lda = PP; gm.a_pn_off = 0; }
                    else if (br == 1) { gm.A = hn; gm.Bt = (const bf16_t*)(ws + WS_WPOOL); gm.K = 256; gm.lda = DM; gm.a_pn_off = 256; }
                    else { gm.A = proj + SEC(C_PU); gm.Bt = (const bf16_t*)(ws + WS_WDIFF); gm.K = DM; gm.lda = PP; gm.a_pn_off = 0; }
                    pg8::StaticOrder S; S.init(TG, DM, G, bx);
                    pg8::EpiMerge E{proj + SEC(C_MQ), proj + SEC(C_GT) + (size_t)br * ((size_t)TG * 1024), PP, br == 0 ? 1 : 0};
                    pg8::gemm_phase<pg8::EpiMerge, pg8::StaticOrder, true, true>(lds, gm, S, E);
                }
            } else if (PHO(7)) {
                pg8::Gemm gm{proj + SEC(C_MQ), (const bf16_t*)(ws + WS_WOUT), TG, DM, DM, PP, 0}; pg8::StaticOrder S; S.init(TG, DM, G, bx);
                pg8::EpiResid E{xsrc + rowoff * DM, a.out + rowoff * DM, DM};
                pg8::gemm_phase<pg8::EpiResid, pg8::StaticOrder, true, true>(lds, gm, S, E);
            }
        } else if (PHO(8) && idx == 15) {
            phase_norm<false>(a.out, a.in[13] + l * DM, hn, TT, nullptr, nullptr, nullptr, lds);
        } else if (PHO(9) && idx == 16) {
            pg8::Gemm gm{hn, (const bf16_t*)(ws + WS_WGU), TT, 2 * FF, DM, 64, 0, (size_t)TT * 64 * 2}; pg8::StaticOrder S; S.init(TT, 2 * FF, G, bx);
            pg8::EpiSwiGLU E{proj, (size_t)TT * 64};
            for (int rep = 0; rep < (DUP_K == 16 ? 2 : 1); ++rep)
            pg8::gemm_phase<pg8::EpiSwiGLU, pg8::StaticOrder, true, true>(lds, gm, S, E);
        } else if (PHO(10)) {
            pg8::Gemm gm{proj, (const bf16_t*)(ws + WS_WDN), TT, DM, FF, 64, 0, (size_t)TT * 64 * 2};   pg8::StaticOrder S; S.init(TT, DM, G, bx);
            pg8::EpiResid E{a.out, a.out, DM};
            pg8::gemm_phase<pg8::EpiResid, pg8::StaticOrder, true, true>(lds, gm, S, E);
        }
        if (ph + 1 < a.ph_hi) {
            if (!xb_ready) { grid.sync(); xb = xcd_barrier_post(barw, bst); xb_ready = true; }
            else { xcd_barrier(xb); if (DUP_K == 100) { xcd_barrier(xb); xcd_barrier(xb); } }
        }
    }
}

extern "C" void kernel_launch(void* const* d_in, const int* in_sizes, int n_in, void* d_out, int out_size, void* d_ws, size_t ws_size, hipStream_t stream) {
    static int grid = 0;
    if (grid == 0) {
        if (n_in != 16 || out_size != TT * DM || ws_size < WS_END) { fprintf(stderr, "kernel_launch: unexpected shapes / workspace (%d inputs, out %d, ws %zu)\n", n_in, out_size, ws_size); grid = -1; return; }
        int dev = 0, cus = 0, per_cu = 0;
        hipGetDevice(&dev); hipDeviceGetAttribute(&cus, hipDeviceAttributeMultiprocessorCount, dev);
        hipFuncSetAttribute((const void*)fwd_kernel, hipFuncAttributeMaxDynamicSharedMemorySize, LDS_BYTES);
        hipOccupancyMaxActiveBlocksPerMultiprocessor(&per_cu, (const void*)fwd_kernel, NTHR, LDS_BYTES);
        (void)hipGetLastError();
        if (per_cu < 1) per_cu = 1;
        grid = cus * 1;
        if (grid <= 0) grid = 256;
    }
    if (grid < 0) return;
    Args a{};
    for (int i = 0; i < 16; ++i) a.in[i] = (const float*)d_in[i];
    a.out = (float*)d_out; a.ws = (unsigned char*)d_ws; a.ph_lo = 0; a.ph_hi = 36;
    void* args[] = {&a};
    hipError_t e = hipLaunchCooperativeKernel((const void*)fwd_kernel, dim3(grid), dim3(NTHR), args, LDS_BYTES, stream);
    if (e != hipSuccess) fprintf(stderr, "cooperative launch failed: %s (grid %d)\n", hipGetErrorString(e), grid);
}
```

```cpp
#include <hip/hip_runtime.h>
#include <hip/hip_cooperative_groups.h>
#include <cstdio>
#include <cstdint>
namespace cg = cooperative_groups;
namespace pg8 {
#define PG8_LAS __attribute__((address_space(3)))
typedef unsigned short bf16_t;
typedef short bf16x8 __attribute__((ext_vector_type(8)));
typedef float f32x4 __attribute__((ext_vector_type(4)));
typedef unsigned u32x4 __attribute__((ext_vector_type(4)));
constexpr int BM = 256, BK = 64, HALF = 128, HTB = HALF * BK * 2  , STAGE_BYTES = 8 * HTB, NXCD = 8, WGM = 4;

__host__ __device__ __forceinline__ int lds_byte(int r, int c) { const int st = (r >> 4) * 2 + (c >> 5), rr = r & 15, cc = c & 31, ob = rr * 64 + cc * 2; return st * 1024 + (ob ^ (((ob >> 9) & 1) << 5)); }
__host__ __device__ __forceinline__ void stage_rc(int b, int& R, int& C) { const int st = b / 1024, sb = b % 1024, swz = sb ^ (((sb >> 9) & 1) << 5); R = (st >> 1) * 16 + swz / 64; C = (st & 1) * 32 + (swz % 64) / 2; }
__host__ __device__ __forceinline__ int perm32(int rho) { const int n = rho >> 4, i = rho & 15; return 8 * (i >> 2) + 4 * n + (i & 3); }

struct Unit { int pm, pn; };
struct Gemm { const bf16_t* A; const bf16_t* Bt; int M, N, K, lda, a_pn_off; size_t a_kstep = 0; };

struct StaticOrder {
    int nM, nN, nwg, G, c;
    __host__ __device__ void init(int M, int N, int G_, int c_) { nM = M / BM; nN = N / BM; nwg = nM * nN; G = G_; c = c_; }
    __host__ __device__ bool next(int i, Unit& u) const {
        const long L = (long)i * G + c; if (L >= nwg) return false;
        int wgid = (int)L; { const int q = nwg / NXCD, r = nwg % NXCD, xcd = wgid % NXCD, off = wgid / NXCD; wgid = (xcd < r ? xcd * (q + 1) : r * (q + 1) + (xcd - r) * q) + off; }
        const int nig = WGM * nN, gid = wgid / nig, fm = gid * WGM, gsz = (nM - fm) < WGM ? (nM - fm) : WGM;
        u.pm = fm + ((wgid % nig) % gsz); u.pn = (wgid % nig) / gsz; return true;
    }
    __device__ __forceinline__ void a_ready(const Unit&) const {}
    __device__ __forceinline__ void done(const Unit&) const {}
};

typedef float f32x2_t __attribute__((ext_vector_type(2))); typedef __bf16 bf16x2_t __attribute__((ext_vector_type(2)));
__device__ __forceinline__ unsigned cvt_pk_bf16(float lo, float hi) { const f32x2_t v = {lo, hi}; const bf16x2_t b = __builtin_convertvector(v, bf16x2_t); return __builtin_bit_cast(unsigned, b); }
__device__ __forceinline__ float fsigmoid(float x) { return __builtin_amdgcn_rcpf(1.0f + __expf(-x)); }
__device__ __forceinline__ float bflo(unsigned u) { return __uint_as_float(u << 16); }
__device__ __forceinline__ float bfhi(unsigned u) { return __uint_as_float(u & 0xffff0000u); }

struct EpiProj {
    static constexpr bool PERM = true, AFTER_DRAIN = false;
    bf16_t* O; int ldc; size_t sec_stride;
    __device__ __forceinline__ void operator()(const f32x4 (&acc)[2][2][4][2], const Unit& u, int wr, int wc, int fr, int fq) const {
        const bool sg = (u.pn >= 12 && u.pn < 16) || (u.pn >= 32);
        const int row0 = u.pm * BM + wr * 64 + fr, col0 = (u.pn & 3) * BM + wc * 32 + 8 * fq;
        bf16_t* const Os = O + (size_t)(u.pn >> 2) * sec_stride;
#pragma unroll
        for (int ai = 0; ai < 2; ++ai)
#pragma unroll
            for (int m = 0; m < 4; ++m) { bf16_t* rowp = Os + (size_t)(row0 + ai * HALF + m * 16) * ldc + col0;
#pragma unroll
                for (int bj = 0; bj < 2; ++bj) { f32x4 v0 = acc[ai][bj][m][0], v1 = acc[ai][bj][m][1];
                    if (sg) {
#pragma unroll
                        for (int i = 0; i < 4; ++i) { v0[i] = fsigmoid(v0[i]); v1[i] = fsigmoid(v1[i]); } }
                    u32x4 w; w.x = cvt_pk_bf16(v0[0], v0[1]); w.y = cvt_pk_bf16(v0[2], v0[3]); w.z = cvt_pk_bf16(v1[0], v1[1]); w.w = cvt_pk_bf16(v1[2], v1[3]);
                    *(u32x4*)(rowp + bj * HALF) = w; } }
    }
};
struct EpiMerge {
    static constexpr bool PERM = true, AFTER_DRAIN = false;
    bf16_t* O; const bf16_t* Gt; int ld; int first;
    __device__ __forceinline__ void operator()(const f32x4 (&acc)[2][2][4][2], const Unit& u, int wr, int wc, int fr, int fq) const {
        const int row0 = u.pm * BM + wr * 64 + fr, col0 = u.pn * BM + wc * 32 + 8 * fq;
#pragma unroll
        for (int ai = 0; ai < 2; ++ai) {
            u32x4 gv[4][2], pv[4][2];
#pragma unroll
            for (int m = 0; m < 4; ++m)
#pragma unroll
                for (int bj = 0; bj < 2; ++bj) { const size_t ro = (size_t)(row0 + ai * HALF + m * 16) * ld + col0 + bj * HALF;
                    gv[m][bj] = *(const u32x4*)(Gt + ro); pv[m][bj] = first ? (u32x4){0u, 0u, 0u, 0u} : *(const u32x4*)(O + ro); }
#pragma unroll
            for (int m = 0; m < 4; ++m)
#pragma unroll
                for (int bj = 0; bj < 2; ++bj) { const size_t ro = (size_t)(row0 + ai * HALF + m * 16) * ld + col0 + bj * HALF;
                    const f32x4 v0 = acc[ai][bj][m][0], v1 = acc[ai][bj][m][1]; const u32x4 g4 = gv[m][bj], p4 = pv[m][bj];
                    float o[8];
                    o[0] = v0[0] * bflo(g4.x) + bflo(p4.x); o[1] = v0[1] * bfhi(g4.x) + bfhi(p4.x); o[2] = v0[2] * bflo(g4.y) + bflo(p4.y); o[3] = v0[3] * bfhi(g4.y) + bfhi(p4.y);
                    o[4] = v1[0] * bflo(g4.z) + bflo(p4.z); o[5] = v1[1] * bfhi(g4.z) + bfhi(p4.z); o[6] = v1[2] * bflo(g4.w) + bflo(p4.w); o[7] = v1[3] * bfhi(g4.w) + bfhi(p4.w);
                    u32x4 w; w.x = cvt_pk_bf16(o[0], o[1]); w.y = cvt_pk_bf16(o[2], o[3]); w.z = cvt_pk_bf16(o[4], o[5]); w.w = cvt_pk_bf16(o[6], o[7]);
                    *(u32x4*)(O + ro) = w; }
        }
    }
};
struct EpiResid {
    static constexpr bool PERM = false, AFTER_DRAIN = false;
    const float* base; float* out; int ldc;
    __device__ __forceinline__ void operator()(const f32x4 (&acc)[2][2][4][2], const Unit& u, int wr, int wc, int fr, int fq) const {
        const int row0 = u.pm * BM + wr * 64 + fr, col0 = u.pn * BM + wc * 32 + 4 * fq;
#pragma unroll
        for (int ai = 0; ai < 2; ++ai) {
            f32x4 b[4][2][2];
#pragma unroll
            for (int m = 0; m < 4; ++m) { const size_t off = (size_t)(row0 + ai * HALF + m * 16) * ldc + col0;
#pragma unroll
                for (int bj = 0; bj < 2; ++bj)
#pragma unroll
                    for (int n = 0; n < 2; ++n) b[m][bj][n] = *(const f32x4*)(base + off + bj * HALF + n * 16); }
#pragma unroll
            for (int m = 0; m < 4; ++m) { const size_t off = (size_t)(row0 + ai * HALF + m * 16) * ldc + col0;
#pragma unroll
                for (int bj = 0; bj < 2; ++bj)
#pragma unroll
                    for (int n = 0; n < 2; ++n) *(f32x4*)(out + off + bj * HALF + n * 16) = b[m][bj][n] + acc[ai][bj][m][n]; }
        }
    }
};
struct EpiSwiGLU {
    static constexpr bool PERM = true, AFTER_DRAIN = false;
    bf16_t* O; size_t slab;
    __device__ __forceinline__ void operator()(const f32x4 (&acc)[2][2][4][2], const Unit& u, int wr, int wc, int fr, int fq) const {
        const int row0 = u.pm * BM + wr * 64 + fr;
        bf16_t* const Os = O + (size_t)(2 * u.pn + (wc >> 1)) * slab + (wc & 1) * 32 + 8 * fq;
#pragma unroll
        for (int ai = 0; ai < 2; ++ai)
#pragma unroll
            for (int m = 0; m < 4; ++m) { bf16_t* rowp = Os + (size_t)(row0 + ai * HALF + m * 16) * 64;
                float o[8];
#pragma unroll
                for (int n = 0; n < 2; ++n)
#pragma unroll
                    for (int i = 0; i < 4; ++i) { const float gt = acc[ai][0][m][n][i], up = acc[ai][1][m][n][i]; o[n * 4 + i] = gt * fsigmoid(gt) * up; }
                u32x4 w; w.x = cvt_pk_bf16(o[0], o[1]); w.y = cvt_pk_bf16(o[2], o[3]); w.z = cvt_pk_bf16(o[4], o[5]); w.w = cvt_pk_bf16(o[6], o[7]);
                *(u32x4*)rowp = w; }
    }
};
template <class Epi, class Sched, bool ALIGN_EPI = false, bool SP2 = false>
__device__ __forceinline__ void gemm_phase(PG8_LAS unsigned char* lds, const Gemm g, const Sched& S, const Epi& E) {
    int tid_ = threadIdx.x; asm volatile("" : "+v"(tid_)); const int tid = tid_, wid = __builtin_amdgcn_readfirstlane(tid >> 6), lane = tid & 63, wr = wid >> 2, wc = wid & 3, fr = lane & 15, fq = lane >> 4;
    const int K = g.K, nt = K / BK;
    unsigned voffA[2], voffB[2];
#pragma unroll
    for (int i = 0; i < 2; ++i) { int R, C; stage_rc(tid * 16 + i * 8192, R, C); const int Rb = Epi::PERM ? ((R & ~31) + perm32(R & 31)) : R;
        voffA[i] = (unsigned)(R * g.lda + C) * 2u; voffB[i] = (unsigned)(Rb * K + C) * 2u; }
    const size_t kstep = (size_t)(BK * 2), kstepA = g.a_kstep ? (size_t)g.a_kstep : (size_t)(BK * 2);
    const size_t hstepA = (size_t)HALF * g.lda * 2, hstepB = (size_t)HALF * K * 2;
    const size_t tstepA = 2 * hstepA, tstepB = 2 * hstepB, pnoffA = (size_t)g.a_pn_off * 2;
    const unsigned ldsw = (unsigned)wid * 1024u;
    const int aoff = lds_byte(wr * 64 + fr, fq * 8), boff = lds_byte(wc * 32 + fr, fq * 8);
#define PG8_SA(b, h) (((b) * 2 + (h)) * HTB)
#define PG8_SB(b, h) ((4 + (b) * 2 + (h)) * HTB)
#define PG8_STAGE(bufoff, gbase, voff) do { _Pragma("unroll") for (int _i = 0; _i < 2; ++_i) \
        __builtin_amdgcn_global_load_lds((const unsigned*)((const char*)(gbase) + (voff)[_i]), (PG8_LAS unsigned*)(lds + (bufoff) + ldsw + _i * 8192), 16, 0, 0); } while (0)
#define PG8_LDA(dst, b, h) do { _Pragma("unroll") for (int m = 0; m < 4; ++m) _Pragma("unroll") for (int k = 0; k < 2; ++k) dst[m][k] = *(const PG8_LAS bf16x8*)(lds + PG8_SA(b, h) + aoff + m * 2048 + k * 1024); } while (0)
#define PG8_LDB(dst, b, h) do { _Pragma("unroll") for (int n = 0; n < 2; ++n) _Pragma("unroll") for (int k = 0; k < 2; ++k) dst[n][k] = *(const PG8_LAS bf16x8*)(lds + PG8_SB(b, h) + boff + n * 2048 + k * 1024); } while (0)
#define PG8_MMA(ai, bj, At, Bt) do { __builtin_amdgcn_s_setprio(1); _Pragma("unroll") for (int m = 0; m < 4; ++m) _Pragma("unroll") for (int n = 0; n < 2; ++n) _Pragma("unroll") for (int k = 0; k < 2; ++k) \
        acc[ai][bj][m][n] = __builtin_amdgcn_mfma_f32_16x16x32_bf16(Bt[n][k], At[m][k], acc[ai][bj][m][n], 0, 0, 0); __builtin_amdgcn_s_setprio(0); } while (0)
#define PG8_WAIT_V(n) asm volatile("s_waitcnt vmcnt(" #n ")" ::: "memory")
#define PG8_WAIT_L(n) asm volatile("s_waitcnt lgkmcnt(" #n ")" ::: "memory")
#define PG8_BAR __builtin_amdgcn_s_barrier()
#define PG8_SCHED __builtin_amdgcn_sched_barrier(0)
    Unit cur, nxt; int ui = 0;
    if (!S.next(0, cur)) return;
    f32x4 acc[2][2][4][2];
#pragma unroll
    for (int a = 0; a < 2; ++a)
#pragma unroll
        for (int b = 0; b < 2; ++b)
#pragma unroll
            for (int m = 0; m < 4; ++m)
#pragma unroll
                for (int n = 0; n < 2; ++n) acc[a][b][m][n] = (f32x4){0.f, 0.f, 0.f, 0.f};
    bf16x8 At[4][2], B0[2][2], B1[2][2];
    const char* cA = (const char*)g.A + (size_t)cur.pm * tstepA + (size_t)cur.pn * pnoffA; const char* cB = (const char*)g.Bt + (size_t)cur.pn * tstepB;
    S.a_ready(cur);
    if constexpr (SP2) {
        PG8_STAGE(PG8_SB(0, 0), cB, voffB); PG8_STAGE(PG8_SB(0, 1), cB + hstepB, voffB); PG8_STAGE(PG8_SA(0, 0), cA, voffA); PG8_STAGE(PG8_SA(0, 1), cA + hstepA, voffA);
        if (wr == 1) PG8_BAR;
        PG8_WAIT_V(2); PG8_BAR;
        PG8_STAGE(PG8_SB(1, 0), cB + kstep, voffB); PG8_STAGE(PG8_SA(1, 0), cA + kstepA, voffA); PG8_STAGE(PG8_SB(1, 1), cB + hstepB + kstep, voffB);
        PG8_WAIT_V(6); PG8_BAR;
    } else {
        PG8_STAGE(PG8_SB(0, 0), cB, voffB); PG8_STAGE(PG8_SA(0, 0), cA, voffA); PG8_STAGE(PG8_SB(0, 1), cB + hstepB, voffB); PG8_STAGE(PG8_SA(0, 1), cA + hstepA, voffA);
        if (wr == 1) PG8_BAR;
        PG8_WAIT_V(4); PG8_BAR;
        PG8_STAGE(PG8_SB(1, 0), cB + kstep, voffB); PG8_STAGE(PG8_SA(1, 0), cA + kstepA, voffA); PG8_STAGE(PG8_SB(1, 1), cB + hstepB + kstep, voffB);
        PG8_WAIT_V(6); PG8_BAR;
    }
    for (;;) {
        const bool has_next = S.next(ui + 1, nxt);
        const char* nA = has_next ? (const char*)g.A + (size_t)nxt.pm * tstepA + (size_t)nxt.pn * pnoffA : cA; const char* nB = has_next ? (const char*)g.Bt + (size_t)nxt.pn * tstepB : cB;
        for (int t = 0; t < nt; t += 2) {
            const bool last = (t == nt - 2);
            const char* a1 = cA + (size_t)(t + 1) * kstepA;
            const char* a2 = last ? nA : cA + (size_t)(t + 2) * kstepA; const char* b2 = last ? nB : cB + (size_t)(t + 2) * kstep;
            const char* a3 = a2 + kstepA; const char* b3 = b2 + kstep;
            if (last && has_next) S.a_ready(nxt);
            if constexpr (SP2) {
            PG8_LDB(B0, 0, 0); PG8_LDB(B1, 0, 1); PG8_SCHED; PG8_LDA(At, 0, 0); PG8_STAGE(PG8_SA(1, 1), a1 + hstepA, voffA);
            PG8_WAIT_V(8); PG8_WAIT_L(0); PG8_BAR; PG8_MMA(0, 0, At, B0); PG8_MMA(0, 1, At, B1); PG8_BAR; PG8_SCHED;
            PG8_LDA(At, 0, 1); PG8_STAGE(PG8_SB(0, 0), b2, voffB); PG8_STAGE(PG8_SB(0, 1), b2 + hstepB, voffB); PG8_STAGE(PG8_SA(0, 0), a2, voffA);
            PG8_WAIT_V(8); PG8_WAIT_L(0); PG8_BAR; PG8_MMA(1, 0, At, B0); PG8_MMA(1, 1, At, B1); PG8_BAR; PG8_SCHED;
            PG8_LDB(B0, 1, 0); PG8_LDB(B1, 1, 1); PG8_SCHED; PG8_LDA(At, 1, 0); PG8_STAGE(PG8_SA(0, 1), a2 + hstepA, voffA);
            PG8_WAIT_V(8); PG8_WAIT_L(0); PG8_BAR; PG8_MMA(0, 0, At, B0); PG8_MMA(0, 1, At, B1); PG8_BAR; PG8_SCHED;
            PG8_LDA(At, 1, 1); PG8_STAGE(PG8_SB(1, 0), b3, voffB); PG8_STAGE(PG8_SB(1, 1), b3 + hstepB, voffB); PG8_STAGE(PG8_SA(1, 0), a3, voffA);
            PG8_WAIT_V(8); PG8_WAIT_L(0); PG8_BAR; PG8_MMA(1, 0, At, B0); PG8_MMA(1, 1, At, B1); PG8_BAR; PG8_SCHED;
            } else {
            PG8_LDB(B0, 0, 0); PG8_SCHED; PG8_LDA(At, 0, 0); PG8_STAGE(PG8_SA(1, 1), a1 + hstepA, voffA);
            PG8_WAIT_L(8); PG8_BAR; PG8_WAIT_L(0); PG8_MMA(0, 0, At, B0); PG8_BAR; PG8_SCHED;
            PG8_LDB(B1, 0, 1); PG8_STAGE(PG8_SB(0, 0), b2, voffB);
            PG8_BAR; PG8_WAIT_L(0); PG8_MMA(0, 1, At, B1); PG8_BAR;
            PG8_LDA(At, 0, 1); PG8_STAGE(PG8_SA(0, 0), a2, voffA);
            PG8_BAR; PG8_WAIT_L(0); PG8_MMA(1, 0, At, B0); PG8_BAR; PG8_SCHED;
            PG8_STAGE(PG8_SB(0, 1), b2 + hstepB, voffB);
            PG8_WAIT_V(6); PG8_BAR; PG8_MMA(1, 1, At, B1); PG8_BAR;
            PG8_LDB(B0, 1, 0); PG8_SCHED; PG8_LDA(At, 1, 0); PG8_STAGE(PG8_SA(0, 1), a2 + hstepA, voffA);
            PG8_WAIT_L(8); PG8_BAR; PG8_WAIT_L(0); PG8_MMA(0, 0, At, B0); PG8_BAR; PG8_SCHED;
            PG8_LDB(B1, 1, 1); PG8_STAGE(PG8_SB(1, 0), b3, voffB);
            PG8_BAR; PG8_WAIT_L(0); PG8_MMA(0, 1, At, B1); PG8_BAR;
            PG8_LDA(At, 1, 1); PG8_STAGE(PG8_SA(1, 0), a3, voffA);
            PG8_BAR; PG8_WAIT_L(0); PG8_MMA(1, 0, At, B0); PG8_BAR; PG8_SCHED;
            PG8_STAGE(PG8_SB(1, 1), b3 + hstepB, voffB);
            PG8_WAIT_V(6); PG8_BAR; PG8_MMA(1, 1, At, B1); PG8_BAR;
            }
        }
        if constexpr (ALIGN_EPI) { if (wr == 0) PG8_BAR; }
        if constexpr (!Epi::AFTER_DRAIN) { E(acc, cur, wr, wc, fr, fq); S.done(cur); }
        if (!has_next) break;
#pragma unroll
        for (int a = 0; a < 2; ++a)
#pragma unroll
            for (int b = 0; b < 2; ++b)
#pragma unroll
                for (int m = 0; m < 4; ++m)
#pragma unroll
                    for (int n = 0; n < 2; ++n) acc[a][b][m][n] = (f32x4){0.f, 0.f, 0.f, 0.f};
        cur = nxt; cA = nA; cB = nB; ++ui;
        if constexpr (ALIGN_EPI) { if (wr == 1) PG8_BAR; }
    }
    PG8_WAIT_V(0);
    if constexpr (!ALIGN_EPI) { if (wr == 0) PG8_BAR; }
    PG8_BAR;
    if constexpr (Epi::AFTER_DRAIN) { E.fused(acc, cur, wr, wc, fr, fq, lds, wid, lane); S.done(cur); }
#undef PG8_SA
#undef PG8_SB
#undef PG8_STAGE
#undef PG8_LDA
#undef PG8_LDB
#undef PG8_MMA
#undef PG8_WAIT_V
#undef PG8_WAIT_L
#undef PG8_BAR
#undef PG8_SCHED
}
}

#define LAS __attribute__((address_space(3)))
typedef unsigned short bf16_t;
typedef short bf16x8 __attribute__((ext_vector_type(8)));
typedef short s16x4 __attribute__((ext_vector_type(4)));
typedef float f32x4 __attribute__((ext_vector_type(4)));
typedef unsigned u32x4 __attribute__((ext_vector_type(4)));
typedef unsigned u32x2 __attribute__((ext_vector_type(2)));
using pg8::cvt_pk_bf16; using pg8::bflo; using pg8::bfhi; using pg8::fsigmoid;

constexpr int DM = 1024, NBATCH = 8, SEQ = 4096, TT = NBATCH * SEQ, NIN = 11272, NP = 11264, FF = 2816;
constexpr int GB = 4, TG = GB * SEQ, NGRP = NBATCH / GB;
constexpr int NBH = GB * 4;
constexpr int LDS_BYTES = 147456;
constexpr int NTHR = 512;
constexpr int PP = 1024;
#define SEC(C) ((size_t)((C) / 1024) * ((size_t)TG * 1024) + (size_t)((C) % 1024))
constexpr int C_MQ = 0, C_MK = 1024, C_MV = 2048, C_MO = 3072, C_PU = 4096, C_AQ = 5120, C_AK = 6144, C_AV = 7168, C_GT = 8192;
constexpr size_t MiB = 1u << 20;
constexpr size_t WS_ROPE = 1 * MiB;
constexpr size_t WS_WIN = 2 * MiB, WS_WMO = 24 * MiB, WS_WPOOL = 26 * MiB, WS_WDIFF = 27 * MiB, WS_WOUT = 29 * MiB, WS_WGU = 31 * MiB, WS_WDN = 42 * MiB;
constexpr size_t WS_GIF = 48 * MiB;
constexpr size_t WS_MV = 48 * MiB + 512 * 1024;
constexpr size_t WS_NST = 49 * MiB;
constexpr size_t WS_HN = 50 * MiB;
constexpr size_t WS_CST = 82 * MiB;
constexpr size_t WS_PROJ = 146 * MiB;
constexpr size_t WS_END = 498 * MiB;

__device__ __forceinline__ int my_tid() { int t = threadIdx.x; asm volatile("" : "+v"(t)); return t; }
__device__ __forceinline__ float wave_sum(float v) {
#pragma unroll
    for (int o = 1; o < 64; o <<= 1) v += __shfl_xor(v, o);
    return v;
}
__device__ __forceinline__ float wave_max(float v) {
#pragma unroll
    for (int o = 1; o < 64; o <<= 1) v = fmaxf(v, __shfl_xor(v, o));
    return v;
}
typedef short v4i16_t __attribute__((ext_vector_type(4)));
__device__ __forceinline__ s16x4 vtr(const LAS char* p) { return __builtin_bit_cast(s16x4, __builtin_amdgcn_ds_read_tr16_b64_v4i16((LAS v4i16_t*)p)); }
__device__ __forceinline__ bf16x8 trfrag(const LAS char* base, int pitch, int k0, int n0, int lane) {
    const int g = lane >> 4, q = (lane & 15) >> 2, p = lane & 3;
    const LAS char* a = base + (k0 + 4 * g + q) * pitch + (n0 + 4 * p) * 2;
    const s16x4 lo = vtr(a), hi = vtr(a + 16 * pitch);
    return (bf16x8){lo[0], lo[1], lo[2], lo[3], hi[0], hi[1], hi[2], hi[3]};
}
__device__ __forceinline__ bf16x8 rowfrag(const LAS char* base, int pitch, int r0, int c0, int lane) {
    return *(const LAS bf16x8*)(base + (r0 + (lane & 15)) * pitch + (c0 + 8 * (lane >> 4)) * 2);
}
__device__ __forceinline__ bf16x8 rowfrag_perm(const LAS char* base, int pitch, int r0, int c0, int lane) {
    const LAS char* a = base + (r0 + (lane & 15)) * pitch + (c0 + 4 * (lane >> 4)) * 2;
    const s16x4 lo = *(const LAS s16x4*)a, hi = *(const LAS s16x4*)(a + 32);
    return (bf16x8){lo[0], lo[1], lo[2], lo[3], hi[0], hi[1], hi[2], hi[3]};
}
__device__ __forceinline__ f32x4 mfma16(bf16x8 a, bf16x8 b, f32x4 c) { return __builtin_amdgcn_mfma_f32_16x16x32_bf16(a, b, c, 0, 0, 0); }
__device__ __forceinline__ void unpack8(const u32x4 v, float (&f)[8]) {
    f[0] = bflo(v.x); f[1] = bfhi(v.x); f[2] = bflo(v.y); f[3] = bfhi(v.y); f[4] = bflo(v.z); f[5] = bfhi(v.z); f[6] = bflo(v.w); f[7] = bfhi(v.w);
}
__device__ __forceinline__ u32x4 pack8(const float (&f)[8]) {
    u32x4 w; w.x = cvt_pk_bf16(f[0], f[1]); w.y = cvt_pk_bf16(f[2], f[3]); w.z = cvt_pk_bf16(f[4], f[5]); w.w = cvt_pk_bf16(f[6], f[7]); return w;
}
#define LDS_WAIT() asm volatile("s_waitcnt lgkmcnt(0)" ::: "memory")
#define BAR_LDS() do { asm volatile("s_waitcnt lgkmcnt(0)" ::: "memory"); __builtin_amdgcn_s_barrier(); asm volatile("" ::: "memory"); } while (0)

struct Args { const float* in[16]; float* out; unsigned char* ws; int ph_lo, ph_hi; };
#define XB_TMO      128
#define XB_XCNT(j)  (256  + 64 * (j))
#define XB_XSUB(j)  (1280 + 64 * (j))
#define XB_XGEN(j)  (2304 + 64 * (j))
#define XB_TOP      3328
#define XB_TOPGEN   3392
#define XCD_BAR_WORDS 3456
#define XB_SPIN_CAP (1u << 18)

__device__ __forceinline__ unsigned xb_ld(unsigned* p)              { return __hip_atomic_load(p, __ATOMIC_RELAXED, __HIP_MEMORY_SCOPE_AGENT); }
__device__ __forceinline__ unsigned xb_add(unsigned* p, unsigned v) { return __hip_atomic_fetch_add(p, v, __ATOMIC_RELAXED, __HIP_MEMORY_SCOPE_AGENT); }
__device__ __forceinline__ unsigned xb_xcc_id() { return (unsigned)__builtin_amdgcn_s_getreg((3 << 11) | 20) & 0xFu; }
#define XB_SPIN(cond, bar) do { unsigned _sp = 0; while (cond) { __builtin_amdgcn_s_sleep(1); \
    if ((++_sp & 255u) == 0u) { if (xb_ld(&(bar)[XB_TMO])) break; if (_sp > XB_SPIN_CAP) { atomicAdd(&(bar)[XB_TMO], 1u); break; } } } } while (0)

struct XcdBarrier {
    unsigned* bar; unsigned x;
    volatile LAS unsigned* st;
};

__device__ __forceinline__ XcdBarrier xcd_barrier_post(unsigned* bar, volatile LAS unsigned* st) {
    XcdBarrier b; b.bar = bar; b.x = xb_xcc_id(); b.st = st;
    if (threadIdx.x == 0) (void)xb_add(&bar[XB_XCNT(b.x)], 1u);
    return b;
}
__device__ __forceinline__ void xcd_barrier_complete(unsigned* bar, unsigned x, unsigned& nloc, unsigned& nx) {
    const unsigned G = gridDim.x * gridDim.y * gridDim.z;
    unsigned sum, cnt, mine, sp = 0u;
    for (;;) {
        sum = 0u; cnt = 0u; mine = 0u;
#pragma unroll
        for (unsigned j = 0; j < 16; ++j) { const unsigned c = xb_ld(&bar[XB_XCNT(j)]); sum += c; cnt += (c > 0u) ? 1u : 0u; mine = (j == x) ? c : mine; }
        if (sum == G) break;
        __builtin_amdgcn_s_sleep(1);
        if ((++sp & 255u) == 0u) { if (xb_ld(&bar[XB_TMO])) break; if (sp > XB_SPIN_CAP) { atomicAdd(&bar[XB_TMO], 1u); break; } }
    }
    nloc = mine > 0u ? mine : 1u; nx = cnt > 0u ? cnt : 1u;
}

__device__ __forceinline__ void xcd_barrier(const XcdBarrier& b) {
    asm volatile("s_waitcnt vmcnt(0)" ::: "memory");
    __syncthreads();
    if (threadIdx.x == 0) {
        unsigned* bar = b.bar;
        __builtin_amdgcn_s_waitcnt(0);
        unsigned nloc = b.st[0], nx = b.st[1];
        if (nloc == 0u) { xcd_barrier_complete(bar, b.x, nloc, nx); b.st[0] = nloc; b.st[1] = nx; }
        const unsigned old = xb_add(&bar[XB_XSUB(b.x)], 1u);
        const unsigned gen = old / nloc;
        if (old + 1u == (gen + 1u) * nloc) {
            __builtin_amdgcn_fence(__ATOMIC_RELEASE, "agent");
            asm volatile("s_waitcnt vmcnt(0)" ::: "memory");
            const unsigned og = xb_add(&bar[XB_TOP], 1u);
            const unsigned tg = og / nx;
            if (og + 1u == (tg + 1u) * nx) xb_add(&bar[XB_TOPGEN], 1u);
            else XB_SPIN(xb_ld(&bar[XB_TOPGEN]) == tg, bar);
            __builtin_amdgcn_fence(__ATOMIC_ACQUIRE, "agent");
            xb_add(&bar[XB_XGEN(b.x)], 1u);
            asm volatile("s_waitcnt vmcnt(0)" ::: "memory");
        } else {
            XB_SPIN(xb_ld(&bar[XB_XGEN(b.x)]) == gen, bar);
            __builtin_amdgcn_fence(__ATOMIC_ACQUIRE, "agent");
            asm volatile("s_waitcnt vmcnt(0)" ::: "memory");
        }
    }
    __syncthreads();
}


__device__ __forceinline__ void cvt_item(const float* W, int ldw, int k0, int srccol0, bf16_t* WT, int K, int dstrow0, const float* rowscale, LAS float* scr, int lane) {
#pragma unroll 8
    for (int i = 0; i < 32; ++i) { const int kk = 2 * i + (lane >> 5); scr[kk * 33 + (lane & 31)] = W[(size_t)(k0 + kk) * ldw + srccol0 + (lane & 31)]; }
    LDS_WAIT();
    const int c = lane & 7;
#pragma unroll
    for (int j = 0; j < 4; ++j) { const int n = (lane >> 3) + 8 * j; const LAS float* s = scr + (8 * c) * 33 + n;
        const float sc = rowscale ? rowscale[n] : 1.0f;
        u32x4 o; o.x = cvt_pk_bf16(s[0 * 33] * sc, s[1 * 33] * sc); o.y = cvt_pk_bf16(s[2 * 33] * sc, s[3 * 33] * sc); o.z = cvt_pk_bf16(s[4 * 33] * sc, s[5 * 33] * sc); o.w = cvt_pk_bf16(s[6 * 33] * sc, s[7 * 33] * sc);
        *(u32x4*)(WT + (size_t)(dstrow0 + n) * K + k0 + 8 * c) = o; }
    LDS_WAIT();
}
__device__ __forceinline__ void phase_weights(const Args& a, int l, LAS unsigned char* lds) {
    const int tid = my_tid(), lane = tid & 63, wave = tid >> 6;
    LAS float* scr = (LAS float*)(lds + wave * 8704);
    const int gw = blockIdx.x * 8 + wave, NGW = gridDim.x * 8;
    unsigned char* ws = a.ws;
    const float* w_in = a.in[2] + (size_t)l * DM * NIN;
    const float* w_mo = a.in[5] + (size_t)l * DM * DM;
    const float* w_pool = a.in[6] + (size_t)l * 4 * 256 * 256;
    const float* pscale = a.in[7] + (size_t)l * DM;
    const float* w_diff = a.in[11] + (size_t)l * DM * DM;
    const float* w_out = a.in[12] + (size_t)l * DM * DM;
    const float* w_gu = a.in[14] + (size_t)l * DM * 2 * FF;
    const float* w_dn = a.in[15] + (size_t)l * FF * DM;
    constexpr int I0 = 16 * (NP / 32), I1 = 16 * 32, I2 = 4 * 4 * 8, I3 = I1, I4 = I1, I5 = 16 * (2 * FF / 32), I6 = (FF / 64) * 32;
    constexpr int NIT = I0 + I1 + I2 + I3 + I4 + I5 + I6;
    for (int it = gw; it < NIT; it += NGW) {
        int r = it;
        if (r < I0) { const int nb = r % (NP / 32), kb = r / (NP / 32), n0 = nb * 32; cvt_item(w_in, NIN, kb * 64, n0 < 4096 ? n0 : n0 + 8, (bf16_t*)(ws + WS_WIN), DM, n0, nullptr, scr, lane); continue; } r -= I0;
        if (r < I1) { const int nb = r % 32, kb = r / 32; cvt_item(w_mo, DM, kb * 64, nb * 32, (bf16_t*)(ws + WS_WMO), DM, nb * 32, nullptr, scr, lane); continue; } r -= I1;
        if (r < I2) { const int g = r / 32, q = r % 32, nb = q % 8, kb = q / 8; cvt_item(w_pool + g * 65536, 256, kb * 64, nb * 32, (bf16_t*)(ws + WS_WPOOL), 256, g * 256 + nb * 32, pscale + g * 256 + nb * 32, scr, lane); continue; } r -= I2;
        if (r < I3) { const int nb = r % 32, kb = r / 32; cvt_item(w_diff, DM, kb * 64, nb * 32, (bf16_t*)(ws + WS_WDIFF), DM, nb * 32, nullptr, scr, lane); continue; } r -= I3;
        if (r < I4) { const int nb = r % 32, kb = r / 32; cvt_item(w_out, DM, kb * 64, nb * 32, (bf16_t*)(ws + WS_WOUT), DM, nb * 32, nullptr, scr, lane); continue; } r -= I4;
        if (r < I5) { const int nb = r % (2 * FF / 32), kb = r / (2 * FF / 32), n0 = nb * 32, pn = n0 >> 8, wi = n0 & 255;
            const int sc0 = wi < 128 ? 128 * pn + wi : FF + 128 * pn + (wi - 128);
            cvt_item(w_gu, 2 * FF, kb * 64, sc0, (bf16_t*)(ws + WS_WGU), DM, n0, nullptr, scr, lane); continue; } r -= I5;
        { const int nb = r % 32, kb = r / 32; cvt_item(w_dn, DM, kb * 64, nb * 32, (bf16_t*)(ws + WS_WDN), FF, nb * 32, nullptr, scr, lane); }
    }
    if (l == 0) {
        float2* tab = (float2*)(ws + WS_ROPE);
        for (int e = blockIdx.x * NTHR + tid; e < SEQ * 32; e += gridDim.x * NTHR) {
            const int pos = e >> 5, i = e & 31;
            double inv = 1.0; const double rr = 0.74989420933245582730;
            for (int j = 0; j < i; ++j) inv *= rr;
            const double t2 = inv * inv; double cs = 1.0, sn = inv, tc = 1.0, tsn = inv;
#pragma unroll
            for (int n = 1; n <= 12; ++n) { tc *= -t2 / (double)((2 * n - 1) * (2 * n)); cs += tc; tsn *= -t2 / (double)((2 * n) * (2 * n + 1)); sn += tsn; }
            double zr = 1.0, zi = 0.0, br = cs, bi = sn;
            for (int b = 0; b < 12; ++b) { if ((pos >> b) & 1) { const double nr = zr * br - zi * bi, ni = zr * bi + zi * br; zr = nr; zi = ni; } const double sr = br * br - bi * bi, si = 2.0 * br * bi; br = sr; bi = si; }
            tab[e] = make_float2((float)zr, (float)zi);
        }
    }
}

template <bool GATES>
__device__ __forceinline__ void phase_norm(const float* x, const float* gain, bf16_t* hn, int nrows, const float* w_in_l, const float* bif, float* gif, LAS unsigned char* lds) {
    const int tid = my_tid(), lane = tid & 63, wave = tid >> 6;
    LAS float* wif = (LAS float*)lds;
    f32x4 wr[GATES ? 8 : 1][4];
    if (GATES) {
        for (int i = 0; i < 16; ++i) { const int idx = tid + NTHR * i, k = idx >> 3, e = idx & 7; wif[e * 1024 + k] = w_in_l[(size_t)k * NIN + 4096 + e]; }
        __syncthreads();
#pragma unroll
        for (int e = 0; e < 8; ++e)
#pragma unroll
            for (int j = 0; j < 4; ++j) wr[e][j] = *(const LAS f32x4*)(wif + e * 1024 + 4 * lane + 256 * j);
    }
    const int gw = blockIdx.x * 8 + wave, NGW = gridDim.x * 8;
    f32x4 gv[4];
#pragma unroll
    for (int j = 0; j < 4; ++j) gv[j] = *(const f32x4*)(gain + 4 * lane + 256 * j);
    f32x4 v[4], nx[4];
    if (gw < nrows) { const f32x4* xr = (const f32x4*)(x + (size_t)gw * DM) + lane;
#pragma unroll
        for (int j = 0; j < 4; ++j) nx[j] = xr[64 * j]; }
    for (int row = gw; row < nrows; row += NGW) {
        float ss = 0.f;
#pragma unroll
        for (int j = 0; j < 4; ++j) v[j] = nx[j];
        if (row + NGW < nrows) { const f32x4* xr = (const f32x4*)(x + (size_t)(row + NGW) * DM) + lane;
#pragma unroll
            for (int j = 0; j < 4; ++j) nx[j] = xr[64 * j]; }
#pragma unroll
        for (int j = 0; j < 4; ++j) ss += (v[j].x * v[j].x + v[j].y * v[j].y) + (v[j].z * v[j].z + v[j].w * v[j].w);
        const float rstd = 1.0f / sqrtf(wave_sum(ss) * (1.0f / DM) + 1e-6f);
        bf16_t* o8 = hn + (size_t)(lane >> 4) * ((size_t)nrows * 64) + (size_t)row * 64 + 4 * (lane & 15);
#pragma unroll
        for (int j = 0; j < 4; ++j) { v[j] = v[j] * rstd * gv[j]; u32x2 w; w.x = cvt_pk_bf16(v[j].x, v[j].y); w.y = cvt_pk_bf16(v[j].z, v[j].w); *(u32x2*)(o8 + (size_t)(4 * j) * ((size_t)nrows * 64)) = w; }
        if (GATES) {
            float ga[8];
#pragma unroll
            for (int e = 0; e < 8; ++e) { float s = 0.f;
#pragma unroll
                for (int j = 0; j < 4; ++j) { const f32x4 w = wr[e][j]; s += (v[j].x * w.x + v[j].y * w.y) + (v[j].z * w.z + v[j].w * w.w); }
                ga[e] = s; }
            float h4[4], h2[2], h1;
            { const bool up = (lane & 32) != 0;
#pragma unroll
              for (int i = 0; i < 4; ++i) { const float mine = up ? ga[4 + i] : ga[i], other = up ? ga[i] : ga[4 + i]; h4[i] = mine + __shfl_xor(other, 32); } }
            { const bool up = (lane & 16) != 0;
#pragma unroll
              for (int i = 0; i < 2; ++i) { const float mine = up ? h4[2 + i] : h4[i], other = up ? h4[i] : h4[2 + i]; h2[i] = mine + __shfl_xor(other, 16); } }
            { const bool up = (lane & 8) != 0; const float mine = up ? h2[1] : h2[0], other = up ? h2[0] : h2[1]; h1 = mine + __shfl_xor(other, 8); }
            h1 += __shfl_xor(h1, 4); h1 += __shfl_xor(h1, 2); h1 += __shfl_xor(h1, 1);
            if ((lane & 7) == 0) {
                const int e = 4 * (lane >> 5) + 2 * ((lane >> 4) & 1) + ((lane >> 3) & 1);
                const float pre = h1 + bif[e];
                gif[(size_t)row * 8 + e] = (e < 4) ? pre : (fminf(pre, 0.f) - log1pf(__expf(-fabsf(pre))));
            }
        }
    }
    __syncthreads();
}

constexpr int PIT = 544;
constexpr int XOFF = 0, YOFF = 128 * PIT, VECOFF = 2 * 128 * PIT;
__device__ __forceinline__ void load_plain(LAS char* dst, const bf16_t* src, size_t gpitch, int tid) {
#pragma unroll
    for (int i = 0; i < 8; ++i) { const int id = tid + NTHR * i, row = id >> 5, cc = id & 31;
        const u32x4 v = *(const u32x4*)(src + (size_t)row * gpitch + cc * 8);
        *(LAS u32x4*)(dst + row * PIT + cc * 16) = v; }
}
__device__ __forceinline__ void load_plain_issue(u32x4 (&pre)[8], const bf16_t* src, size_t gpitch, int tid) {
#pragma unroll
    for (int i = 0; i < 8; ++i) { const int id = tid + NTHR * i, row = id >> 5, cc = id & 31; pre[i] = *(const u32x4*)(src + (size_t)row * gpitch + cc * 8); }
}
__device__ __forceinline__ void load_plain_commit(LAS char* dst, const u32x4 (&pre)[8], int tid) {
#pragma unroll
    for (int i = 0; i < 8; ++i) { const int id = tid + NTHR * i, row = id >> 5, cc = id & 31; *(LAS u32x4*)(dst + row * PIT + cc * 16) = pre[i]; }
}
__device__ __forceinline__ void load_conv(LAS char* dst, const bf16_t* src, int pos0, const float* cw  , const LAS float* rowscale, float cscale, int tid) {
    const int cg = tid & 31, rs = tid >> 5, r0 = rs * 8;
    u32x4 rw[11];
#pragma unroll
    for (int j = 0; j < 11; ++j) { const int rr = r0 - 3 + j;
        if (j >= 3 || pos0 + rr >= 0) rw[j] = *(const u32x4*)(src + (ptrdiff_t)rr * PP + cg * 8); else rw[j] = (u32x4){0u, 0u, 0u, 0u}; }
    float w[4][8];
#pragma unroll
    for (int j = 0; j < 4; ++j) { const f32x4 a = *(const f32x4*)(cw + j * 2048 + cg * 8), b = *(const f32x4*)(cw + j * 2048 + cg * 8 + 4);
        w[j][0] = a.x; w[j][1] = a.y; w[j][2] = a.z; w[j][3] = a.w; w[j][4] = b.x; w[j][5] = b.y; w[j][6] = b.z; w[j][7] = b.w; }
    float sc8[8];
#pragma unroll
    for (int r = 0; r < 8; ++r) sc8[r] = rowscale ? rowscale[r0 + r] : cscale;
    float u[3][8];
#pragma unroll
    for (int j = 0; j < 3; ++j) unpack8(rw[j], u[j]);
#pragma unroll
    for (int r = 0; r < 8; ++r) {
        float x[8]; unpack8(rw[3 + r], x);
        const float sc = sc8[r];
        float o[8];
#pragma unroll
        for (int e = 0; e < 8; ++e) { const float cv = (w[0][e] * u[0][e] + w[1][e] * u[1][e]) + (w[2][e] * u[2][e] + w[3][e] * x[e]); o[e] = cv * fsigmoid(cv) * sc;
            u[0][e] = u[1][e]; u[1][e] = u[2][e]; u[2][e] = x[e]; }
        *(LAS u32x4*)(dst + (r0 + r) * PIT + cg * 16) = pack8(o);
    }
}
__device__ __forceinline__ void load_conv_issue(u32x4 (&rw)[11], const bf16_t* src, int pos0, int tid) {
    const int cg = tid & 31, r0 = (tid >> 5) * 8;
#pragma unroll
    for (int j = 0; j < 11; ++j) { const int rr = r0 - 3 + j;
        if (j >= 3 || pos0 + rr >= 0) rw[j] = *(const u32x4*)(src + (ptrdiff_t)rr * PP + cg * 8); else rw[j] = (u32x4){0u, 0u, 0u, 0u}; }
}
__device__ __forceinline__ void load_conv_finish(LAS char* dst, const u32x4 (&rw)[11], const float* cw, const LAS float* rowscale, float cscale, int tid) {
    const int cg = tid & 31, r0 = (tid >> 5) * 8;
    float w[4][8];
#pragma unroll
    for (int j = 0; j < 4; ++j) { const f32x4 a = *(const f32x4*)(cw + j * 2048 + cg * 8), b = *(const f32x4*)(cw + j * 2048 + cg * 8 + 4);
        w[j][0] = a.x; w[j][1] = a.y; w[j][2] = a.z; w[j][3] = a.w; w[j][4] = b.x; w[j][5] = b.y; w[j][6] = b.z; w[j][7] = b.w; }
    float sc8[8];
#pragma unroll
    for (int r = 0; r < 8; ++r) sc8[r] = rowscale ? rowscale[r0 + r] : cscale;
    float u[3][8];
#pragma unroll
    for (int j = 0; j < 3; ++j) unpack8(rw[j], u[j]);
#pragma unroll
    for (int r = 0; r < 8; ++r) {
        float x[8]; unpack8(rw[3 + r], x);
        const float sc = sc8[r];
        float o[8];
#pragma unroll
        for (int e = 0; e < 8; ++e) { const float cv = (w[0][e] * u[0][e] + w[1][e] * u[1][e]) + (w[2][e] * u[2][e] + w[3][e] * x[e]); o[e] = cv * fsigmoid(cv) * sc;
            u[0][e] = u[1][e]; u[1][e] = u[2][e]; u[2][e] = x[e]; }
        *(LAS u32x4*)(dst + (r0 + r) * PIT + cg * 16) = pack8(o);
    }
}
__device__ __forceinline__ void load_gates(LAS float* vec, const float* gif, int t0, int h, int tid) {
    LAS float* li = vec; LAS float* bc = vec + 128; LAS float* tot = vec + 256;
    const int lane = tid & 63;
    float v = 0.f;
    if (tid < 128) { li[tid] = gif[(size_t)(t0 + tid) * 8 + h]; v = gif[(size_t)(t0 + tid) * 8 + 4 + h];
#pragma unroll
        for (int o = 1; o < 64; o <<= 1) { const float uu = __shfl_up(v, o); if (lane >= o) v += uu; }
        if (tid == 63) tot[0] = v; }
    __syncthreads();
    if (tid < 128) { if (tid >= 64) v += tot[0]; bc[tid] = v; }
}

__device__ __forceinline__ void m1_phase(LAS char* lds, const bf16_t* proj, const float* gif, bf16_t* Cst, float* nst, float* gch, float* mloc, const float* convw, int bx, int G) {
    const int tid = my_tid(), lane = tid & 63, wid = __builtin_amdgcn_readfirstlane(tid >> 6), g = lane >> 4, fr = lane & 15;
    LAS char* X = lds + XOFF; LAS char* Y = lds + YOFF; LAS float* vec = (LAS float*)(lds + VECOFF);
    LAS float* li = vec; LAS float* bc = vec + 128; LAS float* tot = vec + 256; LAS float* es = vec + 272;
    u32x4 rk[11]; float liv = 0.f, lfv = 0.f;
#define M1_ISSUE(it_) do { const int bhl_ = (it_) >> 5, c_ = (it_) & 31, h_ = bhl_ & 3, t0_ = (bhl_ >> 2) * SEQ + c_ * 128; \
        load_conv_issue(rk, proj + SEC(C_MK) + (size_t)t0_ * PP + h_ * 256, c_ * 128, tid); \
        if (tid < 128) { liv = gif[(size_t)(t0_ + tid) * 8 + h_]; lfv = gif[(size_t)(t0_ + tid) * 8 + 4 + h_]; } } while (0)
    if (bx >= NBH * 32) return;
    M1_ISSUE(bx);
    for (int it = bx; it < NBH * 32; it += G) {
        const int bhl = it >> 5, h = bhl & 3, item = it;
        u32x4 pv[8]; load_plain_issue(pv, proj + SEC(C_MV) + (size_t)((bhl >> 2) * SEQ + (it & 31) * 128) * PP + h * 256, PP, tid);
        float v = lfv;
        if (tid < 128) { li[tid] = liv;
#pragma unroll
            for (int o = 1; o < 64; o <<= 1) { const float uu = __shfl_up(v, o); if (lane >= o) v += uu; }
            if (tid == 63) tot[0] = v; }
        BAR_LDS();
        if (tid < 128) { if (tid >= 64) v += tot[0]; bc[tid] = v; }
        BAR_LDS();
        const float gtot = bc[127];
        const float w0 = gtot - bc[lane] + li[lane], w1 = gtot - bc[lane + 64] + li[lane + 64];
        const float ml = wave_max(fmaxf(w0, w1));
        if (tid < 128) es[tid] = __expf(gtot - bc[tid] + li[tid] - ml);
        if (tid == 0) { gch[item] = gtot; mloc[item] = ml; }
        BAR_LDS();
        load_conv_finish(X, rk, convw + 1024 + h * 256, es, 1.0f, tid);
        load_plain_commit(Y, pv, tid);
        BAR_LDS();
        if (it + G < NBH * 32) M1_ISSUE(it + G);
        if (tid < 256) { float sn = 0.f; const LAS char* xc = X + tid * 2;
#pragma unroll 16
            for (int r = 0; r < 128; ++r) sn += __uint_as_float((unsigned)(*(const LAS unsigned short*)(xc + r * PIT)) << 16);
            nst[(size_t)item * 256 + tid] = sn; }
        bf16_t* Co = Cst + (size_t)item * 65536;
#pragma unroll 1
        for (int hk = 0; hk < 2; ++hk) {
            f32x4 acc[2][8];
#pragma unroll
            for (int i = 0; i < 2; ++i)
#pragma unroll
                for (int j = 0; j < 8; ++j) acc[i][j] = (f32x4){0.f, 0.f, 0.f, 0.f};
            const LAS char* Xh = X + hk * 256;
#pragma unroll 1
            for (int t = 0; t < 4; ++t) {
                const bf16x8 v0 = trfrag(Y, PIT, 32 * t, 16 * (2 * wid), lane), v1 = trfrag(Y, PIT, 32 * t, 16 * (2 * wid + 1), lane);
#pragma unroll
                for (int kh = 0; kh < 2; ++kh) {
                    bf16x8 kf[4];
#pragma unroll
                    for (int kb = 0; kb < 4; ++kb) kf[kb] = trfrag(Xh, PIT, 32 * t, 16 * (4 * kh + kb), lane);
                    __builtin_amdgcn_sched_barrier(0);
#pragma unroll
                    for (int kb = 0; kb < 4; ++kb) { acc[0][4 * kh + kb] = mfma16(v0, kf[kb], acc[0][4 * kh + kb]); acc[1][4 * kh + kb] = mfma16(v1, kf[kb], acc[1][4 * kh + kb]); } }
            }
#pragma unroll
            for (int i = 0; i < 2; ++i)
#pragma unroll
                for (int kb = 0; kb < 8; ++kb) { u32x2 w; w.x = cvt_pk_bf16(acc[i][kb][0], acc[i][kb][1]); w.y = cvt_pk_bf16(acc[i][kb][2], acc[i][kb][3]);
                    *(u32x2*)(Co + (size_t)(128 * hk + 16 * kb + fr) * 256 + 16 * (2 * wid + i) + 4 * g) = w; }
        }
        BAR_LDS();
    }
#undef M1_ISSUE
}

__device__ __forceinline__ void phase_scan(bf16_t* Cst, float* nst, const float* gch, const float* mloc, float* mprev) {
    const int tid = my_tid();
    for (int i = blockIdx.x * NTHR + tid; i < NBH * 8192 + NBH * 256; i += gridDim.x * NTHR) {
        if (i < NBH * 8192) {
            const int bh = i >> 13, e8 = i & 8191;
            float st[8];
#pragma unroll
            for (int e = 0; e < 8; ++e) st[e] = 0.f;
            float m = -1e30f;
            for (int c0 = 0; c0 < 32; c0 += 8) {
                u32x4 ld[8];
#pragma unroll
                for (int j = 0; j < 8; ++j) ld[j] = *(const u32x4*)(Cst + ((size_t)(bh * 32 + c0 + j) * 65536 + e8 * 8));
#pragma unroll
                for (int j = 0; j < 8; ++j) { const int c = c0 + j; const float gc = gch[bh * 32 + c], mc = mloc[bh * 32 + c];
                    const float mn = fmaxf(gc + m, mc), aa = __expf(gc + m - mn), bb = __expf(mc - mn);
                    float lc[8]; unpack8(ld[j], lc);
                    *(u32x4*)(Cst + ((size_t)(bh * 32 + c) * 65536 + e8 * 8)) = pack8(st);
#pragma unroll
                    for (int e = 0; e < 8; ++e) st[e] = aa * st[e] + bb * lc[e];
                    if (e8 == 0) mprev[bh * 32 + c] = m;
                    m = mn; }
            }
        } else {
            const int j = i - NBH * 8192, bh = j >> 8, k = j & 255;
            float st = 0.f, m = -1e30f;
            for (int c = 0; c < 32; ++c) { const float gc = gch[bh * 32 + c], mc = mloc[bh * 32 + c];
                const float mn = fmaxf(gc + m, mc), aa = __expf(gc + m - mn), bb = __expf(mc - mn);
                const size_t o = (size_t)(bh * 32 + c) * 256 + k; const float lc = nst[o]; nst[o] = st; st = aa * st + bb * lc; m = mn; }
        }
    }
}

__device__ __forceinline__ void m3_item(LAS char* lds, bf16_t* proj, const float* gif, const bf16_t* Cst, const float* nst, const float* mprev, const float* convw, int bhl, int c) {
    const int tid = my_tid(), lane = tid & 63, wid = __builtin_amdgcn_readfirstlane(tid >> 6), g = lane >> 4, fr = lane & 15;
    const int bl = bhl >> 2, h = bhl & 3, item = bhl * 32 + c, t0 = bl * SEQ + c * 128;
    LAS char* X = lds + XOFF; LAS char* Y = lds + YOFF; LAS float* vec = (LAS float*)(lds + VECOFF);
    LAS float* li = vec; LAS float* bc = vec + 128; LAS float* npv = vec + 272;
    load_gates(vec, gif, t0, h, tid);
    if (tid < 256) npv[tid] = nst[(size_t)item * 256 + tid];
    load_conv(X, proj + SEC(C_MQ) + (size_t)t0 * PP + h * 256, c * 128, convw + h * 256, nullptr, 0.0625f, tid);
    load_conv(Y, proj + SEC(C_MK) + (size_t)t0 * PP + h * 256, c * 128, convw + 1024 + h * 256, nullptr, 1.0f, tid);
    __syncthreads();
    const int j0 = 16 * wid, jj = j0 + fr;
    bf16x8 pf[4]; float den, inter, mt;
    u32x4 pre[8];
    load_plain_issue(pre, Cst + (size_t)item * 65536, 256, tid);
    {
        f32x4 S[8];
#pragma unroll
        for (int sb = 0; sb < 8; ++sb) S[sb] = (f32x4){0.f, 0.f, 0.f, 0.f};
#pragma unroll 1
        for (int t = 0; t < 8; ++t) { const bf16x8 qb = rowfrag(X, PIT, j0, 32 * t, lane);
            bf16x8 kf[8];
#pragma unroll
            for (int sb = 0; sb < 8; ++sb) kf[sb] = rowfrag(Y, PIT, 16 * sb, 32 * t, lane);
            __builtin_amdgcn_sched_barrier(0);
#pragma unroll
            for (int sb = 0; sb < 8; ++sb) S[sb] = mfma16(kf[sb], qb, S[sb]); }
        float qn = 0.f;
        { const LAS char* qr = X + jj * PIT + (64 * g) * 2;
#pragma unroll 2
            for (int i = 0; i < 8; ++i) { const u32x4 v = *(const LAS u32x4*)(qr + 16 * i); float f[8]; unpack8(v, f);
                const f32x4 n0 = *(const LAS f32x4*)(npv + 64 * g + 8 * i), n1 = *(const LAS f32x4*)(npv + 64 * g + 8 * i + 4);
                qn += (f[0] * n0.x + f[1] * n0.y) + (f[2] * n0.z + f[3] * n0.w) + (f[4] * n1.x + f[5] * n1.y) + (f[6] * n1.z + f[7] * n1.w); } }
        qn += __shfl_xor(qn, 16); qn += __shfl_xor(qn, 32);
        const float bj = bc[jj], mp = mprev[item];
        float rmax = -INFINITY;
#pragma unroll
        for (int sb = 0; sb < 8; ++sb) { const f32x4 b4 = *(const LAS f32x4*)(bc + 16 * sb + 4 * g), l4 = *(const LAS f32x4*)(li + 16 * sb + 4 * g);
#pragma unroll
            for (int r = 0; r < 4; ++r) { const int s = 16 * sb + 4 * g + r; const float dm = (s <= jj) ? (bj - b4[r] + l4[r]) : -INFINITY; rmax = fmaxf(rmax, dm); } }
        rmax = fmaxf(rmax, __shfl_xor(rmax, 16)); rmax = fmaxf(rmax, __shfl_xor(rmax, 32));
        const float minter = bj + mp; mt = fmaxf(minter, rmax); inter = __expf(minter - mt);
        den = 0.f;
#pragma unroll
        for (int sb = 0; sb < 8; ++sb) { const f32x4 b4 = *(const LAS f32x4*)(bc + 16 * sb + 4 * g), l4 = *(const LAS f32x4*)(li + 16 * sb + 4 * g);
#pragma unroll
            for (int r = 0; r < 4; ++r) { const int s = 16 * sb + 4 * g + r; const float p = (s <= jj) ? __expf(bj - b4[r] + l4[r] - mt) : 0.f; const float v = S[sb][r] * p; S[sb][r] = v; den += v; } }
        den += __shfl_xor(den, 16); den += __shfl_xor(den, 32);
        den += inter * qn;
#pragma unroll
        for (int t = 0; t < 4; ++t) { u32x4 w; w.x = cvt_pk_bf16(S[2 * t][0], S[2 * t][1]); w.y = cvt_pk_bf16(S[2 * t][2], S[2 * t][3]); w.z = cvt_pk_bf16(S[2 * t + 1][0], S[2 * t + 1][1]); w.w = cvt_pk_bf16(S[2 * t + 1][2], S[2 * t + 1][3]); pf[t] = __builtin_bit_cast(bf16x8, w); }
    }
    f32x4 acc[16];
#pragma unroll
    for (int j = 0; j < 16; ++j) acc[j] = (f32x4){0.f, 0.f, 0.f, 0.f};
#pragma unroll 1
    for (int half = 0; half < 2; ++half) {
        __syncthreads();
        load_plain_commit(Y, pre, tid);
        if (half == 0) load_plain_issue(pre, Cst + (size_t)item * 65536 + 32768, 256, tid);
        else load_plain_issue(pre, proj + SEC(C_MV) + (size_t)t0 * PP + h * 256, PP, tid);
        __syncthreads();
#pragma unroll 1
        for (int t = 0; t < 4; ++t) { const bf16x8 qb = rowfrag_perm(X, PIT, j0, half * 128 + 32 * t, lane);
#pragma unroll
            for (int hb = 0; hb < 2; ++hb) {
                bf16x8 cf[8];
#pragma unroll
                for (int nb = 0; nb < 8; ++nb) cf[nb] = trfrag(Y, PIT, 32 * t, 16 * (8 * hb + nb), lane);
                __builtin_amdgcn_sched_barrier(0);
#pragma unroll
                for (int nb = 0; nb < 8; ++nb) acc[8 * hb + nb] = mfma16(cf[nb], qb, acc[8 * hb + nb]); } }
    }
#pragma unroll
    for (int nb = 0; nb < 16; ++nb) acc[nb] = acc[nb] * inter;
    __syncthreads();
    load_plain_commit(X, pre, tid);
    __syncthreads();
#pragma unroll
    for (int t = 0; t < 4; ++t) if (2 * t <= wid) {
        bf16x8 vf[16];
#pragma unroll
        for (int nb = 0; nb < 16; ++nb) vf[nb] = trfrag(X, PIT, 32 * t, 16 * nb, lane);
        __builtin_amdgcn_sched_barrier(0);
#pragma unroll
        for (int nb = 0; nb < 16; ++nb) acc[nb] = mfma16(vf[nb], pf[t], acc[nb]); }
    const float rdn = 1.0f / fmaxf(fabsf(den), __expf(-mt));
    bf16_t* op = proj + SEC(C_MO) + (size_t)(t0 + jj) * PP + h * 256 + 4 * g;
    u32x2 sgv[16];
#pragma unroll
    for (int nb = 0; nb < 16; ++nb) sgv[nb] = *(const u32x2*)(op + 16 * nb);
#pragma unroll
    for (int nb = 0; nb < 16; ++nb) { const u32x2 sg = sgv[nb];
        u32x2 w; w.x = cvt_pk_bf16(acc[nb][0] * rdn * bflo(sg.x), acc[nb][1] * rdn * bfhi(sg.x)); w.y = cvt_pk_bf16(acc[nb][2] * rdn * bflo(sg.y), acc[nb][3] * rdn * bfhi(sg.y));
        *(u32x2*)(op + 16 * nb) = w; }
    __syncthreads();
}

__device__ __forceinline__ void phase_qkprep(bf16_t* proj, const float* gqk  , const float2* rope) {
    const int tid = my_tid(), lane = tid & 63, wave = tid >> 6;
    const int gw = blockIdx.x * 8 + wave, NGW = gridDim.x * 8;
    const int grp = lane >> 2, u = lane & 3;
    for (int it = gw; it < TG * 2; it += NGW) {
        const int row = it >> 1, which = it & 1, pos = row & (SEQ - 1);
        bf16_t* p = proj + (which ? SEC(C_AK) : SEC(C_AQ)) + (size_t)row * PP + grp * 64 + 8 * u;
        const u32x4 a = *(const u32x4*)p, b = *(const u32x4*)(p + 32);
        float x1[8], x2[8]; unpack8(a, x1); unpack8(b, x2);
        float ss = 0.f;
#pragma unroll
        for (int e = 0; e < 8; ++e) ss += x1[e] * x1[e] + x2[e] * x2[e];
        ss += __shfl_xor(ss, 1); ss += __shfl_xor(ss, 2);
        const float rstd = 1.0f / sqrtf(ss * (1.0f / 64.0f) + 1e-6f) * (which ? 1.0f : 0.125f * 1.4426950408889634f);
        const float* gq = gqk + which * 64 + 8 * u;
        const float2* cs = rope + (size_t)pos * 32 + 8 * u;
        float o1[8], o2[8];
#pragma unroll
        for (int e = 0; e < 8; ++e) { const float y1 = x1[e] * rstd * gq[e], y2 = x2[e] * rstd * gq[32 + e]; const float2 t = cs[e]; o1[e] = y1 * t.x - y2 * t.y; o2[e] = y2 * t.x + y1 * t.y; }
        *(u32x4*)p = pack8(o1); *(u32x4*)(p + 32) = pack8(o2);
    }
}
__device__ __forceinline__ void phase_pool(const bf16_t* proj, bf16_t* pooled) {
    const int tid = my_tid();
    for (int idx = blockIdx.x * NTHR + tid; idx < (TG / 16) * 128; idx += gridDim.x * NTHR) {
        const int cgi = idx & 127, seg = idx >> 7, r0 = seg * 16, pos0 = r0 & (SEQ - 1), w = 2 << (cgi >> 5);
        const bf16_t* src = proj + SEC(C_PU) + (size_t)r0 * PP + cgi * 8;
        float sum[8];
#pragma unroll
        for (int e = 0; e < 8; ++e) sum[e] = 0.f;
        if (pos0 > 0) for (int j = 1; j < w; ++j) { float f[8]; unpack8(*(const u32x4*)(src - (ptrdiff_t)j * PP), f);
#pragma unroll
            for (int e = 0; e < 8; ++e) sum[e] += f[e]; }
        for (int r = 0; r < 16; ++r) {
            float f[8]; unpack8(*(const u32x4*)(src + (ptrdiff_t)r * PP), f);
            const int pos = pos0 + r;
            if (r >= 1 && pos - w >= 0) { float o[8]; unpack8(*(const u32x4*)(src + (ptrdiff_t)(r - w) * PP), o);
#pragma unroll
                for (int e = 0; e < 8; ++e) sum[e] -= o[e]; }
            const float rc = 1.0f / (float)(pos + 1 < w ? pos + 1 : w);
            float out[8];
#pragma unroll
            for (int e = 0; e < 8; ++e) { sum[e] += f[e]; out[e] = sum[e] * rc - f[e]; }
            *(u32x4*)(pooled + (size_t)(r0 + r) * DM + cgi * 8) = pack8(out);
        }
    }
}

constexpr int APIT = 288, ATILE = 64 * APIT, ABUF = 2 * ATILE;
__device__ __forceinline__ void attn_qkexp(const LAS char* Kb, int k0, int q0, int wid, int lane, int g, int qpos, const bf16x8 (&qf)[2][2], const f32x4 negM, bf16x8 (&pf)[2][2]) {
    f32x4 s[2][4];
    {
        bf16x8 kf[2][4][2];
#pragma unroll
        for (int c = 0; c < 2; ++c)
#pragma unroll
            for (int kb = 0; kb < 4; ++kb)
#pragma unroll
                for (int ks = 0; ks < 2; ++ks) kf[c][kb][ks] = rowfrag(Kb, APIT, 16 * kb, c * 64 + 32 * ks, lane);
        __builtin_amdgcn_sched_barrier(0);
#pragma unroll
        for (int c = 0; c < 2; ++c)
#pragma unroll
            for (int kb = 0; kb < 4; ++kb) s[c][kb] = mfma16(kf[c][kb][0], qf[c][0], negM);
#pragma unroll
        for (int c = 0; c < 2; ++c)
#pragma unroll
            for (int kb = 0; kb < 4; ++kb) s[c][kb] = mfma16(kf[c][kb][1], qf[c][1], s[c][kb]);
    }
    if (k0 + 63 > q0 + 16 * wid) {
#pragma unroll
        for (int c = 0; c < 2; ++c)
#pragma unroll
            for (int kb = 0; kb < 4; ++kb)
#pragma unroll
                for (int r = 0; r < 4; ++r) if (k0 + 16 * kb + 4 * g + r > qpos) s[c][kb][r] = -INFINITY;
    }
#pragma unroll
    for (int c = 0; c < 2; ++c) {
#pragma unroll
        for (int kb = 0; kb < 4; ++kb)
#pragma unroll
            for (int r = 0; r < 4; ++r) s[c][kb][r] = __builtin_amdgcn_exp2f(s[c][kb][r]);
#pragma unroll
        for (int tt = 0; tt < 2; ++tt) { u32x4 w; w.x = cvt_pk_bf16(s[c][2 * tt][0], s[c][2 * tt][1]); w.y = cvt_pk_bf16(s[c][2 * tt][2], s[c][2 * tt][3]);
            w.z = cvt_pk_bf16(s[c][2 * tt + 1][0], s[c][2 * tt + 1][1]); w.w = cvt_pk_bf16(s[c][2 * tt + 1][2], s[c][2 * tt + 1][3]); pf[c][tt] = __builtin_bit_cast(bf16x8, w); }
    }
}
__device__ __forceinline__ void attn_pv(const LAS char* Vb, int lane, const bf16x8 (&pf)[2][2], const bf16x8 onesf, f32x4 (&O)[2][8], f32x4 (&Oe)[2]) {
    bf16x8 va[8], vb[8];
#pragma unroll
    for (int nb = 0; nb < 8; ++nb) va[nb] = trfrag(Vb, APIT, 0, 16 * nb, lane);
#pragma unroll
    for (int nb = 0; nb < 8; ++nb) vb[nb] = trfrag(Vb, APIT, 32, 16 * nb, lane);
    __builtin_amdgcn_sched_barrier(0);
    Oe[0] = mfma16(onesf, pf[0][0], Oe[0]); Oe[1] = mfma16(onesf, pf[1][0], Oe[1]);
#pragma unroll
    for (int nb = 0; nb < 8; ++nb) { O[0][nb] = mfma16(va[nb], pf[0][0], O[0][nb]); O[1][nb] = mfma16(va[nb], pf[1][0], O[1][nb]); }
    Oe[0] = mfma16(onesf, pf[0][1], Oe[0]); Oe[1] = mfma16(onesf, pf[1][1], Oe[1]);
#pragma unroll
    for (int nb = 0; nb < 8; ++nb) { O[0][nb] = mfma16(vb[nb], pf[0][1], O[0][nb]); O[1][nb] = mfma16(vb[nb], pf[1][1], O[1][nb]); }
}
__device__ __forceinline__ void attn_step_fast(const LAS char* Kb, const LAS char* Vb, int lane, const bf16x8 (&qf)[2][2], const f32x4 negM, const bf16x8 onesf, f32x4 (&O)[2][8], f32x4 (&Oe)[2]) {
    f32x4 s0[4], s1[4];
    bf16x8 p0[2], p1[2];
    {
        bf16x8 kf[2][4][2];
#pragma unroll
        for (int c = 0; c < 2; ++c)
#pragma unroll
            for (int kb = 0; kb < 4; ++kb)
#pragma unroll
                for (int ks = 0; ks < 2; ++ks) kf[c][kb][ks] = rowfrag(Kb, APIT, 16 * kb, c * 64 + 32 * ks, lane);
        __builtin_amdgcn_sched_barrier(0);
#pragma unroll
        for (int kb = 0; kb < 4; ++kb) s0[kb] = mfma16(kf[0][kb][0], qf[0][0], negM);
#pragma unroll
        for (int kb = 0; kb < 4; ++kb) s0[kb] = mfma16(kf[0][kb][1], qf[0][1], s0[kb]);
        __builtin_amdgcn_sched_barrier(0);
#pragma unroll
        for (int kb = 0; kb < 4; ++kb) s1[kb] = mfma16(kf[1][kb][0], qf[1][0], negM);
#pragma unroll
        for (int kb = 0; kb < 4; ++kb) s1[kb] = mfma16(kf[1][kb][1], qf[1][1], s1[kb]);
    }
#define ATT_EXPPACK(S, P) do { \
        _Pragma("unroll") for (int kb = 0; kb < 4; ++kb) _Pragma("unroll") for (int r = 0; r < 4; ++r) S[kb][r] = __builtin_amdgcn_exp2f(S[kb][r]); \
        _Pragma("unroll") for (int tt = 0; tt < 2; ++tt) { u32x4 w; w.x = cvt_pk_bf16(S[2 * tt][0], S[2 * tt][1]); w.y = cvt_pk_bf16(S[2 * tt][2], S[2 * tt][3]); \
            w.z = cvt_pk_bf16(S[2 * tt + 1][0], S[2 * tt + 1][1]); w.w = cvt_pk_bf16(S[2 * tt + 1][2], S[2 * tt + 1][3]); P[tt] = __builtin_bit_cast(bf16x8, w); } } while (0)
    ATT_EXPPACK(s0, p0);
#pragma unroll
    for (int i = 0; i < 8; ++i) { __builtin_amdgcn_sched_group_barrier(0x008, 1, 0); __builtin_amdgcn_sched_group_barrier(0x002, 3, 0); }
    __builtin_amdgcn_sched_barrier(0);
    bf16x8 va[8], vb[8];
#pragma unroll
    for (int nb = 0; nb < 8; ++nb) va[nb] = trfrag(Vb, APIT, 0, 16 * nb, lane);
#pragma unroll
    for (int nb = 0; nb < 8; ++nb) vb[nb] = trfrag(Vb, APIT, 32, 16 * nb, lane);
    __builtin_amdgcn_sched_barrier(0);
    Oe[0] = mfma16(onesf, p0[0], Oe[0]);
#pragma unroll
    for (int nb = 0; nb < 8; ++nb) O[0][nb] = mfma16(va[nb], p0[0], O[0][nb]);
    Oe[0] = mfma16(onesf, p0[1], Oe[0]);
#pragma unroll
    for (int nb = 0; nb < 8; ++nb) O[0][nb] = mfma16(vb[nb], p0[1], O[0][nb]);
    ATT_EXPPACK(s1, p1);
#pragma unroll
    for (int i = 0; i < 18; ++i) { __builtin_amdgcn_sched_group_barrier(0x008, 1, 0); __builtin_amdgcn_sched_group_barrier(0x002, 2, 0); }
    __builtin_amdgcn_sched_barrier(0);
    Oe[1] = mfma16(onesf, p1[0], Oe[1]);
#pragma unroll
    for (int nb = 0; nb < 8; ++nb) O[1][nb] = mfma16(va[nb], p1[0], O[1][nb]);
    Oe[1] = mfma16(onesf, p1[1], Oe[1]);
#pragma unroll
    for (int nb = 0; nb < 8; ++nb) O[1][nb] = mfma16(vb[nb], p1[1], O[1][nb]);
#undef ATT_EXPPACK
}
__device__ __forceinline__ void attn_item(LAS char* lds, bf16_t* proj, int bl, int h, int qb, float lam, float oscale, const float* gdh, float smax) {
    const int tid = my_tid(), lane = tid & 63, wid = __builtin_amdgcn_readfirstlane(tid >> 6), g = lane >> 4, fr = lane & 15;
    const size_t rowbase = (size_t)bl * SEQ; const int q0 = qb * 128, qpos = q0 + 16 * wid + fr;
    bf16_t* qp = proj + SEC(C_AQ) + (rowbase + qpos) * PP + h * 128;
    bf16x8 qf[2][2];
#pragma unroll
    for (int c = 0; c < 2; ++c)
#pragma unroll
        for (int ks = 0; ks < 2; ++ks) qf[c][ks] = *(const bf16x8*)(qp + c * 64 + 32 * ks + 8 * g);
    f32x4 O[2][8], Oe[2];
#pragma unroll
    for (int c = 0; c < 2; ++c) { Oe[c] = (f32x4){0.f, 0.f, 0.f, 0.f};
#pragma unroll
        for (int nb = 0; nb < 8; ++nb) O[c][nb] = (f32x4){0.f, 0.f, 0.f, 0.f}; }
    const f32x4 negM = (f32x4){-smax, -smax, -smax, -smax};
    const short one16 = (fr == 0) ? (short)0x3F80 : (short)0;
    const bf16x8 onesf = (bf16x8){one16, one16, one16, one16, one16, one16, one16, one16};
    const int NT = 2 * (qb + 1);
    const int sr0 = tid >> 4, sc = tid & 15;
    const bf16_t* kg = proj + SEC(C_AK) + (rowbase + sr0) * PP + h * 128 + sc * 8;
    const bf16_t* vg = proj + SEC(C_AV) + (rowbase + sr0) * PP + h * 128 + sc * 8;
    const int soff = sr0 * APIT + sc * 16;
    u32x4 kr[2], vr[2];
#define ATT_LOAD(tile) do { _Pragma("unroll") for (int i = 0; i < 2; ++i) { kr[i] = *(const u32x4*)(kg + (size_t)(64 * (tile) + 32 * i) * PP); vr[i] = *(const u32x4*)(vg + (size_t)(64 * (tile) + 32 * i) * PP); } } while (0)
#define ATT_STORE(buf) do { LAS char* nb_ = lds + (buf) * ABUF; _Pragma("unroll") for (int i = 0; i < 2; ++i) { *(LAS u32x4*)(nb_ + soff + 32 * i * APIT) = kr[i]; *(LAS u32x4*)(nb_ + ATILE + soff + 32 * i * APIT) = vr[i]; } } while (0)
    ATT_LOAD(0); ATT_STORE(0);
    __syncthreads();
    const int qmaxw = q0 + 16 * wid + 15;
    int t = 0;
    for (; t < NT - 2; ++t) {
        ATT_LOAD(t + 1);
        const LAS char* Kb = lds + (t & 1) * ABUF;
#if ATT_FAST
        attn_step_fast(Kb, Kb + ATILE, lane, qf, negM, onesf, O, Oe);
#else
        { bf16x8 pq[2][2]; attn_qkexp(Kb, 64 * t, q0, wid, lane, g, qpos, qf, negM, pq); attn_pv(Kb + ATILE, lane, pq, onesf, O, Oe); }
#endif
        ATT_STORE((t + 1) & 1);
        BAR_LDS();
    }
    bf16x8 pf[2][2];
    for (; t < NT; ++t) {
        const int k0 = 64 * t;
        if (t + 1 < NT) ATT_LOAD(t + 1);
        if (k0 <= qmaxw) {
            const LAS char* Kb = lds + (t & 1) * ABUF;
            attn_qkexp(Kb, k0, q0, wid, lane, g, qpos, qf, negM, pf);
            attn_pv(Kb + ATILE, lane, pf, onesf, O, Oe);
        }
        if (t + 1 < NT) ATT_STORE((t + 1) & 1);
        BAR_LDS();
    }
#undef ATT_LOAD
#undef ATT_STORE
    const float l0 = __shfl(Oe[0][0], fr), l1 = __shfl(Oe[1][0], fr);
    const float r0 = 1.0f / l0, r1 = lam / l1;
    float ss = 0.f;
#pragma unroll
    for (int nb = 0; nb < 8; ++nb)
#pragma unroll
        for (int r = 0; r < 4; ++r) { const float o = O[0][nb][r] * r0 - O[1][nb][r] * r1; O[0][nb][r] = o; ss += o * o; }
    ss += __shfl_xor(ss, 16); ss += __shfl_xor(ss, 32);
    const float rstd = 1.0f / sqrtf(ss * (1.0f / 128.0f) + 1e-6f) * oscale;
    f32x4 ggv[8];
#pragma unroll
    for (int nb = 0; nb < 8; ++nb) ggv[nb] = *(const f32x4*)(gdh + 16 * nb + 4 * g);
#pragma unroll
    for (int nb = 0; nb < 8; ++nb) { const f32x4 gg = ggv[nb];
        u32x2 w; w.x = cvt_pk_bf16(O[0][nb][0] * rstd * gg.x, O[0][nb][1] * rstd * gg.y); w.y = cvt_pk_bf16(O[0][nb][2] * rstd * gg.z, O[0][nb][3] * rstd * gg.w);
        *(u32x2*)(qp + ((ptrdiff_t)SEC(C_PU) - (ptrdiff_t)SEC(C_AQ)) + 16 * nb + 4 * g) = w; }
}

#ifndef PH_ONLY
#define PH_ONLY -1
#endif
#define PHO(n) (PH_ONLY < 0 || PH_ONLY == (n))
#ifndef PROJ_ALIGN
#define PROJ_ALIGN true
#endif
#ifndef ATT_FAST
#define ATT_FAST 1
#endif
#ifndef DUP_K
#define DUP_K -1
#endif
__global__ void __launch_bounds__(NTHR, 2) fwd_kernel(Args a) {
    extern __shared__ __attribute__((aligned(16))) unsigned char lds_raw[];
    LAS unsigned char* lds = (LAS unsigned char*)lds_raw;
    cg::grid_group grid = cg::this_grid();
    unsigned char* ws = a.ws;
    bf16_t* proj = (bf16_t*)(ws + WS_PROJ);
    bf16_t* hn = (bf16_t*)(ws + WS_HN);
    bf16_t* Cst = (bf16_t*)(ws + WS_CST);
    float* gif = (float*)(ws + WS_GIF);
    float* gch = (float*)(ws + WS_MV); float* mloc = gch + 512; float* mprev = gch + 1024;
    float* nst = (float*)(ws + WS_NST);
    const int G = gridDim.x, bx = blockIdx.x;
    unsigned* barw = (unsigned*)ws;
    volatile LAS unsigned* bst = (volatile LAS unsigned*)(lds + LDS_BYTES - 64);
    if (threadIdx.x < 2) bst[threadIdx.x] = 0u;
    if (bx == 0) for (int i = threadIdx.x; i < XCD_BAR_WORDS; i += NTHR) barw[i] = 0u;
    __syncthreads();
    XcdBarrier xb; xb.bar = barw; xb.x = 0; xb.st = bst;
    bool xb_ready = false;
    for (int ph = a.ph_lo; ph < a.ph_hi; ++ph) {
        const int l = ph / 18, idx = ph % 18;
        const float* xsrc = (l == 0) ? a.in[0] : a.out;
        if (PHO(0) && idx == 0) {
            phase_weights(a, l, lds);
        } else if (idx <= 14) {
            const int grp = (idx - 1) / 7, k = (idx - 1) % 7;
            const size_t rowoff = (size_t)grp * TG;
            if (PHO(1) && k == 0) {
                for (int rep = 0; rep < (DUP_K == 0 ? 2 : 1); ++rep)
                phase_norm<true>(xsrc + rowoff * DM, a.in[1] + l * DM, hn, TG, a.in[2] + (size_t)l * DM * NIN, a.in[3] + l * 8, gif, lds);
            } else if (PHO(2) && k == 1) {
                pg8::Gemm gm{hn, (const bf16_t*)(ws + WS_WIN), TG, NP, DM, 64, 0, (size_t)TG * 64 * 2}; pg8::StaticOrder S; S.init(TG, NP, G, bx);
                pg8::EpiProj E{proj, PP, (size_t)TG * 1024};
                for (int rep = 0; rep < (DUP_K == 1 ? 2 : 1); ++rep)
                pg8::gemm_phase<pg8::EpiProj, pg8::StaticOrder, PROJ_ALIGN, true>(lds, gm, S, E);
            } else if (PHO(3) && k == 2) {
                const float* convw = a.in[4] + (size_t)l * 4 * 2048;
                for (int rep = 0; rep < (DUP_K == 2 ? 2 : 1); ++rep)
                m1_phase((LAS char*)lds, proj, gif, Cst, nst, gch, mloc, convw, bx, G);
                phase_qkprep(proj, a.in[8] + l * 128, (const float2*)(ws + WS_ROPE));
                phase_pool(proj, hn);
            } else if (PHO(4) && k == 3) {
                phase_scan(Cst, nst, gch, mloc, mprev);
                const float* lp = a.in[9] + l * 256;
                float s01 = 0.f, s23 = 0.f;
                for (int i = 0; i < 64; ++i) { s01 += lp[i] * lp[64 + i]; s23 += lp[128 + i] * lp[192 + i]; }
                float mgq = 0.f, mgk = 0.f; { const float* gq = a.in[8] + l * 128; for (int i = 0; i < 64; ++i) { mgq = fmaxf(mgq, fabsf(gq[i])); mgk = fmaxf(mgk, fabsf(gq[64 + i])); } }
                const float smax = 64.0f * mgq * mgk * (0.125f * 1.4426950408889634f) * 1.01f + 0.25f;
                const float lam_init = 0.8f - 0.6f * expf(-0.3f * (float)l);
                const float lam = expf(s01) - expf(s23) + lam_init;
                for (int rep = 0; rep < (DUP_K == 3 ? 2 : 1); ++rep)
                for (int i = bx; i < GB * 8 * 32; i += G) {
                    const int r = i >> 8, j = i & 255, x = j & 7, y = j >> 3, bh = x + 8 * r, qb = (r & 1) ? 31 - y : y;
                    attn_item((LAS char*)lds, proj, bh >> 3, bh & 7, qb, lam, 1.0f - lam_init, a.in[10] + l * 128, smax);
                }
            } else if (PHO(5) && k == 4) {
                const float* convw = a.in[4] + (size_t)l * 4 * 2048;
                for (int it = bx; it < NBH * 32; it += G) m3_item((LAS char*)lds, proj, gif, Cst, nst, mprev, convw, it >> 5, it & 31);
            } else if (PHO(6) && k == 5) {
#pragma unroll 1
                for (int brr = 0; brr < (DUP_K == 5 ? 6 : 3); ++brr) { const int br = brr % 3;
                    pg8::Gemm gm; gm.M = TG; gm.N = DM;
                    if (br == 0) { gm.A = proj + SEC(C_MO); gm.Bt = (const bf16_t*)(ws + WS_WMO); gm.K = DM; gm.lda = PP; gm.a_pn_off = 0; }
                    else if (br == 1) { gm.A = hn; gm.Bt = (const bf16_t*)(ws + WS_WPOOL); gm.K = 256; gm.lda = DM; gm.a_pn_off = 256; }
                    else { gm.A = proj + SEC(C_PU); gm.Bt = (const bf16_t*)(ws + WS_WDIFF); gm.K = DM; gm.lda = PP; gm.a_pn_off = 0; }
                    pg8::StaticOrder S; S.init(TG, DM, G, bx);
                    pg8::EpiMerge E{proj + SEC(C_MQ), proj + SEC(C_GT) + (size_t)br * ((size_t)TG * 1024), PP, br == 0 ? 1 : 0};
                    pg8::gemm_phase<pg8::EpiMerge, pg8::StaticOrder, true, true>(lds, gm, S, E);
                }
            } else if (PHO(7)) {
                pg8::Gemm gm{proj + SEC(C_MQ), (const bf16_t*)(ws + WS_WOUT), TG, DM, DM, PP, 0}; pg8::StaticOrder S; S.init(TG, DM, G, bx);
                pg8::EpiResid E{xsrc + rowoff * DM, a.out + rowoff * DM, DM};
                pg8::gemm_phase<pg8::EpiResid, pg8::StaticOrder, true, true>(lds, gm, S, E);
            }
        } else if (PHO(8) && idx == 15) {
            phase_norm<false>(a.out, a.in[13] + l * DM, hn, TT, nullptr, nullptr, nullptr, lds);
        } else if (PHO(9) && idx == 16) {
            pg8::Gemm gm{hn, (const bf16_t*)(ws + WS_WGU), TT, 2 * FF, DM, 64, 0, (size_t)TT * 64 * 2}; pg8::StaticOrder S; S.init(TT, 2 * FF, G, bx);
            pg8::EpiSwiGLU E{proj, (size_t)TT * 64};
            for (int rep = 0; rep < (DUP_K == 16 ? 2 : 1); ++rep)
            pg8::gemm_phase<pg8::EpiSwiGLU, pg8::StaticOrder, true, true>(lds, gm, S, E);
        } else if (PHO(10)) {
            pg8::Gemm gm{proj, (const bf16_t*)(ws + WS_WDN), TT, DM, FF, 64, 0, (size_t)TT * 64 * 2};   pg8::StaticOrder S; S.init(TT, DM, G, bx);
            pg8::EpiResid E{a.out, a.out, DM};
            pg8::gemm_phase<pg8::EpiResid, pg8::StaticOrder, true, true>(lds, gm, S, E);
        }
        if (ph + 1 < a.ph_hi) {
            if (!xb_ready) { grid.sync(); xb = xcd_barrier_post(barw, bst); xb_ready = true; }
            else { xcd_barrier(xb); if (DUP_K == 100) { xcd_barrier(xb); xcd_barrier(xb); } }
        }
    }
}

extern "C" void kernel_launch(void* const* d_in, const int* in_sizes, int n_in, void* d_out, int out_size, void* d_ws, size_t ws_size, hipStream_t stream) {
    static int grid = 0;
    if (grid == 0) {
        if (n_in != 16 || out_size != TT * DM || ws_size < WS_END) { fprintf(stderr, "kernel_launch: unexpected shapes / workspace (%d inputs, out %d, ws %zu)\n", n_in, out_size, ws_size); grid = -1; return; }
        int dev = 0, cus = 0, per_cu = 0;
        hipGetDevice(&dev); hipDeviceGetAttribute(&cus, hipDeviceAttributeMultiprocessorCount, dev);
        hipFuncSetAttribute((const void*)fwd_kernel, hipFuncAttributeMaxDynamicSharedMemorySize, LDS_BYTES);
        hipOccupancyMaxActiveBlocksPerMultiprocessor(&per_cu, (const void*)fwd_kernel, NTHR, LDS_BYTES);
        (void)hipGetLastError();
        if (per_cu < 1) per_cu = 1;
        grid = cus * 1;
        if (grid <= 0) grid = 256;
    }
    if (grid < 0) return;
    Args a{};
    for (int i = 0; i < 16; ++i) a.in[i] = (const float*)d_in[i];
    a.out = (float*)d_out; a.ws = (unsigned char*)d_ws; a.ph_lo = 0; a.ph_hi = 36;
    void* args[] = {&a};
    hipError_t e = hipLaunchCooperativeKernel((const void*)fwd_kernel, dim3(grid), dim3(NTHR), args, LDS_BYTES, stream);
    if (e != hipSuccess) fprintf(stderr, "cooperative launch failed: %s (grid %d)\n", hipGetErrorString(e), grid);
}
```
